# Optimizing an MI355X kernel written in HIP

```python
import math
import jax
import jax.numpy as jnp
from jax import lax
import numpy as np

D_MODEL = 1024
BATCH = 8
SEQ = 4096
DEPTH = 2

GRID_W = 64
CTX_LEN = 256
RMS_EPS = 1e-6
LN_EPS = 1e-5

HY_WIDTH = D_MODEL
HY_ORDER = 2
HY_BANDS = 16
HY_EMB = 1 + 2 * HY_BANDS
HY_FILTER_HIDDEN = 64
HY_MIN_DECAY = -math.log(1e-2) / 1.5
HY_MAX_DECAY = -math.log(1e-2) / 0.3
SHORT_CONV = 3

HEAD_DIM = 128
ATT_HEADS = D_MODEL // HEAD_DIM
ATT_KV_HEADS = 2
ATT_WIDTH = ATT_HEADS * HEAD_DIM
KV_WIDTH = ATT_KV_HEADS * HEAD_DIM
AXIS_DIM = HEAD_DIM // 2
ROPE_THETA = 10000.0
Q_BLOCK = 128

GM_WIDTH = D_MODEL
GM_GROUPS = 8
GM_GROUP_DIM = GM_WIDTH // GM_GROUPS
CHUNK = 128

N_BRANCH = 3
OFF_HY = 0
OFF_HY_GATE = OFF_HY + (HY_ORDER + 1) * HY_WIDTH
OFF_Q = OFF_HY_GATE + HY_WIDTH
OFF_K = OFF_Q + ATT_WIDTH
OFF_V = OFF_K + KV_WIDTH
OFF_ATT_GATE = OFF_V + KV_WIDTH
OFF_GM = OFF_ATT_GATE + ATT_WIDTH
OFF_GM_GATE = OFF_GM + 2 * GM_WIDTH
OFF_MERGE = OFF_GM_GATE + GM_WIDTH
IN_WIDTH = OFF_MERGE + N_BRANCH * D_MODEL

kernel_name = 'hybrid_hyena_gqa_gmlp_dit'


def rms_norm(x, g):
    xf = x.astype(jnp.float32)
    y = xf * lax.rsqrt(jnp.mean(xf * xf, axis=-1, keepdims=True) + RMS_EPS)
    return (y * g.astype(jnp.float32)).astype(x.dtype)


def layer_norm(x, g, b):
    xf = x.astype(jnp.float32)
    xc = xf - jnp.mean(xf, axis=-1, keepdims=True)
    var = jnp.mean(xc * xc, axis=-1, keepdims=True)
    y = xc * lax.rsqrt(var + LN_EPS) * g.astype(jnp.float32) + b.astype(jnp.float32)
    return y.astype(x.dtype)


def short_conv3(x, w, b):
    xp = jnp.pad(x, ((0, 0), (1, 1), (0, 0)))
    return xp[:, :-2] * w[0] + xp[:, 1:-1] * w[1] + xp[:, 2:] * w[2] + b


def hyena_filter_spectra(L, lp):
    f32 = jnp.float32
    t = jnp.linspace(0.0, 1.0, L, dtype=f32)
    bands = jnp.linspace(1e-4, HY_BANDS - 1, HY_BANDS, dtype=f32)
    ang = (2.0 * math.pi / L) * jnp.arange(L, dtype=f32)[:, None] * bands[None, :]
    z = jnp.concatenate([t[:, None], jnp.cos(ang), -jnp.sin(ang)], axis=-1)
    freq = lp['hy_freq'].astype(f32)
    hdn = jnp.sin(freq[0] * (z @ lp['hy_w1'].astype(f32) + lp['hy_b1'].astype(f32)))
    hdn = jnp.sin(freq[1] * (hdn @ lp['hy_w2'].astype(f32) + lp['hy_b2'].astype(f32)))
    h = (hdn @ lp['hy_w3'].astype(f32)).reshape(L, HY_ORDER, 2, HY_WIDTH)
    h = h * jnp.exp(-t[:, None, None, None] * jnp.abs(lp['hy_decay'].astype(f32)))
    fwd, bwd = h[:, :, 0], h[:, :, 1]
    k = jnp.concatenate([fwd[:1] + bwd[:1], fwd[1:], jnp.zeros_like(fwd[:1]),
                         jnp.flip(bwd[1:], axis=0)], axis=0)
    return jnp.fft.rfft(k, axis=0)


def long_conv(z, kf):
    L = z.shape[1]
    zf = jnp.fft.rfft(z.astype(jnp.float32), n=2 * L, axis=1)
    y = jnp.fft.irfft(zf * kf[None], n=2 * L, axis=1)[:, :L]
    return y.astype(z.dtype)


def hyena_branch(p, lp):
    L = p.shape[1]
    p = short_conv3(p, lp['hy_conv_w'], lp['hy_conv_b'])
    x1, x2, v = jnp.split(p, HY_ORDER + 1, axis=-1)
    kf = hyena_filter_spectra(L, lp)
    bias = lp['hy_bias']
    z = x1 * (long_conv(v, kf[:, 0]) + bias[0] * v)
    z = x2 * (long_conv(z, kf[:, 1]) + bias[1] * z)
    return z


def axial_rope_tables(rows):
    f32 = jnp.float32
    row = jnp.repeat(jnp.arange(rows, dtype=f32), GRID_W)
    col = jnp.tile(jnp.arange(GRID_W, dtype=f32), rows)
    inv = jnp.power(ROPE_THETA, -jnp.arange(0, AXIS_DIM, 2, dtype=f32) / AXIS_DIM)
    ar = row[:, None] * inv
    ac = col[:, None] * inv
    return (jnp.cos(ar), jnp.sin(ar), jnp.cos(ac), jnp.sin(ac))


def rotate_half(x, cos, sin):
    m = x.shape[-1] // 2
    x1, x2 = x[..., :m], x[..., m:]
    cos = cos[None, :, None, :]
    sin = sin[None, :, None, :]
    return jnp.concatenate([x1 * cos - x2 * sin, x2 * cos + x1 * sin], axis=-1)


def apply_axial_rope(x, rope):
    cos_r, sin_r, cos_c, sin_c = rope
    xf = x.astype(jnp.float32)
    y = jnp.concatenate([rotate_half(xf[..., :AXIS_DIM], cos_r, sin_r),
                         rotate_half(xf[..., AXIS_DIM:], cos_c, sin_c)], axis=-1)
    return y.astype(x.dtype)


def block_attention(q, k, v):
    B, Lq, H, Dh = q.shape
    Hkv = k.shape[2]
    G = H // Hkv
    nb = Lq // Q_BLOCK
    qb = q.reshape(B, nb, Q_BLOCK, Hkv, G, Dh).transpose(1, 0, 2, 3, 4, 5)
    scale = Dh ** -0.5

    def one_block(qi):
        s = jnp.einsum('bqhgd,bkhd->bhgqk', qi, k, preferred_element_type=jnp.float32) * scale
        p = jax.nn.softmax(s, axis=-1).astype(v.dtype)
        return jnp.einsum('bhgqk,bkhd->bqhgd', p, v)

    o = lax.map(one_block, qb)
    return o.transpose(1, 0, 2, 3, 4, 5).reshape(B, Lq, H * Dh)


def gmlp_branch(p, lp):
    uv = jax.nn.gelu(p, approximate=False)
    u, v = jnp.split(uv, 2, axis=-1)
    v = layer_norm(v, lp['gm_ln_g'], lp['gm_ln_b'])
    B, L, _ = v.shape
    v = v.reshape(B, L // CHUNK, CHUNK, GM_GROUPS, GM_GROUP_DIM)
    y = jnp.einsum('gpq,bnqgc->bnpgc', lp['gm_ws'], v) + lp['gm_bs'].T[None, None, :, :, None]
    return u * y.reshape(B, L, GM_WIDTH)


def gated_merge(proj, hy, att, gm, lp):
    silu = jax.nn.silu
    y_hy = (hy * silu(proj[..., OFF_HY_GATE:OFF_Q])) @ lp['w_hy_o']
    y_at = (att * silu(proj[..., OFF_ATT_GATE:OFF_GM])) @ lp['w_att_o']
    y_gm = (gm * silu(proj[..., OFF_GM_GATE:OFF_MERGE])) @ lp['w_gm_o']
    g_hy, g_at, g_gm = jnp.split(jax.nn.sigmoid(proj[..., OFF_MERGE:]), N_BRANCH, axis=-1)
    return (g_hy * y_hy + g_at * y_at + g_gm * y_gm) @ lp['w_out']


def latent_mixer(proj, kc, vc, rope, lp):
    B, L, _ = proj.shape
    q = rms_norm(proj[..., OFF_Q:OFF_K].reshape(B, L, ATT_HEADS, HEAD_DIM), lp['q_gain'])
    k = rms_norm(proj[..., OFF_K:OFF_V].reshape(B, L, ATT_KV_HEADS, HEAD_DIM), lp['k_gain'])
    v = proj[..., OFF_V:OFF_ATT_GATE].reshape(B, L, ATT_KV_HEADS, HEAD_DIM)
    q = apply_axial_rope(q, rope)
    k = apply_axial_rope(k, rope)
    att = block_attention(q, jnp.concatenate([kc, k], axis=1), jnp.concatenate([vc, v], axis=1))
    hy = hyena_branch(proj[..., OFF_HY:OFF_HY_GATE], lp)
    gm = gmlp_branch(proj[..., OFF_GM:OFF_GM_GATE], lp)
    return gated_merge(proj, hy, att, gm, lp)


def context_mixer(projc, kc, vc, lp):
    B, C, _ = projc.shape
    q = rms_norm(projc[..., OFF_Q:OFF_K].reshape(B, C, ATT_HEADS, HEAD_DIM), lp['q_gain'])
    att = block_attention(q, kc, vc)
    hy = hyena_branch(projc[..., OFF_HY:OFF_HY_GATE], lp)
    gm = gmlp_branch(projc[..., OFF_GM:OFF_GM_GATE], lp)
    return gated_merge(projc, hy, att, gm, lp)


def hybrid_layer(x, xc, c, c_ctx, rope, lp, ctx_out):
    D = D_MODEL
    w_mod, b_mod = lp['w_mod'], lp['b_mod']
    mod = jax.nn.silu(c) @ w_mod + b_mod
    shift, scale, gate = jnp.split(mod[:, None, :], 3, axis=-1)
    h = rms_norm(x, lp['g_pre']) * (1 + scale) + shift
    n_mod = 3 * D if ctx_out else 2 * D
    mc = jax.nn.silu(c_ctx) @ w_mod[:, :n_mod] + b_mod[:n_mod]
    hc = rms_norm(xc, lp['g_pre']) * (1 + mc[D:2 * D]) + mc[:D]

    w_in = lp['w_in']
    proj = h @ w_in
    B, C, _ = hc.shape
    if ctx_out:
        projc = hc @ w_in
        kvc = projc[..., OFF_K:OFF_ATT_GATE]
    else:
        kvc = hc @ w_in[:, OFF_K:OFF_ATT_GATE]
    kc = rms_norm(kvc[..., :KV_WIDTH].reshape(B, C, ATT_KV_HEADS, HEAD_DIM), lp['k_gain'])
    vc = kvc[..., KV_WIDTH:].reshape(B, C, ATT_KV_HEADS, HEAD_DIM)

    y = latent_mixer(proj, kc, vc, rope, lp)
    x_new = x + gate * rms_norm(y, lp['g_post'])
    if ctx_out:
        yc = context_mixer(projc, kc, vc, lp)
        xc_new = xc + mc[2 * D:] * rms_norm(yc, lp['g_post'])
    else:
        xc_new = xc
    return x_new, xc_new


def setup_inputs(seed: int = 0) -> dict:
    key = jax.random.key(seed)
    ks = jax.random.split(key, 32)
    f32 = jnp.float32
    D = D_MODEL
    H = HY_FILTER_HIDDEN

    def nrm(k, shape, s):
        return s * jax.random.normal(k, shape, f32)

    return {
        'x': nrm(ks[0], (BATCH, SEQ, D), 1.0),
        'c': nrm(ks[1], (BATCH, D), 1.0),
        'ctx': nrm(ks[2], (BATCH, CTX_LEN, D), 1.0),
        'c_ctx': nrm(ks[3], (D,), 1.0),
        'w_mod': nrm(ks[4], (DEPTH, D, 3 * D), 0.5 * D ** -0.5),
        'b_mod': nrm(ks[5], (DEPTH, 3 * D), 0.01),
        'g_pre': 1.0 + nrm(ks[6], (DEPTH, D), 0.02),
        'g_post': 1.0 + nrm(ks[7], (DEPTH, D), 0.02),
        'w_in': nrm(ks[8], (DEPTH, D, IN_WIDTH), D ** -0.5),
        'hy_conv_w': nrm(ks[9], (DEPTH, SHORT_CONV, (HY_ORDER + 1) * HY_WIDTH), SHORT_CONV ** -0.5),
        'hy_conv_b': nrm(ks[10], (DEPTH, (HY_ORDER + 1) * HY_WIDTH), 0.01),
        'hy_w1': nrm(ks[11], (DEPTH, HY_EMB, H), HY_EMB ** -0.5),
        'hy_b1': nrm(ks[12], (DEPTH, H), 0.1),
        'hy_w2': nrm(ks[13], (DEPTH, H, H), H ** -0.5),
        'hy_b2': nrm(ks[14], (DEPTH, H), 0.1),
        'hy_w3': nrm(ks[15], (DEPTH, H, HY_ORDER * 2 * HY_WIDTH), 0.02),
        'hy_freq': 1.0 + nrm(ks[16], (DEPTH, 2, H), 0.1),
        'hy_decay': jax.random.uniform(ks[17], (DEPTH, HY_ORDER, 2, HY_WIDTH), f32, HY_MIN_DECAY, HY_MAX_DECAY),
        'hy_bias': nrm(ks[18], (DEPTH, HY_ORDER, HY_WIDTH), 1.0),
        'q_gain': 1.0 + nrm(ks[19], (DEPTH, HEAD_DIM), 0.02),
        'k_gain': 1.0 + nrm(ks[20], (DEPTH, HEAD_DIM), 0.02),
        'gm_ln_g': 1.0 + nrm(ks[21], (DEPTH, GM_WIDTH), 0.02),
        'gm_ln_b': nrm(ks[22], (DEPTH, GM_WIDTH), 0.01),
        'gm_ws': nrm(ks[23], (DEPTH, GM_GROUPS, CHUNK, CHUNK), CHUNK ** -0.5),
        'gm_bs': 1.0 + nrm(ks[24], (DEPTH, GM_GROUPS, CHUNK), 0.01),
        'w_hy_o': nrm(ks[25], (DEPTH, HY_WIDTH, D), HY_WIDTH ** -0.5),
        'w_att_o': nrm(ks[26], (DEPTH, ATT_WIDTH, D), ATT_WIDTH ** -0.5),
        'w_gm_o': nrm(ks[27], (DEPTH, GM_WIDTH, D), GM_WIDTH ** -0.5),
        'w_out': nrm(ks[28], (DEPTH, D, D), D ** -0.5),
    }


def reference(x, c, ctx, c_ctx, w_mod, b_mod, g_pre, g_post, w_in, hy_conv_w, hy_conv_b,
              hy_w1, hy_b1, hy_w2, hy_b2, hy_w3, hy_freq, hy_decay, hy_bias, q_gain, k_gain,
              gm_ln_g, gm_ln_b, gm_ws, gm_bs, w_hy_o, w_att_o, w_gm_o, w_out):
    ROWS = x.shape[1] // GRID_W
    rope = axial_rope_tables(ROWS)
    xc = ctx
    for i in range(DEPTH):
        lp = {
            'w_mod': w_mod[i], 'b_mod': b_mod[i], 'g_pre': g_pre[i], 'g_post': g_post[i],
            'w_in': w_in[i], 'hy_conv_w': hy_conv_w[i], 'hy_conv_b': hy_conv_b[i],
            'hy_w1': hy_w1[i], 'hy_b1': hy_b1[i], 'hy_w2': hy_w2[i], 'hy_b2': hy_b2[i],
            'hy_w3': hy_w3[i], 'hy_freq': hy_freq[i], 'hy_decay': hy_decay[i], 'hy_bias': hy_bias[i],
            'q_gain': q_gain[i], 'k_gain': k_gain[i], 'gm_ln_g': gm_ln_g[i], 'gm_ln_b': gm_ln_b[i],
            'gm_ws': gm_ws[i], 'gm_bs': gm_bs[i], 'w_hy_o': w_hy_o[i], 'w_att_o': w_att_o[i],
            'w_gm_o': w_gm_o[i], 'w_out': w_out[i],
        }
        x, xc = hybrid_layer(x, xc, c, c_ctx, rope, lp, i < DEPTH - 1)
    return x
```

```cpp
#include <hip/hip_runtime.h>
#include <hip/hip_bf16.h>
#include <hip/hip_cooperative_groups.h>
#include <cstdio>
#include <cstdint>
#include <cmath>
namespace cg = cooperative_groups;

constexpr int DM = 1024, NBATCH = 8, SEQL = 4096, CTXL = 256;
constexpr int ML = NBATCH * SEQL, MC = NBATCH * CTXL, MT = ML + MC;
constexpr int NKEY = CTXL + SEQL;
constexpr int INW = 12800;
#define LAS __attribute__((address_space(3)))
namespace pg8 {
#define PG8_LAS __attribute__((address_space(3)))
typedef unsigned short bf16_t;
typedef short bf16x8 __attribute__((ext_vector_type(8)));
typedef float f32x4 __attribute__((ext_vector_type(4)));
typedef unsigned u32x4 __attribute__((ext_vector_type(4)));
constexpr int BM = 256, BK = 64, HALF = 128, HTB = HALF * BK * 2  , STAGE_BYTES = 8 * HTB, NXCD = 8, WGM = 8;

__host__ __device__ __forceinline__ int lds_byte(int r, int c) { const int st = (r >> 4) * 2 + (c >> 5), rr = r & 15, cc = c & 31, ob = rr * 64 + cc * 2; return st * 1024 + (ob ^ (((ob >> 9) & 1) << 5)); }
__host__ __device__ __forceinline__ void stage_rc(int b, int& R, int& C) { const int st = b / 1024, sb = b % 1024, swz = sb ^ (((sb >> 9) & 1) << 5); R = (st >> 1) * 16 + swz / 64; C = (st & 1) * 32 + (swz % 64) / 2; }
__host__ __device__ __forceinline__ int perm32(int rho) { const int n = rho >> 4, i = rho & 15; return 8 * (i >> 2) + 4 * n + (i & 3); }

struct Unit { int pm, pn; };
struct Gemm { const bf16_t* A; const bf16_t* Bt; int M, N, K; };

struct StaticOrder {
    int nM, nN, nwg, G, c;
    __host__ __device__ void init(int M, int N, int G_, int c_) { nM = M / BM; nN = N / BM; nwg = nM * nN; G = G_; c = c_; }
    __host__ __device__ bool next(int i, Unit& u) const {
        const long L = (long)i * G + c; if (L >= nwg) return false;
        int wgid = (int)L; { const int q = nwg / NXCD, r = nwg % NXCD, xcd = wgid % NXCD, off = wgid / NXCD; wgid = (xcd < r ? xcd * (q + 1) : r * (q + 1) + (xcd - r) * q) + off; }
        const int nig = WGM * nN, gid = wgid / nig, fm = gid * WGM, gsz = (nM - fm) < WGM ? (nM - fm) : WGM;
        u.pm = fm + ((wgid % nig) % gsz); u.pn = (wgid % nig) / gsz; return true;
    }
    __device__ __forceinline__ void a_ready(const Unit&) const {}
    __device__ __forceinline__ void done(const Unit&) const {}
};

__device__ __forceinline__ unsigned cvt_pk_bf16(float lo, float hi) { unsigned r; asm volatile("v_cvt_pk_bf16_f32 %0, %1, %2" : "=v"(r) : "v"(lo), "v"(hi)); return r; }
typedef float f32x2 __attribute__((ext_vector_type(2)));
__device__ __forceinline__ f32x2 gelu_pk(f32x2 v) {
    const f32x2 av = __builtin_elementwise_abs(v), d = av * 0.2316418882f + 1.0f;
    f32x2 t; t.x = __builtin_amdgcn_rcpf(d.x); t.y = __builtin_amdgcn_rcpf(d.y);
    f32x2 q = t * 0.5307027145f + (-0.7265760135f); q = q * t + 0.7107068705f; q = q * t + (-0.142248368f); q = q * t + 0.127414796f; q = q * t;
    const f32x2 s = (v * v) * (-0.72134752044f);
    f32x2 e; e.x = __builtin_amdgcn_exp2f(s.x); e.y = __builtin_amdgcn_exp2f(s.y);
    const f32x2 m = v * (q * e), r = v - m;
    f32x2 o; o.x = v.x < 0.f ? m.x : r.x; o.y = v.y < 0.f ? m.y : r.y; return o;
}

enum { ACT_NONE = 0, ACT_SILU = 1, ACT_SIGM = 2, ACT_GELU = 3 };
template <int ACT> __device__ __forceinline__ f32x4 act4(f32x4 v) {
    if constexpr (ACT == ACT_NONE) return v;
    else if constexpr (ACT == ACT_GELU) { f32x2 a = gelu_pk((f32x2){v[0], v[1]}), b = gelu_pk((f32x2){v[2], v[3]}); return (f32x4){a.x, a.y, b.x, b.y}; }
    else { f32x4 o;
#pragma unroll
        for (int i = 0; i < 4; ++i) { const float e = __builtin_amdgcn_exp2f(v[i] * -1.4426950408889634f); const float s = __builtin_amdgcn_rcpf(1.0f + e); o[i] = (ACT == ACT_SILU) ? v[i] * s : s; }
        return o; }
}
template <int ACT> __device__ __forceinline__ void store_tile_bf16(const f32x4 (&acc)[2][2][4][2], bf16_t* base, size_t ldc, int wr, int wc, int fr, int fq) {
    asm volatile("" : "+v"(fr), "+v"(fq));
#pragma unroll
    for (int ai = 0; ai < 2; ++ai)
#pragma unroll
        for (int m = 0; m < 4; ++m) { bf16_t* rowp = base + (size_t)(ai * HALF + wr * 64 + m * 16 + fr) * ldc + wc * 32 + 8 * fq;
#pragma unroll
            for (int bj = 0; bj < 2; ++bj) { const f32x4 v0 = act4<ACT>(acc[ai][bj][m][0]), v1 = act4<ACT>(acc[ai][bj][m][1]);
                u32x4 w; w.x = cvt_pk_bf16(v0[0], v0[1]); w.y = cvt_pk_bf16(v0[2], v0[3]); w.z = cvt_pk_bf16(v1[0], v1[1]); w.w = cvt_pk_bf16(v1[2], v1[3]);
                *(u32x4*)(rowp + bj * HALF) = w; }
            asm volatile("" ::: "memory"); __builtin_amdgcn_sched_barrier(0); }
}
__device__ __forceinline__ void store_tile_rt(const f32x4 (&acc)[2][2][4][2], bf16_t* base, size_t ldc, int wr, int wc, int fr, int fq, int act) {
    asm volatile("" : "+v"(fr), "+v"(fq));
    const bool is_none = (act == ACT_NONE), is_silu = (act == ACT_SILU);
#pragma unroll
    for (int ai = 0; ai < 2; ++ai)
#pragma unroll
        for (int m = 0; m < 4; ++m) { bf16_t* rowp = base + (size_t)(ai * HALF + wr * 64 + m * 16 + fr) * ldc + wc * 32 + 8 * fq;
#pragma unroll
            for (int bj = 0; bj < 2; ++bj) { float o[8];
#pragma unroll
                for (int i = 0; i < 8; ++i) { const float x = acc[ai][bj][m][i >> 2][i & 3]; const float e = __builtin_amdgcn_exp2f(x * -1.4426950408889634f); const float sg = __builtin_amdgcn_rcpf(1.0f + e);
                    o[i] = is_none ? x : (is_silu ? x * sg : sg); }
                u32x4 w; w.x = cvt_pk_bf16(o[0], o[1]); w.y = cvt_pk_bf16(o[2], o[3]); w.z = cvt_pk_bf16(o[4], o[5]); w.w = cvt_pk_bf16(o[6], o[7]);
                *(u32x4*)(rowp + bj * HALF) = w; }
            asm volatile("" ::: "memory"); __builtin_amdgcn_sched_barrier(0); }
}
template <int mode> struct EpiIn {
    static constexpr bool PERM = true, AFTER_DRAIN = false;
    bf16_t *p0, *p1, *p2, *p3;
    __device__ __forceinline__ void operator()(f32x4 (&acc)[2][2][4][2], const Unit& u, int wr, int wc, int fr, int fq) const {
        bf16_t* base; size_t ldc = 1024; int act, ct;
        if (mode == 0) { if (u.pn < 4) { base = p0; act = ACT_SILU; ct = u.pn; } else { base = p1; act = ACT_SIGM; ct = u.pn - 4; } }
        else if (mode == 1) {
            if (u.pn < 4) { base = p0; act = ACT_NONE; ct = u.pn; }
            else if (u.pn < 6) { base = p1; act = ACT_NONE; ct = u.pn - 4; ldc = 512; }
            else if (u.pn < 10) { base = p2; act = ACT_SILU; ct = u.pn - 6; }
            else { base = p3; act = ACT_SIGM; ct = u.pn - 10; } }
        else { if (u.pn < 4) { base = p0; act = ACT_GELU; ct = u.pn; } else if (u.pn < 8) { base = p1; act = ACT_SILU; ct = u.pn - 4; } else { base = p2; act = ACT_SIGM; ct = u.pn - 8; } }
        base += (size_t)u.pm * BM * ldc + ct * BM;
        if (mode == 2 && act == ACT_GELU) store_tile_bf16<ACT_GELU>(acc, base, ldc, wr, wc, fr, fq);
        else store_tile_rt(acc, base, ldc, wr, wc, fr, fq, act);
    }
};
template <bool GELU> struct EpiT {
    static constexpr bool PERM = true, AFTER_DRAIN = false;
    bf16_t* O; int ldc; float* statp;
    __device__ __forceinline__ void operator()(f32x4 (&acc)[2][2][4][2], const Unit& u, int wr, int wc, int fr, int fq) const {
        asm volatile("" : "+v"(fr), "+v"(fq));
        bf16_t* base = O + (size_t)u.pm * BM * ldc + (size_t)u.pn * BM;
        if constexpr (!GELU) { store_tile_bf16<ACT_NONE>(acc, base, ldc, wr, wc, fr, fq); return; } else {
#pragma unroll
        for (int ai = 0; ai < 2; ++ai)
#pragma unroll
            for (int bj = 0; bj < 2; ++bj)
#pragma unroll
                for (int m = 0; m < 4; ++m)
#pragma unroll
                    for (int n = 0; n < 2; ++n) acc[ai][bj][m][n] = act4<ACT_GELU>(acc[ai][bj][m][n]);
        store_tile_bf16<ACT_NONE>(acc, base, ldc, wr, wc, fr, fq);
        const int part = u.pm * 2 + wr;
#pragma unroll
        for (int bj = 0; bj < 2; ++bj)
#pragma unroll
            for (int n = 0; n < 2; ++n) {
                f32x4 s = (f32x4){0.f, 0.f, 0.f, 0.f}, q = s;
#pragma unroll
                for (int ai = 0; ai < 2; ++ai)
#pragma unroll
                    for (int m = 0; m < 4; ++m) { const f32x4 x = acc[ai][bj][m][n]; s += x; q += x * x; }
#pragma unroll
                for (int c = 0; c < 4; ++c) {
                    float a = s[c], b = q[c];
                    a += __shfl_xor(a, 1); b += __shfl_xor(b, 1); a += __shfl_xor(a, 2); b += __shfl_xor(b, 2);
                    a += __shfl_xor(a, 4); b += __shfl_xor(b, 4); a += __shfl_xor(a, 8); b += __shfl_xor(b, 8);
                    s[c] = a; q[c] = b; }
                if (fr == 0) { const int tok = u.pn * BM + bj * HALF + wc * 32 + 8 * fq + 4 * n; float* sp = statp + ((size_t)part * ldc + tok) * 2;
                    *(f32x4*)(sp) = (f32x4){s[0], q[0], s[1], q[1]}; *(f32x4*)(sp + 4) = (f32x4){s[2], q[2], s[3], q[3]}; }
            }
        }
    }
};
__device__ __forceinline__ float bflo(unsigned w) { return __uint_as_float(w << 16); }
__device__ __forceinline__ float bfhi(unsigned w) { return __uint_as_float(w & 0xffff0000u); }
struct EpiS {
    static constexpr bool PERM = true, AFTER_DRAIN = false;
    const bf16_t* G; bf16_t* S; int first;
    __device__ __forceinline__ void operator()(f32x4 (&acc)[2][2][4][2], const Unit& u, int wr, int wc, int fr, int fq) const {
        asm volatile("" : "+v"(fr), "+v"(fq));
#pragma unroll
        for (int ai = 0; ai < 2; ++ai)
#pragma unroll
            for (int m = 0; m < 4; ++m) { const size_t off = (size_t)(u.pm * BM + ai * HALF + wr * 64 + m * 16 + fr) * 1024 + u.pn * BM + wc * 32 + 8 * fq;
#pragma unroll
                for (int bj = 0; bj < 2; ++bj) { const u32x4 g = *(const u32x4*)(G + off + bj * HALF); u32x4 sv = (u32x4){0u, 0u, 0u, 0u}; if (!first) sv = *(const u32x4*)(S + off + bj * HALF);
                    const f32x4 a0 = acc[ai][bj][m][0], a1 = acc[ai][bj][m][1]; u32x4 w;
                    w.x = cvt_pk_bf16(bflo(sv.x) + bflo(g.x) * a0[0], bfhi(sv.x) + bfhi(g.x) * a0[1]);
                    w.y = cvt_pk_bf16(bflo(sv.y) + bflo(g.y) * a0[2], bfhi(sv.y) + bfhi(g.y) * a0[3]);
                    w.z = cvt_pk_bf16(bflo(sv.z) + bflo(g.z) * a1[0], bfhi(sv.z) + bfhi(g.z) * a1[1]);
                    w.w = cvt_pk_bf16(bflo(sv.w) + bflo(g.w) * a1[2], bfhi(sv.w) + bfhi(g.w) * a1[3]);
                    *(u32x4*)(S + off + bj * HALF) = w; } }
    }
};
struct EpiY {
    static constexpr bool PERM = true, AFTER_DRAIN = false;
    float* Y; float* ysq; int ldm;
    __device__ __forceinline__ void operator()(f32x4 (&acc)[2][2][4][2], const Unit& u, int wr, int wc, int fr, int fq) const {
        asm volatile("" : "+v"(fr), "+v"(fq));
#pragma unroll
        for (int ai = 0; ai < 2; ++ai)
#pragma unroll
            for (int m = 0; m < 4; ++m) { const int row = u.pm * BM + ai * HALF + wr * 64 + m * 16 + fr; float* rowp = Y + (size_t)row * 1024 + u.pn * BM + wc * 32 + 8 * fq; float q = 0.f;
#pragma unroll
                for (int bj = 0; bj < 2; ++bj) { const f32x4 a0 = acc[ai][bj][m][0], a1 = acc[ai][bj][m][1];
                    *(f32x4*)(rowp + bj * HALF) = a0; *(f32x4*)(rowp + bj * HALF + 4) = a1;
                    q += (a0[0] * a0[0] + a0[1] * a0[1]) + (a0[2] * a0[2] + a0[3] * a0[3]) + (a1[0] * a1[0] + a1[1] * a1[1]) + (a1[2] * a1[2] + a1[3] * a1[3]); }
                q += __shfl_xor(q, 16); q += __shfl_xor(q, 32);
                if (fq == 0) ysq[(size_t)(u.pn * 4 + wc) * ldm + row] = q; }
    }
};
template <class Epi, class Sched, bool ALIGN_EPI = false, bool SP2 = false>
__device__ __forceinline__ void gemm_phase(PG8_LAS unsigned char* lds, const Gemm g, const Sched& S, const Epi& E) {
    int tid_l = threadIdx.x; asm volatile("" : "+v"(tid_l));
    const int tid = tid_l, wid = __builtin_amdgcn_readfirstlane(tid >> 6), lane = tid & 63, wr = wid >> 2, wc = wid & 3, fr = lane & 15, fq = lane >> 4;
    const int K = g.K, nt = K / BK;
    unsigned voffA[2], voffB[2];
#pragma unroll
    for (int i = 0; i < 2; ++i) { int R, C; stage_rc(tid * 16 + i * 8192, R, C); const int Rb = Epi::PERM ? ((R & ~31) + perm32(R & 31)) : R;
        voffA[i] = (unsigned)(R * K + C) * 2u; voffB[i] = (unsigned)(Rb * K + C) * 2u; }
    const size_t kstep = (size_t)(BK * 2);
    const size_t hstep = (size_t)HALF * K * 2;
    const size_t tstep = 2 * hstep;
    const unsigned ldsw = (unsigned)wid * 1024u;
    const int aoff = lds_byte(wr * 64 + fr, fq * 8), boff = lds_byte(wc * 32 + fr, fq * 8);
#define PG8_SA(b, h) (((b) * 2 + (h)) * HTB)
#define PG8_SB(b, h) ((4 + (b) * 2 + (h)) * HTB)
#define PG8_STAGE(bufoff, gbase, voff) do { _Pragma("unroll") for (int _i = 0; _i < 2; ++_i) \
        __builtin_amdgcn_global_load_lds((const unsigned*)((const char*)(gbase) + (voff)[_i]), (PG8_LAS unsigned*)(lds + (bufoff) + ldsw + _i * 8192), 16, 0, 0); } while (0)
#define PG8_LDA(dst, b, h) do { _Pragma("unroll") for (int m = 0; m < 4; ++m) _Pragma("unroll") for (int k = 0; k < 2; ++k) dst[m][k] = *(const PG8_LAS bf16x8*)(lds + PG8_SA(b, h) + aoff + m * 2048 + k * 1024); } while (0)
#define PG8_LDB(dst, b, h) do { _Pragma("unroll") for (int n = 0; n < 2; ++n) _Pragma("unroll") for (int k = 0; k < 2; ++k) dst[n][k] = *(const PG8_LAS bf16x8*)(lds + PG8_SB(b, h) + boff + n * 2048 + k * 1024); } while (0)
#define PG8_MMA(ai, bj, At, Bt) do { __builtin_amdgcn_s_setprio(1); _Pragma("unroll") for (int m = 0; m < 4; ++m) _Pragma("unroll") for (int n = 0; n < 2; ++n) _Pragma("unroll") for (int k = 0; k < 2; ++k) \
        acc[ai][bj][m][n] = __builtin_amdgcn_mfma_f32_16x16x32_bf16(Bt[n][k], At[m][k], acc[ai][bj][m][n], 0, 0, 0); __builtin_amdgcn_s_setprio(0); } while (0)
#define PG8_WAIT_V(n) asm volatile("s_waitcnt vmcnt(" #n ")" ::: "memory")
#define PG8_WAIT_L(n) asm volatile("s_waitcnt lgkmcnt(" #n ")" ::: "memory")
#define PG8_BAR __builtin_amdgcn_s_barrier()
#define PG8_SCHED __builtin_amdgcn_sched_barrier(0)
    Unit cur, nxt; int ui = 0;
    if (!S.next(0, cur)) return;
    f32x4 acc[2][2][4][2];
#pragma unroll
    for (int a = 0; a < 2; ++a)
#pragma unroll
        for (int b = 0; b < 2; ++b)
#pragma unroll
            for (int m = 0; m < 4; ++m)
#pragma unroll
                for (int n = 0; n < 2; ++n) acc[a][b][m][n] = (f32x4){0.f, 0.f, 0.f, 0.f};
    bf16x8 At[4][2], B0[2][2], B1[2][2];
    const char* cA = (const char*)g.A + (size_t)cur.pm * tstep; const char* cB = (const char*)g.Bt + (size_t)cur.pn * tstep;
    S.a_ready(cur);
    if constexpr (SP2) {
        PG8_STAGE(PG8_SB(0, 0), cB, voffB); PG8_STAGE(PG8_SB(0, 1), cB + hstep, voffB); PG8_STAGE(PG8_SA(0, 0), cA, voffA); PG8_STAGE(PG8_SA(0, 1), cA + hstep, voffA);
        if (wr == 1) PG8_BAR;
        PG8_WAIT_V(2); PG8_BAR;
        PG8_STAGE(PG8_SB(1, 0), cB + kstep, voffB); PG8_STAGE(PG8_SA(1, 0), cA + kstep, voffA); PG8_STAGE(PG8_SB(1, 1), cB + hstep + kstep, voffB);
        PG8_WAIT_V(6); PG8_BAR;
    } else {
        PG8_STAGE(PG8_SB(0, 0), cB, voffB); PG8_STAGE(PG8_SA(0, 0), cA, voffA); PG8_STAGE(PG8_SB(0, 1), cB + hstep, voffB); PG8_STAGE(PG8_SA(0, 1), cA + hstep, voffA);
        if (wr == 1) PG8_BAR;
        PG8_WAIT_V(4); PG8_BAR;
        PG8_STAGE(PG8_SB(1, 0), cB + kstep, voffB); PG8_STAGE(PG8_SA(1, 0), cA + kstep, voffA); PG8_STAGE(PG8_SB(1, 1), cB + hstep + kstep, voffB);
        PG8_WAIT_V(6); PG8_BAR;
    }
    for (;;) {
        const bool has_next = S.next(ui + 1, nxt);
        const char* nA = has_next ? (const char*)g.A + (size_t)nxt.pm * tstep : cA; const char* nB = has_next ? (const char*)g.Bt + (size_t)nxt.pn * tstep : cB;
        for (int t = 0; t < nt; t += 2) {
            const bool last = (t == nt - 2);
            const char* a1 = cA + (size_t)(t + 1) * kstep;
            const char* a2 = last ? nA : cA + (size_t)(t + 2) * kstep; const char* b2 = last ? nB : cB + (size_t)(t + 2) * kstep;
                        asm volatile("" : "+s"(a1), "+s"(a2), "+s"(b2));
            const char* a3 = a2 + kstep; const char* b3 = b2 + kstep; asm volatile("" : "+s"(a3), "+s"(b3));
            if (last && has_next) S.a_ready(nxt);
            if constexpr (SP2) {
            PG8_LDB(B0, 0, 0); PG8_LDB(B1, 0, 1); PG8_SCHED; PG8_LDA(At, 0, 0); PG8_STAGE(PG8_SA(1, 1), a1 + hstep, voffA);
            PG8_WAIT_V(8); PG8_WAIT_L(0); PG8_BAR; PG8_MMA(0, 0, At, B0); PG8_MMA(0, 1, At, B1); PG8_BAR; PG8_SCHED;
            PG8_LDA(At, 0, 1); PG8_STAGE(PG8_SB(0, 0), b2, voffB); PG8_STAGE(PG8_SB(0, 1), b2 + hstep, voffB); PG8_STAGE(PG8_SA(0, 0), a2, voffA);
            PG8_WAIT_V(8); PG8_WAIT_L(0); PG8_BAR; PG8_MMA(1, 0, At, B0); PG8_MMA(1, 1, At, B1); PG8_BAR; PG8_SCHED;
            PG8_LDB(B0, 1, 0); PG8_LDB(B1, 1, 1); PG8_SCHED; PG8_LDA(At, 1, 0); PG8_STAGE(PG8_SA(0, 1), a2 + hstep, voffA);
            PG8_WAIT_V(8); PG8_WAIT_L(0); PG8_BAR; PG8_MMA(0, 0, At, B0); PG8_MMA(0, 1, At, B1); PG8_BAR; PG8_SCHED;
            PG8_LDA(At, 1, 1); PG8_STAGE(PG8_SB(1, 0), b3, voffB); PG8_STAGE(PG8_SB(1, 1), b3 + hstep, voffB); PG8_STAGE(PG8_SA(1, 0), a3, voffA);
            PG8_WAIT_V(8); PG8_WAIT_L(0); PG8_BAR; PG8_MMA(1, 0, At, B0); PG8_MMA(1, 1, At, B1); PG8_BAR; PG8_SCHED;
            } else {
            PG8_LDB(B0, 0, 0); PG8_SCHED; PG8_LDA(At, 0, 0); PG8_STAGE(PG8_SA(1, 1), a1 + hstep, voffA);
            PG8_WAIT_L(8); PG8_BAR; PG8_WAIT_L(0); PG8_MMA(0, 0, At, B0); PG8_BAR; PG8_SCHED;
            PG8_LDB(B1, 0, 1); PG8_STAGE(PG8_SB(0, 0), b2, voffB);
            PG8_BAR; PG8_WAIT_L(0); PG8_MMA(0, 1, At, B1); PG8_BAR;
            PG8_LDA(At, 0, 1); PG8_STAGE(PG8_SA(0, 0), a2, voffA);
            PG8_BAR; PG8_WAIT_L(0); PG8_MMA(1, 0, At, B0); PG8_BAR; PG8_SCHED;
            PG8_STAGE(PG8_SB(0, 1), b2 + hstep, voffB);
            PG8_WAIT_V(6); PG8_BAR; PG8_MMA(1, 1, At, B1); PG8_BAR;
            PG8_LDB(B0, 1, 0); PG8_SCHED; PG8_LDA(At, 1, 0); PG8_STAGE(PG8_SA(0, 1), a2 + hstep, voffA);
            PG8_WAIT_L(8); PG8_BAR; PG8_WAIT_L(0); PG8_MMA(0, 0, At, B0); PG8_BAR; PG8_SCHED;
            PG8_LDB(B1, 1, 1); PG8_STAGE(PG8_SB(1, 0), b3, voffB);
            PG8_BAR; PG8_WAIT_L(0); PG8_MMA(0, 1, At, B1); PG8_BAR;
            PG8_LDA(At, 1, 1); PG8_STAGE(PG8_SA(1, 0), a3, voffA);
            PG8_BAR; PG8_WAIT_L(0); PG8_MMA(1, 0, At, B0); PG8_BAR; PG8_SCHED;
            PG8_STAGE(PG8_SB(1, 1), b3 + hstep, voffB);
            PG8_WAIT_V(6); PG8_BAR; PG8_MMA(1, 1, At, B1); PG8_BAR;
            }
        }
        if constexpr (ALIGN_EPI) { if (wr == 0) PG8_BAR; }
        if constexpr (!Epi::AFTER_DRAIN) { E(acc, cur, wr, wc, fr, fq); S.done(cur); }
        if (!has_next) break;
#pragma unroll
        for (int a = 0; a < 2; ++a)
#pragma unroll
            for (int b = 0; b < 2; ++b)
#pragma unroll
                for (int m = 0; m < 4; ++m)
#pragma unroll
                    for (int n = 0; n < 2; ++n) acc[a][b][m][n] = (f32x4){0.f, 0.f, 0.f, 0.f};
        cur = nxt; cA = nA; cB = nB; ++ui;
        if constexpr (ALIGN_EPI) { if (wr == 1) PG8_BAR; }
    }
    PG8_WAIT_V(0);
    if constexpr (!ALIGN_EPI) { if (wr == 0) PG8_BAR; }
    PG8_BAR;
    if constexpr (Epi::AFTER_DRAIN) { E.fused(acc, cur, wr, wc, fr, fq, lds, wid, lane); S.done(cur); }
#undef PG8_SA
#undef PG8_SB
#undef PG8_STAGE
#undef PG8_LDA
#undef PG8_LDB
#undef PG8_MMA
#undef PG8_WAIT_V
#undef PG8_WAIT_L
#undef PG8_BAR
#undef PG8_SCHED
}
}
namespace attn {
using bf16 = __hip_bfloat16;
constexpr int   D = 128, NW = 8, QBLK = 32, KVBLK = 64;
constexpr float SCALE = 0.088388347648318440f;
constexpr float THR = 8.f;
constexpr int SDEPTH = 2;
constexpr int LDQ = 1024, LDK = 256, LDO = 1024;
constexpr size_t SHM_V = KVBLK * D * 2, SHM_K = KVBLK * D * 2, SHM_ATTN = 2 * SHM_V + 2 * SHM_K + NW * 64 * 4;
using bf16x8 = __attribute__((ext_vector_type(8))) short;
using s16x4  = __attribute__((ext_vector_type(4))) short;
using f32x16 = __attribute__((ext_vector_type(16))) float;
using f32x8  = __attribute__((ext_vector_type(8))) float;
using u32x4  = __attribute__((ext_vector_type(4))) unsigned;
#define KSWZ(row, colB) ((row) * 256 + ((colB) ^ (((row) & 7) << 4)))
#define SBAR() __builtin_amdgcn_sched_barrier(0)
__device__ __forceinline__ int crow(int r, int hi) { return (r & 3) + 8 * (r >> 2) + 4 * hi; }
__device__ __forceinline__ unsigned cvtpk(float lo, float hi) {
  unsigned r; asm volatile("v_cvt_pk_bf16_f32 %0, %1, %2" : "=v"(r) : "v"(lo), "v"(hi)); return r;
}
template <typename TIn> struct Stage;
template <> struct Stage<bf16>  { using T = bf16x8;
  __device__ static __forceinline__ T ld8(const bf16* p) { return *reinterpret_cast<const bf16x8*>(p); }
  __device__ static __forceinline__ bf16x8 tobf(T x) { return x; } };
template <> struct Stage<float> { using T = f32x8;
  __device__ static __forceinline__ T ld8(const float* p) { return *reinterpret_cast<const f32x8*>(p); }
  __device__ static __forceinline__ bf16x8 tobf(T x) {
    u32x4 w = {cvtpk(x[0], x[1]), cvtpk(x[2], x[3]), cvtpk(x[4], x[5]), cvtpk(x[6], x[7])}; return *reinterpret_cast<bf16x8*>(&w); } };

__device__ __forceinline__ void partialSM(f32x16& p0, f32x16& p1, float& m_reg, float& mn, float& alpha) {
  constexpr float C = SCALE * 1.4426950408889634f;
  float pmax = p0[0]; for (int r = 1; r < 16; ++r) pmax = fmaxf(pmax, p0[r]); for (int r = 0; r < 16; ++r) pmax = fmaxf(pmax, p1[r]);
  { auto rr = __builtin_amdgcn_permlane32_swap(__float_as_uint(pmax), __float_as_uint(pmax), false, false);
    pmax = fmaxf(__uint_as_float(rr[0]), __uint_as_float(rr[1])); }
  if (__builtin_expect(__all(pmax - m_reg <= THR / SCALE), 1)) { mn = m_reg; alpha = 1.f; }
  else { mn = fmaxf(m_reg, pmax); alpha = __builtin_amdgcn_exp2f((m_reg - mn) * C); m_reg = mn; }
  float mnC = -mn * C;
  for (int r = 0; r < 16; ++r) p0[r] = fmaf(p0[r], C, mnC); for (int r = 0; r < 16; ++r) p1[r] = fmaf(p1[r], C, mnC);
  for (int r = 0; r < 16; ++r) p0[r] = __builtin_amdgcn_exp2f(p0[r]);
}
__device__ __forceinline__ void finishSM(f32x16& p0, f32x16& p1, float alpha, float& l_reg, bf16x8& pa0, bf16x8& pa1, bf16x8& pa2, bf16x8& pa3) {
  for (int r = 0; r < 16; ++r) p1[r] = __builtin_amdgcn_exp2f(p1[r]);
  float ps = 0; for (int r = 0; r < 16; ++r) ps += p0[r]; for (int r = 0; r < 16; ++r) ps += p1[r];
  { auto rr = __builtin_amdgcn_permlane32_swap(__float_as_uint(ps), __float_as_uint(ps), false, false);
    ps = __uint_as_float(rr[0]) + __uint_as_float(rr[1]); }
  l_reg = l_reg * alpha + ps;
#define PK4(P, BASE, OUT) do { unsigned a0 = cvtpk(P[BASE + 0], P[BASE + 1]), a1 = cvtpk(P[BASE + 2], P[BASE + 3]);   \
    unsigned b0 = cvtpk(P[BASE + 4], P[BASE + 5]), b1 = cvtpk(P[BASE + 6], P[BASE + 7]);                              \
    auto r0 = __builtin_amdgcn_permlane32_swap(a0, b0, false, false); auto r1 = __builtin_amdgcn_permlane32_swap(a1, b1, false, false); \
    u32x4 w = {r0[0], r1[0], r0[1], r1[1]}; OUT = *reinterpret_cast<bf16x8*>(&w); } while (0)
  PK4(p0, 0, pa0); PK4(p0, 8, pa1); PK4(p1, 0, pa2); PK4(p1, 8, pa3);
#undef PK4
}
__device__ __forceinline__ void qkt(f32x16& p0, f32x16& p1, const bf16* Ks, const bf16x8* qr, int r32, int hi) {
  p0 = f32x16{}; p1 = f32x16{};
  for (int d0 = 0; d0 < 8; ++d0) { int cb = (d0 * 16 + hi * 8) * 2;
    bf16x8 b0 = *reinterpret_cast<const bf16x8*>((const char*)Ks + KSWZ(r32, cb));
    bf16x8 b1 = *reinterpret_cast<const bf16x8*>((const char*)Ks + KSWZ(32 + r32, cb));
    p0 = __builtin_amdgcn_mfma_f32_32x32x16_bf16(b0, qr[d0], p0, 0, 0, 0);
    p1 = __builtin_amdgcn_mfma_f32_32x32x16_bf16(b1, qr[d0], p1, 0, 0, 0); }
}
__device__ __forceinline__ int v_st(int k, int c) { const int kk = (k & ~0xC) | ((k & 4) << 1) | ((k & 8) >> 1); return ((kk >> 3) * 4 + (c >> 5)) * 512 + ((kk & 7) * 32 + (c & 31)) * 2; }
__device__ __forceinline__ int v_rd_base(int lane) { return ((lane & 3) << 3) | (((lane >> 2) & 3) << 6) | (((lane >> 4) & 1) << 5) | (((lane >> 5) & 1) << 8); }
constexpr int v_rd_off(int d0, int ks, int half) { return d0 * 512 + ks * 4096 + half * 2048; }
template <int OFF> __device__ __forceinline__ s16x4 tr_read(int vb) {
  s16x4 r; asm volatile("ds_read_b64_tr_b16 %0, %1 offset:%2" : "=&v"(r) : "v"(vb), "i"(OFF) : "memory"); return r;
}
template <int D0> __device__ __forceinline__ void pv_one(f32x16& od, int vb, bf16x8 pa0, bf16x8 pa1, bf16x8 pa2, bf16x8 pa3) {
  const s16x4 l0 = tr_read<v_rd_off(D0, 0, 0)>(vb), h0 = tr_read<v_rd_off(D0, 0, 1)>(vb), l1 = tr_read<v_rd_off(D0, 1, 0)>(vb), h1 = tr_read<v_rd_off(D0, 1, 1)>(vb);
  const s16x4 l2 = tr_read<v_rd_off(D0, 2, 0)>(vb), h2 = tr_read<v_rd_off(D0, 2, 1)>(vb), l3 = tr_read<v_rd_off(D0, 3, 0)>(vb), h3 = tr_read<v_rd_off(D0, 3, 1)>(vb);
  asm volatile("s_waitcnt lgkmcnt(0)" ::: "memory"); SBAR();
#define PK(L, H) (bf16x8){L[0], L[1], L[2], L[3], H[0], H[1], H[2], H[3]}
  od = __builtin_amdgcn_mfma_f32_32x32x16_bf16(pa0, PK(l0, h0), od, 0, 0, 0);
  od = __builtin_amdgcn_mfma_f32_32x32x16_bf16(pa1, PK(l1, h1), od, 0, 0, 0);
  od = __builtin_amdgcn_mfma_f32_32x32x16_bf16(pa2, PK(l2, h2), od, 0, 0, 0);
  od = __builtin_amdgcn_mfma_f32_32x32x16_bf16(pa3, PK(l3, h3), od, 0, 0, 0);
#undef PK
}
__device__ __forceinline__ void pv_d0(f32x16* o, int vb, bf16x8 pa0, bf16x8 pa1, bf16x8 pa2, bf16x8 pa3) {
  pv_one<0>(o[0], vb, pa0, pa1, pa2, pa3); pv_one<1>(o[1], vb, pa0, pa1, pa2, pa3); pv_one<2>(o[2], vb, pa0, pa1, pa2, pa3); pv_one<3>(o[3], vb, pa0, pa1, pa2, pa3);
}

__device__ __forceinline__ void attn_dense_body(const bf16* Qb, const bf16* __restrict__ Kh, const bf16* __restrict__ Vh,
                                                unsigned short* Ob, const unsigned short* __restrict__ Gb, int seq, char* lds) {
  using TQ = bf16;
  using St = Stage<bf16>; using SQ = Stage<TQ>;
  int tid_l = threadIdx.x; asm volatile("" : "+v"(tid_l));
  const int tid = tid_l, wid = tid >> 6, lane = tid & 63, r32 = lane & 31, hi = lane >> 5;
  bf16* V_lds = (bf16*)lds; bf16* K_lds = (bf16*)(lds + 2 * SHM_V);
  float* ws = (float*)(lds + 2 * SHM_V + 2 * SHM_K) + wid * 64; float* li_l = ws; float* al_l = ws + 32;
  float m_reg = -1e30f, l_reg = 0; f32x16 o[4] = {}; bf16x8 qr[8];
  const TQ* Qw = Qb + (long)(wid * QBLK + r32) * LDQ + hi * 8;
#pragma unroll
  for (int d0 = 0; d0 < 8; ++d0) qr[d0] = SQ::tobf(SQ::ld8(Qw + d0 * 16));
  const int sr = tid >> 4, sc = (tid & 15) * 8, vst0 = v_st(sr, sc), vst1 = v_st(32 + sr, sc);
  const int vb0 = (int)(uintptr_t)V_lds + v_rd_base(lane);
  struct { typename St::T vs0, vs1, ks0, ks1; } sr_[SDEPTH];
#define SLOAD(i, k0) do { sr_[i].vs0 = St::ld8(&Vh[(long)((k0) + sr) * LDK + sc]); sr_[i].vs1 = St::ld8(&Vh[(long)((k0) + 32 + sr) * LDK + sc]); \
    sr_[i].ks0 = St::ld8(&Kh[(long)((k0) + sr) * LDK + sc]); sr_[i].ks1 = St::ld8(&Kh[(long)((k0) + 32 + sr) * LDK + sc]); } while (0)
#define SWRITE(b, i) do { *(bf16x8*)((char*)V_lds + (b) * SHM_V + vst0) = St::tobf(sr_[i].vs0);          \
    *(bf16x8*)((char*)V_lds + (b) * SHM_V + vst1) = St::tobf(sr_[i].vs1); int kc = sc * 2;               \
    *(bf16x8*)((char*)K_lds + (b) * SHM_K + KSWZ(sr, kc)) = St::tobf(sr_[i].ks0);                       \
    *(bf16x8*)((char*)K_lds + (b) * SHM_K + KSWZ(32 + sr, kc)) = St::tobf(sr_[i].ks1); } while (0)
#define SWAIT() do { if constexpr (SDEPTH == 2) asm volatile("s_waitcnt vmcnt(4)" ::: "memory"); else asm volatile("s_waitcnt vmcnt(0)" ::: "memory"); } while (0)
#define RESC(a) do { if (__any((a) < 1.f)) { if (hi == 0) al_l[r32] = (a); asm volatile("s_waitcnt lgkmcnt(0)" ::: "memory"); \
    for (int d = 0; d < 4; ++d) for (int r = 0; r < 16; ++r) o[d][r] *= al_l[crow(r, hi)]; } } while (0)
  f32x16 pA0, pA1, pB0, pB1; float mnA, mnB, alA, alB; bf16x8 pa0, pa1, pa2, pa3; const int NT = seq / KVBLK;
  constexpr int SE = 0, SO = SDEPTH - 1;
  SLOAD(SE, 0); asm volatile("s_waitcnt vmcnt(0)" ::: "memory"); SWRITE(0, SE); __syncthreads();
  qkt(pA0, pA1, K_lds, qr, r32, hi); partialSM(pA0, pA1, m_reg, mnA, alA);
  SLOAD(SO, KVBLK); if constexpr (SDEPTH == 2) { if (2 < NT) SLOAD(SE, 2 * KVBLK); }
  SWAIT(); SWRITE(1, SO); __syncthreads();
  for (int j = 1; j + 1 < NT; j += 2) {
    SBAR(); qkt(pB0, pB1, (bf16*)((char*)K_lds + SHM_K), qr, r32, hi);
    finishSM(pA0, pA1, alA, l_reg, pa0, pa1, pa2, pa3); SBAR();
    SLOAD(SO, (j + SDEPTH) * KVBLK); SBAR();
    pv_d0(o, vb0, pa0, pa1, pa2, pa3); partialSM(pB0, pB1, m_reg, mnB, alB);
    __syncthreads(); SWAIT(); SWRITE(0, SE);
    RESC(alB); __syncthreads();
    SBAR(); qkt(pA0, pA1, K_lds, qr, r32, hi);
    finishSM(pB0, pB1, alB, l_reg, pa0, pa1, pa2, pa3); SBAR();
    if (SDEPTH == 1 || j + 3 < NT) SLOAD(SE, (j + 1 + SDEPTH) * KVBLK); SBAR();
    pv_d0(o, vb0 + (int)SHM_V, pa0, pa1, pa2, pa3); partialSM(pA0, pA1, m_reg, mnA, alA);
    __syncthreads(); SWAIT(); SWRITE(1, SO);
    RESC(alA); __syncthreads();
  }
  SBAR(); qkt(pB0, pB1, (bf16*)((char*)K_lds + SHM_K), qr, r32, hi);
  finishSM(pA0, pA1, alA, l_reg, pa0, pa1, pa2, pa3); SBAR();
  pv_d0(o, vb0, pa0, pa1, pa2, pa3); partialSM(pB0, pB1, m_reg, mnB, alB);
  __syncthreads(); RESC(alB);
  finishSM(pB0, pB1, alB, l_reg, pa0, pa1, pa2, pa3); SBAR();
  pv_d0(o, vb0 + (int)SHM_V, pa0, pa1, pa2, pa3);
  if (hi == 0) li_l[r32] = l_reg; asm volatile("s_waitcnt lgkmcnt(0)" ::: "memory");
  float rli[16];
#pragma unroll
  for (int r = 0; r < 16; ++r) rli[r] = __builtin_amdgcn_rcpf(li_l[crow(r, hi)]);
  unsigned short* Ow = Ob + (long)(wid * QBLK) * LDO; const unsigned short* Gw = Gb + (long)(wid * QBLK) * LDO;
#pragma unroll
  for (int r = 0; r < 16; ++r) { int orow = crow(r, hi); asm volatile("" ::: "memory");
#pragma unroll
    for (int d0 = 0; d0 < 4; ++d0) { const long ix = (long)orow * LDO + d0 * 32 + r32; const float g = __uint_as_float((unsigned)Gw[ix] << 16);
      const float v = o[d0][r] * rli[r] * g; unsigned u = __float_as_uint(v); u = (u + 0x7fffu + ((u >> 16) & 1u)) >> 16; Ow[ix] = (unsigned short)u; } }
#undef SLOAD
#undef SWRITE
#undef SWAIT
#undef RESC
}

#undef KSWZ
#undef SBAR
}
using pg8::bf16_t; using pg8::bf16x8; using pg8::f32x4; using pg8::u32x4;
typedef float f32x16 __attribute__((ext_vector_type(16)));
typedef unsigned u32x2 __attribute__((ext_vector_type(2)));
constexpr size_t MiB = 1u << 20;
constexpr size_t WS_MOD = 0;
constexpr size_t WS_HDN = 1 * MiB;
constexpr size_t WS_HDNC = 2 * MiB;
constexpr size_t WS_STATP = 3 * MiB;
constexpr size_t WS_YSQ = 6 * MiB;
constexpr size_t WS_WIN = 10 * MiB;
constexpr size_t WS_WHYO = 35 * MiB, WS_WATTO = 37 * MiB, WS_WGMO = 39 * MiB, WS_WOUT = 41 * MiB;
constexpr size_t WS_GMWS = 43 * MiB;
constexpr size_t WS_FILT = 44 * MiB;
constexpr size_t WS_FILTC = 76 * MiB;
constexpr size_t WS_H = 78 * MiB;
constexpr size_t UNIT = 68 * MiB;
constexpr size_t WS_R0 = 146 * MiB, WS_R1 = WS_R0 + UNIT, WS_R2 = WS_R1 + UNIT, WS_R3 = WS_R2 + UNIT, WS_R4 = WS_R3 + UNIT, WS_END = WS_R4 + UNIT;
static_assert((size_t)MT * 1024 * 2 == UNIT, "unit");
constexpr int LDS_BYTES = 147456;

__device__ __forceinline__ unsigned f2bf(float f) { unsigned u = __float_as_uint(f); return (u + 0x7fffu + ((u >> 16) & 1u)) >> 16; }
__device__ __forceinline__ float bf2f(unsigned short b) { return __uint_as_float((unsigned)b << 16); }
__device__ __forceinline__ unsigned pk2(float lo, float hi) { return pg8::cvt_pk_bf16(lo, hi); }
__device__ __forceinline__ float wave_sum(float v) {
#pragma unroll
    for (int o = 1; o < 64; o <<= 1) v += __shfl_xor(v, o);
    return v;
}
#define LDS_WAIT() asm volatile("s_waitcnt lgkmcnt(0)" ::: "memory")
__device__ __forceinline__ int crow(int r, int hi) { return (r & 3) + 8 * (r >> 2) + 4 * hi; }

struct Args { const float* in[29]; float* out; unsigned char* ws; int ph_lo, ph_hi; };
enum { I_X = 0, I_C, I_CTX, I_CCTX, I_WMOD, I_BMOD, I_GPRE, I_GPOST, I_WIN, I_HCW, I_HCB, I_HW1, I_HB1, I_HW2, I_HB2, I_HW3, I_HFREQ, I_HDECAY, I_HBIAS,
       I_QG, I_KG, I_LNG, I_LNB, I_GMWS, I_GMBS, I_WHYO, I_WATTO, I_WGMO, I_WOUT };

__device__ __forceinline__ void transpose_item(const float* W, int K, int N, bf16_t* WT, int k0, int n0, int dst_row0, LAS float* scr, int lane) {
#pragma unroll 8
    for (int i = 0; i < 32; ++i) { const int kk = 2 * i + (lane >> 5); scr[kk * 33 + (lane & 31)] = W[(size_t)(k0 + kk) * N + n0 + (lane & 31)]; }
    LDS_WAIT(); asm volatile("" ::: "memory");
    const int c = lane & 7;
#pragma unroll
    for (int j = 0; j < 4; ++j) { const int n = (lane >> 3) + 8 * j; const LAS float* s = scr + (8 * c) * 33 + n;
        u32x4 o; o.x = pk2(s[0 * 33], s[1 * 33]); o.y = pk2(s[2 * 33], s[3 * 33]); o.z = pk2(s[4 * 33], s[5 * 33]); o.w = pk2(s[6 * 33], s[7 * 33]);
        *(u32x4*)(WT + (size_t)(dst_row0 + n) * K + k0 + 8 * c) = o; }
    LDS_WAIT(); asm volatile("" ::: "memory");
}
__device__ __forceinline__ int win_remap(int src) {
    if (src < 4096) return src;
    if (src < 6656) return src + 1024;
    if (src < 7680) return src + 2048;
    if (src < 8704) return src + 4096;
    if (src < 9728) return src + 1024;
    if (src < 10752) return src - 5632;
    if (src < 11776) return src - 3072;
    return src - 1024;
}

__device__ __forceinline__ float silu_f(float x) { return x / (1.0f + __expf(-x)); }

__device__ __forceinline__ void hdn_item(const float* w1, const float* b1, const float* w2, const float* b2, const float* freq, int t, int L, float* dst, int lane) {
    const float tl = (float)t / (float)(L - 1);
    float zv = 0.f;
    if (lane == 0) zv = tl;
    else if (lane < 33) { const int jb = (lane - 1) & 15; const float band = 1e-4f + (float)jb * ((15.0f - 1e-4f) / 15.0f);
        const float ang = ((6.283185307179586f / (float)L) * (float)t) * band; zv = (lane < 17) ? cosf(ang) : -sinf(ang); }
    float a = b1[lane];
    for (int i = 0; i < 33; ++i) a += __shfl(zv, i) * w1[i * 64 + lane];
    const float h1 = sinf(freq[lane] * a);
    float a2 = b2[lane];
    for (int k = 0; k < 64; ++k) a2 += __shfl(h1, k) * w2[k * 64 + lane];
    dst[t * 64 + lane] = sinf(freq[64 + lane] * a2);
}
__device__ __forceinline__ void filt_item(const float* hdn, const float* w3, const float* decay, int o, int t0, int c0, int L, bf16_t* F, int lane) {
    const int c = c0 + lane;
    float af[8], ab[8];
#pragma unroll
    for (int i = 0; i < 8; ++i) { af[i] = 0.f; ab[i] = 0.f; }
    for (int k = 0; k < 64; ++k) {
        const float wf = w3[(size_t)k * 4096 + o * 2048 + c], wb = w3[(size_t)k * 4096 + o * 2048 + 1024 + c];
#pragma unroll
        for (int i = 0; i < 8; ++i) { const float hv = hdn[(t0 + i) * 64 + k]; af[i] += hv * wf; ab[i] += hv * wb; }
    }
    const float df = fabsf(decay[o * 2048 + c]), db = fabsf(decay[o * 2048 + 1024 + c]);
#pragma unroll
    for (int i = 0; i < 8; ++i) { const int t = t0 + i; const float tl = (float)t / (float)(L - 1);
        const float vf = af[i] * expf(-tl * df), vb = ab[i] * expf(-tl * db);
        if (t == 0) F[(size_t)L * 1024 + c] = (bf16_t)f2bf(vf + vb);
        else { F[(size_t)(L + t) * 1024 + c] = (bf16_t)f2bf(vf); F[(size_t)(L - t) * 1024 + c] = (bf16_t)f2bf(vb); } }
}

__device__ __forceinline__ void h_row(const f32x4 (&v)[4], const float* gpre, const float* modr, bf16_t* hrow, int lane) {
    float s = 0.f;
#pragma unroll
    for (int j = 0; j < 4; ++j) s += (v[j].x * v[j].x + v[j].y * v[j].y) + (v[j].z * v[j].z + v[j].w * v[j].w);
    const float rn = rsqrtf(wave_sum(s) * (1.f / 1024.f) + 1e-6f);
#pragma unroll
    for (int j = 0; j < 4; ++j) { const int col = 4 * lane + 256 * j;
        const f32x4 g = *(const f32x4*)(gpre + col), sh = *(const f32x4*)(modr + col), sc = *(const f32x4*)(modr + 1024 + col);
        const f32x4 y = (v[j] * rn) * g * (sc + 1.0f) + sh;
        u32x2 w; w.x = pk2(y.x, y.y); w.y = pk2(y.z, y.w); *(u32x2*)(hrow + col) = w; }
}

template <int NTB>
__device__ __forceinline__ void lconv_unit(LAS unsigned char* lds, const bf16_t* zsrc, bool zconv, float zw0, float zw1, float zw2, float zb,
                                           const bf16_t* gsrc, float gw0, float gw1, float gw2, float gb,
                                           const bf16_t* filt, float bias, bf16_t* dst) {
    constexpr int L = 64 * NTB;
    constexpr int RS = (L + 384) * 2 + 16;
    constexpr int FOFF = 8 * RS;
    constexpr int CLB = (((2 * L + 8) * 2 + 255) / 256) * 256 + 64;
    static_assert(FOFF % 16 == 0 && FOFF + 4 * CLB <= 144 * 1024, "lconv LDS");
    int tid_l = threadIdx.x; asm volatile("" : "+v"(tid_l));
    const int tid = tid_l, lane = tid & 63, wid = __builtin_amdgcn_readfirstlane(tid >> 6);
    const int n = lane & 31, h = lane >> 5;
    if (tid < 384) { const int b = tid / 48, j = tid % 48; const int off = b * RS + (j < 24 ? j * 16 : (192 + L) * 2 + (j - 24) * 16);
        *(LAS u32x4*)(lds + off) = (u32x4){0u, 0u, 0u, 0u}; }
    for (int i = tid; i < L; i += 512) {
        const int b = i / (L / 8), ch = i % (L / 8), s0 = ch * 8; const bf16_t* p = zsrc + (size_t)b * L + s0;
        u32x4 raw = *(const u32x4*)p;
        if (zconv) {
            float x[10];
            x[0] = (s0 > 0) ? bf2f(p[-1]) : 0.f; x[9] = (s0 + 8 < L) ? bf2f(p[8]) : 0.f;
            x[1] = pg8::bflo(raw.x); x[2] = pg8::bfhi(raw.x); x[3] = pg8::bflo(raw.y); x[4] = pg8::bfhi(raw.y);
            x[5] = pg8::bflo(raw.z); x[6] = pg8::bfhi(raw.z); x[7] = pg8::bflo(raw.w); x[8] = pg8::bfhi(raw.w);
            float y[8];
#pragma unroll
            for (int e = 0; e < 8; ++e) y[e] = zw0 * x[e] + zw1 * x[e + 1] + zw2 * x[e + 2] + zb;
            raw.x = pk2(y[0], y[1]); raw.y = pk2(y[2], y[3]); raw.z = pk2(y[4], y[5]); raw.w = pk2(y[6], y[7]);
        }
        *(LAS u32x4*)(lds + b * RS + (192 + s0) * 2) = raw;
    }
    for (int ip = tid; ip < 2 * L + 7; ip += 512) {
        const int idx = ip - 3; unsigned short v = 0;
        if (idx >= 1 && idx <= 2 * L - 1) v = filt[(size_t)idx * 1024];
#pragma unroll
        for (int s = 0; s < 4; ++s) { const int y = 2 * L + 4 - idx - s; if (y >= 0 && y < 2 * L + 8) *(LAS unsigned short*)(lds + FOFF + s * CLB + 2 * y) = v; }
    }
    __syncthreads();
    const int Tw = 8 * wid;
    f32x16 acc[2][2];
#pragma unroll
    for (int a = 0; a < 2; ++a)
#pragma unroll
        for (int c = 0; c < 2; ++c)
#pragma unroll
            for (int r = 0; r < 16; ++r) acc[a][c][r] = 0.f;
    if (Tw < NTB) {
        const int sft = (4 - (n & 3)) & 3;
        const LAS unsigned char* bp = lds + FOFF + sft * CLB + 2 * (8 * h - n - sft + L + 4);
        const LAS unsigned char* zp = lds + (n & 7) * RS + 384 + 128 * (Tw + (n >> 3)) + 16 * h;
        const int dlo = Tw - (NTB - 1), dhi = (Tw + 7 < NTB - 1) ? Tw + 7 : NTB - 1;
        for (int Dd = dlo; Dd <= dhi; ++Dd) {
            bf16x8 tf[6];
#pragma unroll
            for (int f = 0; f < 6; ++f) { const LAS unsigned char* q = bp + 32 * (f - 2 - 4 * Dd);
                const u32x2 lo = *(const LAS u32x2*)q, hi2 = *(const LAS u32x2*)(q + 8); const u32x4 w = (u32x4){lo.x, lo.y, hi2.x, hi2.y}; tf[f] = __builtin_bit_cast(bf16x8, w); }
#pragma unroll
            for (int mt = 0; mt < 2; ++mt) {
                const int Tb = Tw + 4 * mt;
                if (Tb < NTB && Dd >= Tb - (NTB - 1) && Dd <= Tb + 3) {
                    bf16x8 zf[4];
#pragma unroll
                    for (int ks = 0; ks < 4; ++ks) zf[ks] = *(const LAS bf16x8*)(zp + 512 * mt + 32 * ks - 128 * Dd);
#pragma unroll
                    for (int nt = 0; nt < 2; ++nt)
#pragma unroll
                        for (int ks = 0; ks < 4; ++ks) acc[mt][nt] = __builtin_amdgcn_mfma_f32_32x32x16_bf16(zf[ks], tf[ks - 2 * nt + 2], acc[mt][nt], 0, 0, 0);
                }
            }
        }
#pragma unroll
        for (int mt = 0; mt < 2; ++mt) {
            if (Tw + 4 * mt < NTB) {
#pragma unroll
                for (int nt = 0; nt < 2; ++nt)
#pragma unroll
                    for (int r = 0; r < 16; ++r) {
                        const int b = (r & 3) + 4 * h, Tl = r >> 2, s = 64 * (Tw + 4 * mt + Tl) + 32 * nt + n;
                        const float zc = bf2f(*(const LAS unsigned short*)(lds + b * RS + (192 + s) * 2));
                        const bf16_t* gp = gsrc + (size_t)b * L + s;
                        const float g0 = bf2f(gp[0]), gm = (s > 0) ? bf2f(gp[-1]) : 0.f, gq = (s + 1 < L) ? bf2f(gp[1]) : 0.f;
                        const float gc = gw0 * gm + gw1 * g0 + gw2 * gq + gb;
                        dst[(size_t)b * L + s] = (bf16_t)f2bf(gc * (acc[mt][nt][r] + bias * zc));
                    }
            }
        }
    }
    __syncthreads();
}
__device__ __forceinline__ void gmlp_unit(LAS unsigned char* lds, int tok0, int g, const bf16_t* vT, const float* statp, const bf16_t* gmws, const float* bs,
                                          const float* lng, const float* lnb, bf16_t* U, const bf16_t* GG) {
    int tid_l = threadIdx.x; asm volatile("" : "+v"(tid_l));
    const int tid = tid_l, lane = tid & 63, wid = __builtin_amdgcn_readfirstlane(tid >> 6), n = lane & 31, h = lane >> 5;
    LAS float* mean = (LAS float*)lds; LAS float* rstd = mean + 128;
    if (tid < 128) { float s = 0.f, q = 0.f;
#pragma unroll
        for (int p = 0; p < 8; ++p) { const float* sp = statp + ((size_t)p * MT + tok0 + tid) * 2; s += sp[0]; q += sp[1]; }
        const float mu = s * (1.f / 1024.f); const float var = fmaxf(q * (1.f / 1024.f) - mu * mu, 0.f);
        mean[tid] = mu; rstd[tid] = rsqrtf(var + 1e-5f); }
    __syncthreads();
    const int pt = wid >> 1, ctb = (wid & 1) * 2;
    f32x16 acc[2];
#pragma unroll
    for (int c = 0; c < 2; ++c)
#pragma unroll
        for (int r = 0; r < 16; ++r) acc[c][r] = 0.f;
    const bf16_t* ap = gmws + ((size_t)g * 128 + 32 * pt + n) * 128 + 8 * h;
#pragma unroll
    for (int ks = 0; ks < 8; ++ks) {
        const bf16x8 af = *(const bf16x8*)(ap + 16 * ks);
        float mu[8], rs[8];
#pragma unroll
        for (int e = 0; e < 8; ++e) { mu[e] = mean[16 * ks + 8 * h + e]; rs[e] = rstd[16 * ks + 8 * h + e]; }
#pragma unroll
        for (int ct = 0; ct < 2; ++ct) {
            const int cgl = g * 128 + 32 * (ctb + ct) + n; const float ga = lng[cgl], be = lnb[cgl];
            const u32x4 raw = *(const u32x4*)(vT + (size_t)cgl * MT + tok0 + 16 * ks + 8 * h);
            u32x4 w;
            w.x = pk2((pg8::bflo(raw.x) - mu[0]) * rs[0] * ga + be, (pg8::bfhi(raw.x) - mu[1]) * rs[1] * ga + be);
            w.y = pk2((pg8::bflo(raw.y) - mu[2]) * rs[2] * ga + be, (pg8::bfhi(raw.y) - mu[3]) * rs[3] * ga + be);
            w.z = pk2((pg8::bflo(raw.z) - mu[4]) * rs[4] * ga + be, (pg8::bfhi(raw.z) - mu[5]) * rs[5] * ga + be);
            w.w = pk2((pg8::bflo(raw.w) - mu[6]) * rs[6] * ga + be, (pg8::bfhi(raw.w) - mu[7]) * rs[7] * ga + be);
            acc[ct] = __builtin_amdgcn_mfma_f32_32x32x16_bf16(af, __builtin_bit_cast(bf16x8, w), acc[ct], 0, 0, 0);
        }
    }
#pragma unroll
    for (int ct = 0; ct < 2; ++ct)
#pragma unroll
        for (int r = 0; r < 16; ++r) {
            const int p = 32 * pt + crow(r, h); const size_t ix = (size_t)(tok0 + p) * 1024 + g * 128 + 32 * (ctb + ct) + n;
            const float y = acc[ct][r] + bs[g * 128 + p];
            U[ix] = (bf16_t)f2bf(bf2f(U[ix]) * y * bf2f(GG[ix]));
        }
    __syncthreads();
}

__device__ __forceinline__ void qk_row(int m, bf16_t* Q, const bf16_t* KV, bf16_t* Kp, bf16_t* Vp, const float* qg, const float* kg, int lane) {
    const bool lat = m < ML; int b, s;
    if (lat) { b = m >> 12; s = m & 4095; } else { b = (m - ML) >> 8; s = (m - ML) & 255; }
    const int i = lane & 31, axis = lane >> 5, d1 = axis * 64 + i, d2 = d1 + 32;
    float cs = 1.f, sn = 0.f;
    if (lat) { const float pos = (float)(axis ? (s & 63) : (s >> 6)); const float inv = powf(10000.0f, -(float)(2 * i) * (1.0f / 64.0f)); const float ang = pos * inv; cs = cosf(ang); sn = sinf(ang); }
    const float q1 = qg[d1], q2 = qg[d2], k1 = kg[d1], k2 = kg[d2];
    bf16_t* qr = Q + (size_t)m * 1024;
#pragma unroll
    for (int hh = 0; hh < 8; ++hh) {
        const float x1 = bf2f(qr[hh * 128 + d1]), x2 = bf2f(qr[hh * 128 + d2]);
        const float rn = rsqrtf(wave_sum(x1 * x1 + x2 * x2) * (1.f / 128.f) + 1e-6f);
        const float a = x1 * rn * q1, c = x2 * rn * q2;
        qr[hh * 128 + d1] = (bf16_t)f2bf(a * cs - c * sn); qr[hh * 128 + d2] = (bf16_t)f2bf(c * cs + a * sn);
    }
    const size_t krow = (size_t)b * NKEY + (lat ? CTXL + s : s);
    const bf16_t* kr = KV + (size_t)m * 512;
#pragma unroll
    for (int hh = 0; hh < 2; ++hh) {
        const float x1 = bf2f(kr[hh * 128 + d1]), x2 = bf2f(kr[hh * 128 + d2]);
        const float rn = rsqrtf(wave_sum(x1 * x1 + x2 * x2) * (1.f / 128.f) + 1e-6f);
        const float a = x1 * rn * k1, c = x2 * rn * k2;
        Kp[krow * 256 + hh * 128 + d1] = (bf16_t)f2bf(a * cs - c * sn); Kp[krow * 256 + hh * 128 + d2] = (bf16_t)f2bf(c * cs + a * sn);
    }
    *(u32x2*)(Vp + krow * 256 + lane * 4) = *(const u32x2*)(kr + 256 + lane * 4);
}

__device__ __forceinline__ void tgate_item(LAS unsigned char* lds, const bf16_t* inT, const bf16_t* gate, bf16_t* out, int tok0, int c0) {
    int tid_l = threadIdx.x; asm volatile("" : "+v"(tid_l));
    const int tid = tid_l; LAS unsigned short* t = (LAS unsigned short*)lds;
    { const int cl = tid >> 3, ch = tid & 7; const u32x4 raw = *(const u32x4*)(inT + (size_t)(c0 + cl) * MT + tok0 + ch * 8);
      LAS unsigned short* d = t + (ch * 8) * 72 + cl;
      d[0 * 72] = (unsigned short)(raw.x & 0xffff); d[1 * 72] = (unsigned short)(raw.x >> 16); d[2 * 72] = (unsigned short)(raw.y & 0xffff); d[3 * 72] = (unsigned short)(raw.y >> 16);
      d[4 * 72] = (unsigned short)(raw.z & 0xffff); d[5 * 72] = (unsigned short)(raw.z >> 16); d[6 * 72] = (unsigned short)(raw.w & 0xffff); d[7 * 72] = (unsigned short)(raw.w >> 16); }
    __syncthreads();
    { const int tl = tid >> 3, ch = tid & 7; const u32x4 v = *(const LAS u32x4*)(t + tl * 72 + ch * 8);
      const size_t ix = (size_t)(tok0 + tl) * 1024 + c0 + ch * 8; const u32x4 g = *(const u32x4*)(gate + ix); u32x4 w;
      w.x = pk2(pg8::bflo(v.x) * pg8::bflo(g.x), pg8::bfhi(v.x) * pg8::bfhi(g.x)); w.y = pk2(pg8::bflo(v.y) * pg8::bflo(g.y), pg8::bfhi(v.y) * pg8::bfhi(g.y));
      w.z = pk2(pg8::bflo(v.z) * pg8::bflo(g.z), pg8::bfhi(v.z) * pg8::bfhi(g.z)); w.w = pk2(pg8::bflo(v.w) * pg8::bflo(g.w), pg8::bfhi(v.w) * pg8::bfhi(g.w));
      *(u32x4*)(out + ix) = w; }
    __syncthreads();
}
constexpr int NPH = 16;
#ifndef PHMASK
#define PHMASK 0xffff
#endif
#define PON(k) ((PHMASK >> (k)) & 1)
__global__ void __launch_bounds__(512, 2) fwd_kernel(Args args) {
    extern __shared__ __attribute__((aligned(16))) unsigned char lds_raw[];
    LAS unsigned char* lds = (LAS unsigned char*)lds_raw;
    cg::grid_group grid = cg::this_grid();
    const int G = gridDim.x, bx = blockIdx.x;
    const int vcu = (G % 8 == 0) ? (bx % 8) * (G / 8) + bx / 8 : bx;
    const int NGW = G * 8;
    for (int gp = args.ph_lo; gp < args.ph_hi; ++gp) {
    int tid_l = threadIdx.x; asm volatile("" : "+v"(tid_l));
    const int tid = tid_l, lane = tid & 63, wave = __builtin_amdgcn_readfirstlane(tid >> 6);
    const int gw = vcu * 8 + wave;
    unsigned char* ws = args.ws; asm volatile("" : "+s"(ws));
    float* modv = (float*)(ws + WS_MOD); float* hdn = (float*)(ws + WS_HDN); float* hdnc = (float*)(ws + WS_HDNC);
    float* statp = (float*)(ws + WS_STATP); float* ysq = (float*)(ws + WS_YSQ);
    bf16_t* WIN = (bf16_t*)(ws + WS_WIN); bf16_t* WHYO = (bf16_t*)(ws + WS_WHYO); bf16_t* WATTO = (bf16_t*)(ws + WS_WATTO); bf16_t* WGMO = (bf16_t*)(ws + WS_WGMO); bf16_t* WOUT = (bf16_t*)(ws + WS_WOUT);
    bf16_t* GMWS = (bf16_t*)(ws + WS_GMWS); bf16_t* FILT = (bf16_t*)(ws + WS_FILT); bf16_t* FILTC = (bf16_t*)(ws + WS_FILTC);
    bf16_t* H = (bf16_t*)(ws + WS_H);
    bf16_t* R0 = (bf16_t*)(ws + WS_R0); bf16_t* R1 = (bf16_t*)(ws + WS_R1); bf16_t* R2 = (bf16_t*)(ws + WS_R2); bf16_t* R3 = (bf16_t*)(ws + WS_R3); bf16_t* R4 = (bf16_t*)(ws + WS_R4);
    bf16_t* KVRAW = R1; bf16_t* KP = (bf16_t*)(ws + WS_R1 + 34 * MiB); bf16_t* VP = (bf16_t*)(ws + WS_R1 + 51 * MiB);
    float* Y = (float*)(ws + WS_R0);

    {
        const int l = gp / NPH, p = gp % NPH;
        if (p == 0 && PON(0)) {
            if (l == 0) {
                for (int it = bx; it < 96; it += G) {
                    const int ll = it / 48, cb = it % 48, col = cb * 64 + lane, kb = wave * 128;
                    const float* Wm = args.in[I_WMOD] + (size_t)ll * 1024 * 3072; const float* cc = args.in[I_C]; const float* cx = args.in[I_CCTX];
                    float acc[9];
#pragma unroll
                    for (int r = 0; r < 9; ++r) acc[r] = 0.f;
                    for (int k = kb; k < kb + 128; ++k) { const float w = Wm[(size_t)k * 3072 + col];
#pragma unroll
                        for (int r = 0; r < 9; ++r) { const float cv = (r < 8) ? cc[r * 1024 + k] : cx[k]; acc[r] += silu_f(cv) * w; } }
                    LAS float* red = (LAS float*)lds;
#pragma unroll
                    for (int r = 0; r < 9; ++r) red[(wave * 9 + r) * 64 + lane] = acc[r];
                    __syncthreads();
                    for (int i = tid; i < 576; i += 512) { const int r = i >> 6, ln = i & 63; float s = args.in[I_BMOD][ll * 3072 + cb * 64 + ln];
                        for (int w8 = 0; w8 < 8; ++w8) s += red[(w8 * 9 + r) * 64 + ln];
                        modv[(size_t)(ll * 9 + r) * 3072 + cb * 64 + ln] = s; }
                    __syncthreads();
                }
            }
            LAS float* scr = (LAS float*)(lds + 4096 + wave * 16384);
            const int nhd = 4096 + (l == 0 ? 256 : 0);
            const int NIT = 6400 + 2048 + 256 + nhd;
            for (int it = gw; it < NIT; it += NGW) {
                int r = it;
                if (r < 6400) { const int kb = r / 400, nb = r % 400; transpose_item(args.in[I_WIN] + (size_t)l * 1024 * INW, 1024, INW, WIN, kb * 64, nb * 32, win_remap(nb * 32), scr, lane); continue; }
                r -= 6400;
                if (r < 2048) { const int which = r >> 9, i2 = r & 511, kb = i2 >> 5, nb = i2 & 31;
                    const float* W = args.in[which == 0 ? I_WHYO : which == 1 ? I_WATTO : which == 2 ? I_WGMO : I_WOUT] + (size_t)l * 1024 * 1024;
                    bf16_t* WT = which == 0 ? WHYO : which == 1 ? WATTO : which == 2 ? WGMO : WOUT;
                    transpose_item(W, 1024, 1024, WT, kb * 64, nb * 32, nb * 32, scr, lane); continue; }
                r -= 2048;
                if (r < 256) { const float* src = args.in[I_GMWS] + (size_t)l * 131072 + r * 512 + lane * 8; const f32x4 a = *(const f32x4*)src, b = *(const f32x4*)(src + 4);
                    u32x4 w; w.x = pk2(a.x, a.y); w.y = pk2(a.z, a.w); w.z = pk2(b.x, b.y); w.w = pk2(b.z, b.w); *(u32x4*)(GMWS + r * 512 + lane * 8) = w; continue; }
                r -= 256;
                { const float* w1 = args.in[I_HW1] + l * 33 * 64; const float* b1 = args.in[I_HB1] + l * 64; const float* w2 = args.in[I_HW2] + l * 4096; const float* b2 = args.in[I_HB2] + l * 64; const float* fq = args.in[I_HFREQ] + l * 128;
                  if (r < 4096) hdn_item(w1, b1, w2, b2, fq, r, 4096, hdn, lane); else hdn_item(w1, b1, w2, b2, fq, r - 4096, 256, hdnc, lane); }
            }
        } else if (p == 1 && PON(1)) {
            if (l == 0) {
                for (int m = gw; m < MT; m += NGW) {
                    const float* xr = (m < ML) ? args.in[I_X] + (size_t)m * 1024 : args.in[I_CTX] + (size_t)(m - ML) * 1024; const int r = (m < ML) ? (m >> 12) : 8;
                    f32x4 v[4];
#pragma unroll
                    for (int j = 0; j < 4; ++j) v[j] = *(const f32x4*)(xr + 4 * lane + 256 * j);
                    h_row(v, args.in[I_GPRE], modv + (size_t)r * 3072, H + (size_t)m * 1024, lane);
                }
            }
            const int nf = 16384 + (l == 0 ? 1024 : 0);
            const float* w3 = args.in[I_HW3] + (size_t)l * 64 * 4096; const float* dec = args.in[I_HDECAY] + l * 4096;
            for (int it = gw; it < nf; it += NGW) {
                if (it < 16384) { const int o = it >> 13, rem = it & 8191; filt_item(hdn, w3, dec, o, (rem >> 4) * 8, (rem & 15) * 64, 4096, FILT + (size_t)o * 8192 * 1024, lane); }
                else { const int i2 = it - 16384, o = i2 >> 9, rem = i2 & 511; filt_item(hdnc, w3, dec, o, (rem >> 4) * 8, (rem & 15) * 64, 256, FILTC + (size_t)o * 512 * 1024, lane); }
            }
        } else if (p == 2 && PON(2)) {
            { pg8::Gemm g{WIN, H, 3072, MT, 1024}; pg8::StaticOrder S; S.init(3072, MT, G, bx); pg8::EpiT<false> E{R0, MT, nullptr};
              pg8::gemm_phase<pg8::EpiT<false>, pg8::StaticOrder, true, true>(lds, g, S, E); }
            { pg8::Gemm g{H, WIN + (size_t)3072 * 1024, MT, 2048, 1024}; pg8::StaticOrder S; S.init(MT, 2048, G, (bx + 96) % G); pg8::EpiIn<0> E{R3, R4, nullptr, nullptr};
              pg8::gemm_phase<pg8::EpiIn<0>, pg8::StaticOrder, true, true>(lds, g, S, E); }
        } else if ((p == 3 || p == 4) && PON(3)) {
            const int o = p - 3; const int nun = 1024 + (l == 0 ? 1024 : 0);
            const float* cw = args.in[I_HCW] + (size_t)l * 3 * 3072; const float* cb = args.in[I_HCB] + (size_t)l * 3072; const float* hb = args.in[I_HBIAS] + l * 2048 + o * 1024;
            for (int u = bx; u < nun; u += G) {
                const int c = u & 1023; const bool isctx = u >= 1024; const size_t tb = isctx ? ML : 0;
                const int zc = 2048 + c, gc = (o == 0) ? c : 1024 + c;
                const bf16_t* zsrc = R2 + (size_t)c * MT + tb; const bf16_t* gsrc = (o == 0 ? R0 : R1) + (size_t)c * MT + tb; bf16_t* dst = (o == 0 ? R2 : R0) + (size_t)c * MT + tb;
                const float zw0 = cw[zc], zw1 = cw[3072 + zc], zw2 = cw[6144 + zc], zb = cb[zc];
                const float gw0 = cw[gc], gw1 = cw[3072 + gc], gw2 = cw[6144 + gc], gb = cb[gc];
                if (!isctx) lconv_unit<64>(lds, zsrc, o == 0, zw0, zw1, zw2, zb, gsrc, gw0, gw1, gw2, gb, FILT + (size_t)o * 8192 * 1024 + c, hb[c], dst);
                else lconv_unit<4>(lds, zsrc, o == 0, zw0, zw1, zw2, zb, gsrc, gw0, gw1, gw2, gb, FILTC + (size_t)o * 512 * 1024 + c, hb[c], dst);
            }
        } else if (p == 5 && PON(5)) {
            for (int it = bx; it < (MT / 64) * 16; it += G) tgate_item(lds, R0, R3, R1, (it >> 4) * 64, (it & 15) * 64);
        } else if (p == 6 && PON(6)) {
            pg8::Gemm g{R1, WHYO, MT, 1024, 1024}; pg8::StaticOrder S; S.init(MT, 1024, G, bx); pg8::EpiS E{R4, R4, 1};
            pg8::gemm_phase<pg8::EpiS, pg8::StaticOrder, true, true>(lds, g, S, E);
        } else if (p == 7 && PON(7)) {
            pg8::Gemm g{H, WIN + (size_t)5120 * 1024, MT, 3584, 1024}; pg8::StaticOrder S; S.init(MT, 3584, G, bx); pg8::EpiIn<1> E{R0, KVRAW, R2, R3};
            pg8::gemm_phase<pg8::EpiIn<1>, pg8::StaticOrder, true, true>(lds, g, S, E);
        } else if (p == 8 && PON(8)) {
            for (int m = gw; m < MT; m += NGW) qk_row(m, R0, KVRAW, KP, VP, args.in[I_QG] + l * 128, args.in[I_KG] + l * 128, lane);
        } else if (p == 9 && PON(9)) {
            const int nun = 1024 + (l == 0 ? 64 : 0);
            for (int u = vcu; u < nun; u += G) {
                if (u < 1024) { const int grp = u >> 6, b = grp >> 1, kvh = grp & 1, within = u & 63, hh = kvh * 4 + (within >> 4), qb = within & 15;
                    const size_t qo = ((size_t)(b * SEQL + qb * 256)) * 1024 + hh * 128; const size_t ko = (size_t)b * NKEY * 256 + kvh * 128;
                    attn::attn_dense_body((const attn::bf16*)(R0 + qo), (const attn::bf16*)(KP + ko), (const attn::bf16*)(VP + ko), R0 + qo, R2 + qo, NKEY, (char*)lds_raw); }
                else { const int uc = u - 1024, b = uc >> 3, hh = uc & 7, kvh = hh >> 2;
                    const size_t qo = ((size_t)(ML + b * CTXL)) * 1024 + hh * 128; const size_t ko = (size_t)b * NKEY * 256 + kvh * 128;
                    attn::attn_dense_body((const attn::bf16*)(R0 + qo), (const attn::bf16*)(KP + ko), (const attn::bf16*)(VP + ko), R0 + qo, R2 + qo, CTXL, (char*)lds_raw); }
                __syncthreads();
            }
        } else if (p == 10 && PON(10)) {
            pg8::Gemm g{R0, WATTO, MT, 1024, 1024}; pg8::StaticOrder S; S.init(MT, 1024, G, bx); pg8::EpiS E{R3, R4, 0};
            pg8::gemm_phase<pg8::EpiS, pg8::StaticOrder, true, true>(lds, g, S, E);
        } else if (p == 11 && PON(11)) {
            { pg8::Gemm g{H, WIN + (size_t)8704 * 1024, MT, 3072, 1024}; pg8::StaticOrder S; S.init(MT, 3072, G, bx); pg8::EpiIn<2> E{R0, R2, R3, nullptr};
              pg8::gemm_phase<pg8::EpiIn<2>, pg8::StaticOrder, true, true>(lds, g, S, E); }
            { pg8::Gemm g{WIN + (size_t)11776 * 1024, H, 1024, MT, 1024}; pg8::StaticOrder S; S.init(1024, MT, G, (bx + 96) % G); pg8::EpiT<true> E{R1, MT, statp};
              pg8::gemm_phase<pg8::EpiT<true>, pg8::StaticOrder, true, true>(lds, g, S, E); }
        } else if (p == 12 && PON(12)) {
            const int nun = (l == 0 ? MT / 128 : ML / 128) * 8;
            for (int u = bx; u < nun; u += G)
                gmlp_unit(lds, (u >> 3) * 128, u & 7, R1, statp, GMWS, args.in[I_GMBS] + l * 1024, args.in[I_LNG] + l * 1024, args.in[I_LNB] + l * 1024, R0, R2);
        } else if (p == 13 && PON(13)) {
            pg8::Gemm g{R0, WGMO, MT, 1024, 1024}; pg8::StaticOrder S; S.init(MT, 1024, G, bx); pg8::EpiS E{R3, R4, 0};
            pg8::gemm_phase<pg8::EpiS, pg8::StaticOrder, true, true>(lds, g, S, E);
        } else if (p == 14 && PON(14)) {
            pg8::Gemm g{R4, WOUT, MT, 1024, 1024}; pg8::StaticOrder S; S.init(MT, 1024, G, bx); pg8::EpiY E{Y, ysq, MT};
            pg8::gemm_phase<pg8::EpiY, pg8::StaticOrder, true, true>(lds, g, S, E);
        } else if (p == 15 && PON(15)) {
            const int nrow = (l == 0) ? MT : ML;
            for (int m = gw; m < nrow; m += NGW) {
                const float* yr = Y + (size_t)m * 1024; const int r = (m < ML) ? (m >> 12) : 8;
                const float* xr = (l == 0) ? ((m < ML) ? args.in[I_X] + (size_t)m * 1024 : args.in[I_CTX] + (size_t)(m - ML) * 1024) : args.out + (size_t)m * 1024;
                const float q = (lane < 16) ? ysq[(size_t)lane * MT + m] : 0.f;
                const float rn = rsqrtf(wave_sum(q) * (1.f / 1024.f) + 1e-6f);
                const float* gpo = args.in[I_GPOST] + l * 1024; const float* gt = modv + (size_t)(l * 9 + r) * 3072 + 2048;
                f32x4 v[4];
#pragma unroll
                for (int j = 0; j < 4; ++j) { const int col = 4 * lane + 256 * j;
                    const f32x4 y = *(const f32x4*)(yr + col), x = *(const f32x4*)(xr + col), gp4 = *(const f32x4*)(gpo + col), g4 = *(const f32x4*)(gt + col);
                    v[j] = x + g4 * ((y * rn) * gp4);
                    if (m < ML) *(f32x4*)(args.out + (size_t)m * 1024 + col) = v[j]; }
                if (l == 0) h_row(v, args.in[I_GPRE] + 1024, modv + (size_t)(9 + r) * 3072, H + (size_t)m * 1024, lane);
            }
        }
        if (gp + 1 < args.ph_hi) grid.sync();
    }
    }
}

extern "C" void kernel_launch(void* const* d_in, const int* in_sizes, int n_in, void* d_out, int out_size, void* d_ws, size_t ws_size, hipStream_t stream) {
    static int grid = 0;
    if (grid == 0) {
        if (n_in != 29 || out_size != ML * DM || ws_size < WS_END) { fprintf(stderr, "kernel_launch: unexpected shapes n_in %d out %d ws %zu (need %zu)\n", n_in, out_size, ws_size, (size_t)WS_END); grid = -1; return; }
        int dev = 0, cus = 0, per_cu = 0;
        hipGetDevice(&dev); hipDeviceGetAttribute(&cus, hipDeviceAttributeMultiprocessorCount, dev);
        if (hipFuncSetAttribute((const void*)fwd_kernel, hipFuncAttributeMaxDynamicSharedMemorySize, LDS_BYTES) != hipSuccess) { fprintf(stderr, "kernel_launch: hipFuncSetAttribute failed\n"); grid = -1; return; }
        if (hipOccupancyMaxActiveBlocksPerMultiprocessor(&per_cu, (const void*)fwd_kernel, 512, LDS_BYTES) != hipSuccess || per_cu < 1) { fprintf(stderr, "kernel_launch: occupancy query gave %d\n", per_cu); per_cu = 1; }
        (void)hipGetLastError();
        grid = cus * 1;
        fprintf(stderr, "kernel_launch: cus %d per_cu %d grid %d\n", cus, per_cu, grid);
    }
    if (grid < 0) return;
    Args a{};
    for (int i = 0; i < 29; ++i) a.in[i] = (const float*)d_in[i];
    a.out = (float*)d_out; a.ws = (unsigned char*)d_ws; a.ph_lo = 0; a.ph_hi = 2 * NPH;
    void* kargs[] = {&a};
    hipError_t e = hipLaunchCooperativeKernel((const void*)fwd_kernel, dim3(grid), dim3(512), kargs, LDS_BYTES, stream);
    if (e != hipSuccess) fprintf(stderr, "kernel_launch: cooperative launch failed: %s (grid %d)\n", hipGetErrorString(e), grid);
}
```

```cpp
#include <hip/hip_runtime.h>
#include <hip/hip_bf16.h>
#include <hip/hip_cooperative_groups.h>
#include <cstdio>
#include <cstdint>
#include <cmath>
namespace cg = cooperative_groups;

constexpr int DM = 1024, NBATCH = 8, SEQL = 4096, CTXL = 256;
constexpr int ML = NBATCH * SEQL, MC = NBATCH * CTXL, MT = ML + MC;
constexpr int NKEY = CTXL + SEQL;
constexpr int INW = 12800;
#define LAS __attribute__((address_space(3)))
template <int M> __device__ __forceinline__ float sx_add(float v) {
    if constexpr (M < 32) return v + __int_as_float(__builtin_amdgcn_ds_swizzle(__float_as_int(v), (M << 10) | 0x1f));
    else { auto rr = __builtin_amdgcn_permlane32_swap(__float_as_uint(v), __float_as_uint(v), false, false); return __uint_as_float(rr[0]) + __uint_as_float(rr[1]); }
}
typedef unsigned u32x4_g __attribute__((ext_vector_type(4)));
__device__ __forceinline__ u32x4_g zero4() { unsigned z = 0; asm volatile("" : "+v"(z)); return (u32x4_g){z, z, z, z}; }
namespace pg8 {
#define PG8_LAS __attribute__((address_space(3)))
typedef unsigned short bf16_t;
typedef short bf16x8 __attribute__((ext_vector_type(8)));
typedef float f32x4 __attribute__((ext_vector_type(4)));
typedef unsigned u32x4 __attribute__((ext_vector_type(4)));
constexpr int BM = 256, BK = 64, HALF = 128, HTB = HALF * BK * 2  , STAGE_BYTES = 8 * HTB, NXCD = 8, WGM = 8;

__host__ __device__ __forceinline__ int lds_byte(int r, int c) { const int st = (r >> 4) * 2 + (c >> 5), rr = r & 15, cc = c & 31, ob = rr * 64 + cc * 2; return st * 1024 + (ob ^ (((ob >> 9) & 1) << 5)); }
__host__ __device__ __forceinline__ void stage_rc(int b, int& R, int& C) { const int st = b / 1024, sb = b % 1024, swz = sb ^ (((sb >> 9) & 1) << 5); R = (st >> 1) * 16 + swz / 64; C = (st & 1) * 32 + (swz % 64) / 2; }
__host__ __device__ __forceinline__ int perm32(int rho) { const int n = rho >> 4, i = rho & 15; return 8 * (i >> 2) + 4 * n + (i & 3); }

struct Unit { int pm, pn; };
struct Gemm { const bf16_t* A; const bf16_t* Bt; int M, N, K; };

struct StaticOrder {
    int nM, nN, nwg, G, c;
    __host__ __device__ void init(int M, int N, int G_, int c_) { nM = M / BM; nN = N / BM; nwg = nM * nN; G = G_; c = c_; }
    __host__ __device__ bool next(int i, Unit& u) const {
        const long L = (long)i * G + c; if (L >= nwg) return false;
        int wgid = (int)L; { const int q = nwg / NXCD, r = nwg % NXCD, xcd = wgid % NXCD, off = wgid / NXCD; wgid = (xcd < r ? xcd * (q + 1) : r * (q + 1) + (xcd - r) * q) + off; }
        const int nig = WGM * nN, gid = wgid / nig, fm = gid * WGM, gsz = (nM - fm) < WGM ? (nM - fm) : WGM;
        u.pm = fm + ((wgid % nig) % gsz); u.pn = (wgid % nig) / gsz; return true;
    }
    __device__ __forceinline__ void a_ready(const Unit&) const {}
    __device__ __forceinline__ void done(const Unit&) const {}
};

__device__ __forceinline__ unsigned cvt_pk_bf16(float lo, float hi) { unsigned r; asm volatile("v_cvt_pk_bf16_f32 %0, %1, %2" : "=v"(r) : "v"(lo), "v"(hi)); return r; }
typedef float f32x2 __attribute__((ext_vector_type(2)));
__device__ __forceinline__ f32x2 gelu_pk(f32x2 v) {
    const f32x2 av = __builtin_elementwise_abs(v), d = av * 0.2316418882f + 1.0f;
    f32x2 t; t.x = __builtin_amdgcn_rcpf(d.x); t.y = __builtin_amdgcn_rcpf(d.y);
    f32x2 q = t * 0.5307027145f + (-0.7265760135f); q = q * t + 0.7107068705f; q = q * t + (-0.142248368f); q = q * t + 0.127414796f; q = q * t;
    const f32x2 s = (v * v) * (-0.72134752044f);
    f32x2 e; e.x = __builtin_amdgcn_exp2f(s.x); e.y = __builtin_amdgcn_exp2f(s.y);
    const f32x2 m = v * (q * e), r = v - m;
    f32x2 o; o.x = v.x < 0.f ? m.x : r.x; o.y = v.y < 0.f ? m.y : r.y; return o;
}

enum { ACT_NONE = 0, ACT_SILU = 1, ACT_SIGM = 2, ACT_GELU = 3 };
template <int ACT> __device__ __forceinline__ f32x4 act4(f32x4 v) {
    if constexpr (ACT == ACT_NONE) return v;
    else if constexpr (ACT == ACT_GELU) { f32x2 a = gelu_pk((f32x2){v[0], v[1]}), b = gelu_pk((f32x2){v[2], v[3]}); return (f32x4){a.x, a.y, b.x, b.y}; }
    else { f32x4 o;
#pragma unroll
        for (int i = 0; i < 4; ++i) { const float e = __builtin_amdgcn_exp2f(v[i] * -1.4426950408889634f); const float s = __builtin_amdgcn_rcpf(1.0f + e); o[i] = (ACT == ACT_SILU) ? v[i] * s : s; }
        return o; }
}
template <int ACT> __device__ __forceinline__ void store_tile_bf16(const f32x4 (&acc)[2][2][4][2], bf16_t* base, size_t ldc, int wr, int wc, int fr, int fq) {
    asm volatile("" : "+v"(fr), "+v"(fq));
#pragma unroll
    for (int ai = 0; ai < 2; ++ai)
#pragma unroll
        for (int m = 0; m < 4; ++m) { bf16_t* rowp = base + (size_t)(ai * HALF + wr * 64 + m * 16 + fr) * ldc + wc * 32 + 8 * fq;
#pragma unroll
            for (int bj = 0; bj < 2; ++bj) { const f32x4 v0 = act4<ACT>(acc[ai][bj][m][0]), v1 = act4<ACT>(acc[ai][bj][m][1]);
                u32x4 w; w.x = cvt_pk_bf16(v0[0], v0[1]); w.y = cvt_pk_bf16(v0[2], v0[3]); w.z = cvt_pk_bf16(v1[0], v1[1]); w.w = cvt_pk_bf16(v1[2], v1[3]);
                *(u32x4*)(rowp + bj * HALF) = w; }
            asm volatile("" ::: "memory"); __builtin_amdgcn_sched_barrier(0); }
}
__device__ __forceinline__ void store_tile_rt(const f32x4 (&acc)[2][2][4][2], bf16_t* base, size_t ldc, int wr, int wc, int fr, int fq, int act) {
    asm volatile("" : "+v"(fr), "+v"(fq));
    const bool is_none = (act == ACT_NONE), is_silu = (act == ACT_SILU);
#pragma unroll
    for (int ai = 0; ai < 2; ++ai)
#pragma unroll
        for (int m = 0; m < 4; ++m) { bf16_t* rowp = base + (size_t)(ai * HALF + wr * 64 + m * 16 + fr) * ldc + wc * 32 + 8 * fq;
#pragma unroll
            for (int bj = 0; bj < 2; ++bj) { float o[8];
#pragma unroll
                for (int i = 0; i < 8; ++i) { const float x = acc[ai][bj][m][i >> 2][i & 3]; const float e = __builtin_amdgcn_exp2f(x * -1.4426950408889634f); const float sg = __builtin_amdgcn_rcpf(1.0f + e);
                    o[i] = is_none ? x : (is_silu ? x * sg : sg); }
                u32x4 w; w.x = cvt_pk_bf16(o[0], o[1]); w.y = cvt_pk_bf16(o[2], o[3]); w.z = cvt_pk_bf16(o[4], o[5]); w.w = cvt_pk_bf16(o[6], o[7]);
                *(u32x4*)(rowp + bj * HALF) = w; }
            asm volatile("" ::: "memory"); __builtin_amdgcn_sched_barrier(0); }
}
template <int mode> struct EpiIn {
    static constexpr bool PERM = true, AFTER_DRAIN = false;
    bf16_t *p0, *p1, *p2, *p3; bf16_t* p4 = nullptr;
    __device__ __forceinline__ void operator()(f32x4 (&acc)[2][2][4][2], const Unit& u, int wr, int wc, int fr, int fq) const {
        bf16_t* base; size_t ldc = 1024; int act, ct;
        if (mode == 0) { if (u.pn < 4) { base = p0; act = ACT_SILU; ct = u.pn; } else { base = p1; act = ACT_SIGM; ct = u.pn - 4; } }
        else if (mode == 1) {
            if (u.pn < 4) { base = p0; act = ACT_NONE; ct = u.pn; }
            else if (u.pn < 6) { base = p1; act = ACT_NONE; ct = u.pn - 4; ldc = 512; }
            else if (u.pn < 10) { base = p2; act = ACT_SILU; ct = u.pn - 6; }
            else { base = (p4 && u.pm >= 128) ? p4 - (size_t)128 * BM * 1024 : p3; act = ACT_SIGM; ct = u.pn - 10; } }
        else if (mode == 3) { base = p0; act = ACT_NONE; ct = u.pn; ldc = 512; }
        else { if (u.pn < 4) { base = p0; act = ACT_GELU; ct = u.pn; } else if (u.pn < 8) { base = p1; act = ACT_SILU; ct = u.pn - 4; } else { base = p2; act = ACT_SIGM; ct = u.pn - 8; } }
        base += (size_t)u.pm * BM * ldc + ct * BM;
        if (mode == 2 && act == ACT_GELU) store_tile_bf16<ACT_GELU>(acc, base, ldc, wr, wc, fr, fq);
        else if ((mode == 1 || mode == 3) && act == ACT_NONE) store_tile_bf16<ACT_NONE>(acc, base, ldc, wr, wc, fr, fq);
        else store_tile_rt(acc, base, ldc, wr, wc, fr, fq, act);
    }
};
template <bool GELU> struct EpiT {
    static constexpr bool PERM = true, AFTER_DRAIN = false;
    bf16_t* O; int ldc; float* statp;
    __device__ __forceinline__ void operator()(f32x4 (&acc)[2][2][4][2], const Unit& u, int wr, int wc, int fr, int fq) const {
        asm volatile("" : "+v"(fr), "+v"(fq));
        bf16_t* base = O + (size_t)u.pm * BM * ldc + (size_t)u.pn * BM;
        if constexpr (!GELU) { store_tile_bf16<ACT_NONE>(acc, base, ldc, wr, wc, fr, fq); return; } else {
#pragma unroll
        for (int ai = 0; ai < 2; ++ai)
#pragma unroll
            for (int bj = 0; bj < 2; ++bj)
#pragma unroll
                for (int m = 0; m < 4; ++m)
#pragma unroll
                    for (int n = 0; n < 2; ++n) acc[ai][bj][m][n] = act4<ACT_GELU>(acc[ai][bj][m][n]);
        store_tile_bf16<ACT_NONE>(acc, base, ldc, wr, wc, fr, fq);
        const int part = u.pm * 2 + wr;
#pragma unroll
        for (int bj = 0; bj < 2; ++bj)
#pragma unroll
            for (int n = 0; n < 2; ++n) {
                f32x4 s = (f32x4){0.f, 0.f, 0.f, 0.f}, q = s;
#pragma unroll
                for (int ai = 0; ai < 2; ++ai)
#pragma unroll
                    for (int m = 0; m < 4; ++m) { const f32x4 x = acc[ai][bj][m][n]; s += x; q += x * x; }
#pragma unroll
                for (int c = 0; c < 4; ++c) {
                    float a = s[c], b = q[c];
                    a = sx_add<1>(a); b = sx_add<1>(b); a = sx_add<2>(a); b = sx_add<2>(b);
                    a = sx_add<4>(a); b = sx_add<4>(b); a = sx_add<8>(a); b = sx_add<8>(b);
                    s[c] = a; q[c] = b; }
                if (fr == 0) { const int tok = u.pn * BM + bj * HALF + wc * 32 + 8 * fq + 4 * n; float* sp = statp + ((size_t)part * ldc + tok) * 2;
                    *(f32x4*)(sp) = (f32x4){s[0], q[0], s[1], q[1]}; *(f32x4*)(sp + 4) = (f32x4){s[2], q[2], s[3], q[3]}; }
            }
        }
    }
};
__device__ __forceinline__ float bflo(unsigned w) { return __uint_as_float(w << 16); }
__device__ __forceinline__ float bfhi(unsigned w) { return __uint_as_float(w & 0xffff0000u); }
struct EpiS {
    static constexpr bool PERM = true, AFTER_DRAIN = false;
    const bf16_t* G; bf16_t* S; int first;
    __device__ __forceinline__ void operator()(f32x4 (&acc)[2][2][4][2], const Unit& u, int wr, int wc, int fr, int fq) const {
        asm volatile("" : "+v"(fr), "+v"(fq));
#pragma unroll
        for (int ai = 0; ai < 2; ++ai)
#pragma unroll
            for (int m = 0; m < 4; ++m) { const size_t off = (size_t)(u.pm * BM + ai * HALF + wr * 64 + m * 16 + fr) * 1024 + u.pn * BM + wc * 32 + 8 * fq;
#pragma unroll
                for (int bj = 0; bj < 2; ++bj) { const u32x4 g = *(const u32x4*)(G + off + bj * HALF); u32x4 sv = zero4(); if (!first) sv = *(const u32x4*)(S + off + bj * HALF);
                    const f32x4 a0 = acc[ai][bj][m][0], a1 = acc[ai][bj][m][1]; u32x4 w;
                    w.x = cvt_pk_bf16(bflo(sv.x) + bflo(g.x) * a0[0], bfhi(sv.x) + bfhi(g.x) * a0[1]);
                    w.y = cvt_pk_bf16(bflo(sv.y) + bflo(g.y) * a0[2], bfhi(sv.y) + bfhi(g.y) * a0[3]);
                    w.z = cvt_pk_bf16(bflo(sv.z) + bflo(g.z) * a1[0], bfhi(sv.z) + bfhi(g.z) * a1[1]);
                    w.w = cvt_pk_bf16(bflo(sv.w) + bflo(g.w) * a1[2], bfhi(sv.w) + bfhi(g.w) * a1[3]);
                    *(u32x4*)(S + off + bj * HALF) = w; } }
    }
};
struct EpiY {
    static constexpr bool PERM = true, AFTER_DRAIN = false;
    float* Y; float* ysq; int ldm;
    __device__ __forceinline__ void operator()(f32x4 (&acc)[2][2][4][2], const Unit& u, int wr, int wc, int fr, int fq) const {
        asm volatile("" : "+v"(fr), "+v"(fq));
#pragma unroll
        for (int ai = 0; ai < 2; ++ai)
#pragma unroll
            for (int m = 0; m < 4; ++m) { const int row = u.pm * BM + ai * HALF + wr * 64 + m * 16 + fr; float* rowp = Y + (size_t)row * 1024 + u.pn * BM + wc * 32 + 8 * fq; float q = 0.f;
#pragma unroll
                for (int bj = 0; bj < 2; ++bj) { const f32x4 a0 = acc[ai][bj][m][0], a1 = acc[ai][bj][m][1];
                    *(f32x4*)(rowp + bj * HALF) = a0; *(f32x4*)(rowp + bj * HALF + 4) = a1;
                    q += (a0[0] * a0[0] + a0[1] * a0[1]) + (a0[2] * a0[2] + a0[3] * a0[3]) + (a1[0] * a1[0] + a1[1] * a1[1]) + (a1[2] * a1[2] + a1[3] * a1[3]); }
                q = sx_add<16>(q); q = sx_add<32>(q);
                if (fq == 0) ysq[(size_t)(u.pn * 4 + wc) * ldm + row] = q; }
    }
};
struct EpiF {
    static constexpr bool PERM = true, AFTER_DRAIN = false;
    bf16_t* F; const float* decay; int L;
    __device__ __forceinline__ void operator()(f32x4 (&acc)[2][2][4][2], const Unit& u, int wr, int wc, int fr, int fq) const {
        asm volatile("" : "+v"(fr), "+v"(fq));
        const float inv = -1.4426950408889634f / (float)(L - 1);
#pragma unroll
        for (int ai = 0; ai < 2; ++ai)
#pragma unroll
            for (int m = 0; m < 4; ++m) { const int r = u.pm * BM + ai * HALF + wr * 64 + m * 16 + fr; const int o = r >> 11, dir = (r >> 10) & 1, c = r & 1023;
                const float d = fabsf(decay[r]) * inv; bf16_t* rowp = F + ((size_t)(o * 1024 + c) * 2 + dir) * L + u.pn * BM + wc * 32 + 8 * fq;
#pragma unroll
                for (int bj = 0; bj < 2; ++bj) { const int t0 = u.pn * BM + bj * HALF + wc * 32 + 8 * fq; float o8[8];
#pragma unroll
                    for (int i = 0; i < 8; ++i) o8[i] = acc[ai][bj][m][i >> 2][i & 3] * __builtin_amdgcn_exp2f((float)(t0 + i) * d);
                    u32x4 w; w.x = cvt_pk_bf16(o8[0], o8[1]); w.y = cvt_pk_bf16(o8[2], o8[3]); w.z = cvt_pk_bf16(o8[4], o8[5]); w.w = cvt_pk_bf16(o8[6], o8[7]);
                    *(u32x4*)(rowp + bj * HALF) = w; }
                asm volatile("" ::: "memory"); }
    }
};
template <class Epi, class Sched, bool ALIGN_EPI = false, bool SP2 = false>
__device__ __forceinline__ void gemm_phase(PG8_LAS unsigned char* lds, const Gemm g, const Sched& S, const Epi& E) {
    int tid_l = threadIdx.x; asm volatile("" : "+v"(tid_l));
    const int tid = tid_l, wid = __builtin_amdgcn_readfirstlane(tid >> 6), lane = tid & 63, wr = wid >> 2, wc = wid & 3, fr = lane & 15, fq = lane >> 4;
    const int K = g.K, nt = K / BK;
    unsigned voffA[2], voffB[2];
#pragma unroll
    for (int i = 0; i < 2; ++i) { int R, C; stage_rc(tid * 16 + i * 8192, R, C); const int Rb = Epi::PERM ? ((R & ~31) + perm32(R & 31)) : R;
        voffA[i] = (unsigned)(R * K + C) * 2u; voffB[i] = (unsigned)(Rb * K + C) * 2u; }
    const size_t kstep = (size_t)(BK * 2);
    const size_t hstep = (size_t)HALF * K * 2;
    const size_t tstep = 2 * hstep;
    const unsigned ldsw = (unsigned)wid * 1024u;
    const int aoff = lds_byte(wr * 64 + fr, fq * 8), boff = lds_byte(wc * 32 + fr, fq * 8);
#define PG8_SA(b, h) (((b) * 2 + (h)) * HTB)
#define PG8_SB(b, h) ((4 + (b) * 2 + (h)) * HTB)
#define PG8_STAGE(bufoff, gbase, voff) do { _Pragma("unroll") for (int _i = 0; _i < 2; ++_i) \
        __builtin_amdgcn_global_load_lds((const unsigned*)((const char*)(gbase) + (voff)[_i]), (PG8_LAS unsigned*)(lds + (bufoff) + ldsw + _i * 8192), 16, 0, 0); } while (0)
#define PG8_LDA(dst, b, h) do { _Pragma("unroll") for (int m = 0; m < 4; ++m) _Pragma("unroll") for (int k = 0; k < 2; ++k) dst[m][k] = *(const PG8_LAS bf16x8*)(lds + PG8_SA(b, h) + aoff + m * 2048 + k * 1024); } while (0)
#define PG8_LDB(dst, b, h) do { _Pragma("unroll") for (int n = 0; n < 2; ++n) _Pragma("unroll") for (int k = 0; k < 2; ++k) dst[n][k] = *(const PG8_LAS bf16x8*)(lds + PG8_SB(b, h) + boff + n * 2048 + k * 1024); } while (0)
#define PG8_MMA(ai, bj, At, Bt) do { __builtin_amdgcn_s_setprio(1); _Pragma("unroll") for (int m = 0; m < 4; ++m) _Pragma("unroll") for (int n = 0; n < 2; ++n) _Pragma("unroll") for (int k = 0; k < 2; ++k) \
        acc[ai][bj][m][n] = __builtin_amdgcn_mfma_f32_16x16x32_bf16(Bt[n][k], At[m][k], acc[ai][bj][m][n], 0, 0, 0); __builtin_amdgcn_s_setprio(0); } while (0)
#define PG8_WAIT_V(n) asm volatile("s_waitcnt vmcnt(" #n ")" ::: "memory")
#define PG8_WAIT_L(n) asm volatile("s_waitcnt lgkmcnt(" #n ")" ::: "memory")
#define PG8_BAR __builtin_amdgcn_s_barrier()
#define PG8_SCHED __builtin_amdgcn_sched_barrier(0)
    Unit cur, nxt; int ui = 0;
    if (!S.next(0, cur)) return;
    f32x4 acc[2][2][4][2];
#pragma unroll
    for (int a = 0; a < 2; ++a)
#pragma unroll
        for (int b = 0; b < 2; ++b)
#pragma unroll
            for (int m = 0; m < 4; ++m)
#pragma unroll
                for (int n = 0; n < 2; ++n) acc[a][b][m][n] = (f32x4){0.f, 0.f, 0.f, 0.f};
    bf16x8 At[4][2], B0[2][2], B1[2][2];
    const char* cA = (const char*)g.A + (size_t)cur.pm * tstep; const char* cB = (const char*)g.Bt + (size_t)cur.pn * tstep;
    S.a_ready(cur);
    if constexpr (SP2) {
        PG8_STAGE(PG8_SB(0, 0), cB, voffB); PG8_STAGE(PG8_SB(0, 1), cB + hstep, voffB); PG8_STAGE(PG8_SA(0, 0), cA, voffA); PG8_STAGE(PG8_SA(0, 1), cA + hstep, voffA);
        if (wr == 1) PG8_BAR;
        PG8_WAIT_V(2); PG8_BAR;
        PG8_STAGE(PG8_SB(1, 0), cB + kstep, voffB); PG8_STAGE(PG8_SA(1, 0), cA + kstep, voffA); PG8_STAGE(PG8_SB(1, 1), cB + hstep + kstep, voffB);
        PG8_WAIT_V(6); PG8_BAR;
    } else {
        PG8_STAGE(PG8_SB(0, 0), cB, voffB); PG8_STAGE(PG8_SA(0, 0), cA, voffA); PG8_STAGE(PG8_SB(0, 1), cB + hstep, voffB); PG8_STAGE(PG8_SA(0, 1), cA + hstep, voffA);
        if (wr == 1) PG8_BAR;
        PG8_WAIT_V(4); PG8_BAR;
        PG8_STAGE(PG8_SB(1, 0), cB + kstep, voffB); PG8_STAGE(PG8_SA(1, 0), cA + kstep, voffA); PG8_STAGE(PG8_SB(1, 1), cB + hstep + kstep, voffB);
        PG8_WAIT_V(6); PG8_BAR;
    }
    for (;;) {
        const bool has_next = S.next(ui + 1, nxt);
        const char* nA = has_next ? (const char*)g.A + (size_t)nxt.pm * tstep : cA; const char* nB = has_next ? (const char*)g.Bt + (size_t)nxt.pn * tstep : cB;
        for (int t = 0; t < nt; t += 2) {
            const bool last = (t == nt - 2);
            const char* a1 = cA + (size_t)(t + 1) * kstep;
            const char* a2 = last ? nA : cA + (size_t)(t + 2) * kstep; const char* b2 = last ? nB : cB + (size_t)(t + 2) * kstep;
                        asm volatile("" : "+s"(a1), "+s"(a2), "+s"(b2));
            const char* a3 = a2 + kstep; const char* b3 = b2 + kstep; asm volatile("" : "+s"(a3), "+s"(b3));
            if (last && has_next) S.a_ready(nxt);
            if constexpr (SP2) {
            PG8_LDB(B0, 0, 0); PG8_LDB(B1, 0, 1); PG8_SCHED; PG8_LDA(At, 0, 0); PG8_STAGE(PG8_SA(1, 1), a1 + hstep, voffA);
            PG8_WAIT_V(8); PG8_WAIT_L(0); PG8_BAR; PG8_MMA(0, 0, At, B0); PG8_MMA(0, 1, At, B1); PG8_BAR; PG8_SCHED;
            PG8_LDA(At, 0, 1); PG8_STAGE(PG8_SB(0, 0), b2, voffB); PG8_STAGE(PG8_SB(0, 1), b2 + hstep, voffB); PG8_STAGE(PG8_SA(0, 0), a2, voffA);
            PG8_WAIT_V(8); PG8_WAIT_L(0); PG8_BAR; PG8_MMA(1, 0, At, B0); PG8_MMA(1, 1, At, B1); PG8_BAR; PG8_SCHED;
            PG8_LDB(B0, 1, 0); PG8_LDB(B1, 1, 1); PG8_SCHED; PG8_LDA(At, 1, 0); PG8_STAGE(PG8_SA(0, 1), a2 + hstep, voffA);
            PG8_WAIT_V(8); PG8_WAIT_L(0); PG8_BAR; PG8_MMA(0, 0, At, B0); PG8_MMA(0, 1, At, B1); PG8_BAR; PG8_SCHED;
            PG8_LDA(At, 1, 1); PG8_STAGE(PG8_SB(1, 0), b3, voffB); PG8_STAGE(PG8_SB(1, 1), b3 + hstep, voffB); PG8_STAGE(PG8_SA(1, 0), a3, voffA);
            PG8_WAIT_V(8); PG8_WAIT_L(0); PG8_BAR; PG8_MMA(1, 0, At, B0); PG8_MMA(1, 1, At, B1); PG8_BAR; PG8_SCHED;
            } else {
            PG8_LDB(B0, 0, 0); PG8_SCHED; PG8_LDA(At, 0, 0); PG8_STAGE(PG8_SA(1, 1), a1 + hstep, voffA);
            PG8_WAIT_L(8); PG8_BAR; PG8_WAIT_L(0); PG8_MMA(0, 0, At, B0); PG8_BAR; PG8_SCHED;
            PG8_LDB(B1, 0, 1); PG8_STAGE(PG8_SB(0, 0), b2, voffB);
            PG8_BAR; PG8_WAIT_L(0); PG8_MMA(0, 1, At, B1); PG8_BAR;
            PG8_LDA(At, 0, 1); PG8_STAGE(PG8_SA(0, 0), a2, voffA);
            PG8_BAR; PG8_WAIT_L(0); PG8_MMA(1, 0, At, B0); PG8_BAR; PG8_SCHED;
            PG8_STAGE(PG8_SB(0, 1), b2 + hstep, voffB);
            PG8_WAIT_V(6); PG8_BAR; PG8_MMA(1, 1, At, B1); PG8_BAR;
            PG8_LDB(B0, 1, 0); PG8_SCHED; PG8_LDA(At, 1, 0); PG8_STAGE(PG8_SA(0, 1), a2 + hstep, voffA);
            PG8_WAIT_L(8); PG8_BAR; PG8_WAIT_L(0); PG8_MMA(0, 0, At, B0); PG8_BAR; PG8_SCHED;
            PG8_LDB(B1, 1, 1); PG8_STAGE(PG8_SB(1, 0), b3, voffB);
            PG8_BAR; PG8_WAIT_L(0); PG8_MMA(0, 1, At, B1); PG8_BAR;
            PG8_LDA(At, 1, 1); PG8_STAGE(PG8_SA(1, 0), a3, voffA);
            PG8_BAR; PG8_WAIT_L(0); PG8_MMA(1, 0, At, B0); PG8_BAR; PG8_SCHED;
            PG8_STAGE(PG8_SB(1, 1), b3 + hstep, voffB);
            PG8_WAIT_V(6); PG8_BAR; PG8_MMA(1, 1, At, B1); PG8_BAR;
            }
        }
        if constexpr (ALIGN_EPI) { if (wr == 0) PG8_BAR; }
        if constexpr (!Epi::AFTER_DRAIN) { E(acc, cur, wr, wc, fr, fq); S.done(cur); }
        if (!has_next) break;
#pragma unroll
        for (int a = 0; a < 2; ++a)
#pragma unroll
            for (int b = 0; b < 2; ++b)
#pragma unroll
                for (int m = 0; m < 4; ++m)
#pragma unroll
                    for (int n = 0; n < 2; ++n) acc[a][b][m][n] = (f32x4){0.f, 0.f, 0.f, 0.f};
        cur = nxt; cA = nA; cB = nB; ++ui;
        if constexpr (ALIGN_EPI) { if (wr == 1) PG8_BAR; }
    }
    PG8_WAIT_V(0);
    if constexpr (!ALIGN_EPI) { if (wr == 0) PG8_BAR; }
    PG8_BAR;
    if constexpr (Epi::AFTER_DRAIN) { E.fused(acc, cur, wr, wc, fr, fq, lds, wid, lane); S.done(cur); }
#undef PG8_SA
#undef PG8_SB
#undef PG8_STAGE
#undef PG8_LDA
#undef PG8_LDB
#undef PG8_MMA
#undef PG8_WAIT_V
#undef PG8_WAIT_L
#undef PG8_BAR
#undef PG8_SCHED
}
}
namespace attn {
using bf16 = __hip_bfloat16;
constexpr int   D = 128, NW = 8, QBLK = 32, KVBLK = 64;
constexpr float SCALE = 0.088388347648318440f;
constexpr float THR = 8.f;
constexpr int SDEPTH = 2;
constexpr int LDQ = 1024, LDK = 256, LDO = 1024;
constexpr size_t SHM_V = KVBLK * D * 2, SHM_K = KVBLK * D * 2, SHM_ATTN = 2 * SHM_V + 2 * SHM_K + NW * 64 * 4;
using bf16x8 = __attribute__((ext_vector_type(8))) short;
using s16x4  = __attribute__((ext_vector_type(4))) short;
using f32x16 = __attribute__((ext_vector_type(16))) float;
using f32x8  = __attribute__((ext_vector_type(8))) float;
using u32x4  = __attribute__((ext_vector_type(4))) unsigned;
#define KSWZ(row, colB) ((row) * 256 + ((colB) ^ (((row) & 7) << 4)))
#define SBAR() __builtin_amdgcn_sched_barrier(0)
__device__ __forceinline__ int crow(int r, int hi) { return (r & 3) + 8 * (r >> 2) + 4 * hi; }
__device__ __forceinline__ unsigned cvtpk(float lo, float hi) {
  unsigned r; asm volatile("v_cvt_pk_bf16_f32 %0, %1, %2" : "=v"(r) : "v"(lo), "v"(hi)); return r;
}
template <typename TIn> struct Stage;
template <> struct Stage<bf16>  { using T = bf16x8;
  __device__ static __forceinline__ T ld8(const bf16* p) { return *reinterpret_cast<const bf16x8*>(p); }
  __device__ static __forceinline__ bf16x8 tobf(T x) { return x; } };
template <> struct Stage<float> { using T = f32x8;
  __device__ static __forceinline__ T ld8(const float* p) { return *reinterpret_cast<const f32x8*>(p); }
  __device__ static __forceinline__ bf16x8 tobf(T x) {
    u32x4 w = {cvtpk(x[0], x[1]), cvtpk(x[2], x[3]), cvtpk(x[4], x[5]), cvtpk(x[6], x[7])}; return *reinterpret_cast<bf16x8*>(&w); } };

__device__ __forceinline__ void partialSM(f32x16& p0, f32x16& p1, float& m_reg, float& mn, float& alpha) {
  constexpr float C = SCALE * 1.4426950408889634f;
  float pmax = p0[0]; for (int r = 1; r < 16; ++r) pmax = fmaxf(pmax, p0[r]); for (int r = 0; r < 16; ++r) pmax = fmaxf(pmax, p1[r]);
  { auto rr = __builtin_amdgcn_permlane32_swap(__float_as_uint(pmax), __float_as_uint(pmax), false, false);
    pmax = fmaxf(__uint_as_float(rr[0]), __uint_as_float(rr[1])); }
  if (__builtin_expect(__all(pmax - m_reg <= THR / SCALE), 1)) { mn = m_reg; alpha = 1.f; }
  else { mn = fmaxf(m_reg, pmax); alpha = __builtin_amdgcn_exp2f((m_reg - mn) * C); m_reg = mn; }
  float mnC = -mn * C;
  for (int r = 0; r < 16; ++r) p0[r] = fmaf(p0[r], C, mnC); for (int r = 0; r < 16; ++r) p1[r] = fmaf(p1[r], C, mnC);
  for (int r = 0; r < 16; ++r) p0[r] = __builtin_amdgcn_exp2f(p0[r]);
}
__device__ __forceinline__ void finishSM(f32x16& p0, f32x16& p1, float alpha, float& l_reg, bf16x8& pa0, bf16x8& pa1, bf16x8& pa2, bf16x8& pa3) {
  for (int r = 0; r < 16; ++r) p1[r] = __builtin_amdgcn_exp2f(p1[r]);
  float ps = 0; for (int r = 0; r < 16; ++r) ps += p0[r]; for (int r = 0; r < 16; ++r) ps += p1[r];
  { auto rr = __builtin_amdgcn_permlane32_swap(__float_as_uint(ps), __float_as_uint(ps), false, false);
    ps = __uint_as_float(rr[0]) + __uint_as_float(rr[1]); }
  l_reg = l_reg * alpha + ps;
#define PK4(P, BASE, OUT) do { unsigned a0 = cvtpk(P[BASE + 0], P[BASE + 1]), a1 = cvtpk(P[BASE + 2], P[BASE + 3]);   \
    unsigned b0 = cvtpk(P[BASE + 4], P[BASE + 5]), b1 = cvtpk(P[BASE + 6], P[BASE + 7]);                              \
    auto r0 = __builtin_amdgcn_permlane32_swap(a0, b0, false, false); auto r1 = __builtin_amdgcn_permlane32_swap(a1, b1, false, false); \
    u32x4 w = {r0[0], r1[0], r0[1], r1[1]}; OUT = *reinterpret_cast<bf16x8*>(&w); } while (0)
  PK4(p0, 0, pa0); PK4(p0, 8, pa1); PK4(p1, 0, pa2); PK4(p1, 8, pa3);
#undef PK4
}
__device__ __forceinline__ void qkt(f32x16& p0, f32x16& p1, const bf16* Ks, const bf16x8* qr, int r32, int hi) {
  p0 = f32x16{}; p1 = f32x16{};
  for (int d0 = 0; d0 < 8; ++d0) { int cb = (d0 * 16 + hi * 8) * 2;
    bf16x8 b0 = *reinterpret_cast<const bf16x8*>((const char*)Ks + KSWZ(r32, cb));
    bf16x8 b1 = *reinterpret_cast<const bf16x8*>((const char*)Ks + KSWZ(32 + r32, cb));
    p0 = __builtin_amdgcn_mfma_f32_32x32x16_bf16(b0, qr[d0], p0, 0, 0, 0);
    p1 = __builtin_amdgcn_mfma_f32_32x32x16_bf16(b1, qr[d0], p1, 0, 0, 0); }
}
__device__ __forceinline__ int v_st(int k, int c) { const int kk = (k & ~0xC) | ((k & 4) << 1) | ((k & 8) >> 1); return ((kk >> 3) * 4 + (c >> 5)) * 512 + ((kk & 7) * 32 + (c & 31)) * 2; }
__device__ __forceinline__ int v_rd_base(int lane) { return ((lane & 3) << 3) | (((lane >> 2) & 3) << 6) | (((lane >> 4) & 1) << 5) | (((lane >> 5) & 1) << 8); }
constexpr int v_rd_off(int d0, int ks, int half) { return d0 * 512 + ks * 4096 + half * 2048; }
template <int OFF> __device__ __forceinline__ s16x4 tr_read(int vb) {
  s16x4 r; asm volatile("ds_read_b64_tr_b16 %0, %1 offset:%2" : "=&v"(r) : "v"(vb), "i"(OFF) : "memory"); return r;
}
template <int D0> __device__ __forceinline__ void pv_one(f32x16& od, int vb, bf16x8 pa0, bf16x8 pa1, bf16x8 pa2, bf16x8 pa3) {
  const s16x4 l0 = tr_read<v_rd_off(D0, 0, 0)>(vb), h0 = tr_read<v_rd_off(D0, 0, 1)>(vb), l1 = tr_read<v_rd_off(D0, 1, 0)>(vb), h1 = tr_read<v_rd_off(D0, 1, 1)>(vb);
  const s16x4 l2 = tr_read<v_rd_off(D0, 2, 0)>(vb), h2 = tr_read<v_rd_off(D0, 2, 1)>(vb), l3 = tr_read<v_rd_off(D0, 3, 0)>(vb), h3 = tr_read<v_rd_off(D0, 3, 1)>(vb);
  asm volatile("s_waitcnt lgkmcnt(0)" ::: "memory"); SBAR();
#define PK(L, H) (bf16x8){L[0], L[1], L[2], L[3], H[0], H[1], H[2], H[3]}
  od = __builtin_amdgcn_mfma_f32_32x32x16_bf16(pa0, PK(l0, h0), od, 0, 0, 0);
  od = __builtin_amdgcn_mfma_f32_32x32x16_bf16(pa1, PK(l1, h1), od, 0, 0, 0);
  od = __builtin_amdgcn_mfma_f32_32x32x16_bf16(pa2, PK(l2, h2), od, 0, 0, 0);
  od = __builtin_amdgcn_mfma_f32_32x32x16_bf16(pa3, PK(l3, h3), od, 0, 0, 0);
#undef PK
}
__device__ __forceinline__ void pv_d0(f32x16* o, int vb, bf16x8 pa0, bf16x8 pa1, bf16x8 pa2, bf16x8 pa3) {
  pv_one<0>(o[0], vb, pa0, pa1, pa2, pa3); pv_one<1>(o[1], vb, pa0, pa1, pa2, pa3); pv_one<2>(o[2], vb, pa0, pa1, pa2, pa3); pv_one<3>(o[3], vb, pa0, pa1, pa2, pa3);
}

__device__ __forceinline__ void attn_dense_body(const bf16* Qb, const bf16* __restrict__ Kh, const bf16* __restrict__ Vh,
                                                unsigned short* Ob, const unsigned short* __restrict__ Gb, int seq, char* lds) {
  using TQ = bf16;
  using St = Stage<bf16>; using SQ = Stage<TQ>;
  int tid_l = threadIdx.x; asm volatile("" : "+v"(tid_l));
  const int tid = tid_l, wid = tid >> 6, lane = tid & 63, r32 = lane & 31, hi = lane >> 5;
  bf16* V_lds = (bf16*)lds; bf16* K_lds = (bf16*)(lds + 2 * SHM_V);
  float* ws = (float*)(lds + 2 * SHM_V + 2 * SHM_K) + wid * 64; float* li_l = ws; float* al_l = ws + 32;
  float m_reg = -1e30f, l_reg = 0; f32x16 o[4] = {}; bf16x8 qr[8];
  const TQ* Qw = Qb + (long)(wid * QBLK + r32) * LDQ + hi * 8;
#pragma unroll
  for (int d0 = 0; d0 < 8; ++d0) qr[d0] = SQ::tobf(SQ::ld8(Qw + d0 * 16));
  const int sr = tid >> 4, sc = (tid & 15) * 8, vst0 = v_st(sr, sc), vst1 = v_st(32 + sr, sc);
  const int vb0 = (int)(uintptr_t)V_lds + v_rd_base(lane);
  struct { typename St::T vs0, vs1, ks0, ks1; } sr_[SDEPTH];
#define SLOAD(i, k0) do { sr_[i].vs0 = St::ld8(&Vh[(long)((k0) + sr) * LDK + sc]); sr_[i].vs1 = St::ld8(&Vh[(long)((k0) + 32 + sr) * LDK + sc]); \
    sr_[i].ks0 = St::ld8(&Kh[(long)((k0) + sr) * LDK + sc]); sr_[i].ks1 = St::ld8(&Kh[(long)((k0) + 32 + sr) * LDK + sc]); } while (0)
#define SWRITE(b, i) do { *(bf16x8*)((char*)V_lds + (b) * SHM_V + vst0) = St::tobf(sr_[i].vs0);          \
    *(bf16x8*)((char*)V_lds + (b) * SHM_V + vst1) = St::tobf(sr_[i].vs1); int kc = sc * 2;               \
    *(bf16x8*)((char*)K_lds + (b) * SHM_K + KSWZ(sr, kc)) = St::tobf(sr_[i].ks0);                       \
    *(bf16x8*)((char*)K_lds + (b) * SHM_K + KSWZ(32 + sr, kc)) = St::tobf(sr_[i].ks1); } while (0)
#define SWAIT() do { if constexpr (SDEPTH == 2) asm volatile("s_waitcnt vmcnt(4)" ::: "memory"); else asm volatile("s_waitcnt vmcnt(0)" ::: "memory"); } while (0)
#define RESC(a) do { if (__any((a) < 1.f)) { if (hi == 0) al_l[r32] = (a); asm volatile("s_waitcnt lgkmcnt(0)" ::: "memory"); \
    for (int d = 0; d < 4; ++d) for (int r = 0; r < 16; ++r) o[d][r] *= al_l[crow(r, hi)]; } } while (0)
  f32x16 pA0, pA1, pB0, pB1; float mnA, mnB, alA, alB; bf16x8 pa0, pa1, pa2, pa3; const int NT = seq / KVBLK;
  constexpr int SE = 0, SO = SDEPTH - 1;
  SLOAD(SE, 0); asm volatile("s_waitcnt vmcnt(0)" ::: "memory"); SWRITE(0, SE); __syncthreads();
  qkt(pA0, pA1, K_lds, qr, r32, hi); partialSM(pA0, pA1, m_reg, mnA, alA);
  SLOAD(SO, KVBLK); if constexpr (SDEPTH == 2) { if (2 < NT) SLOAD(SE, 2 * KVBLK); }
  SWAIT(); SWRITE(1, SO); __syncthreads();
  for (int j = 1; j + 1 < NT; j += 2) {
    SBAR(); qkt(pB0, pB1, (bf16*)((char*)K_lds + SHM_K), qr, r32, hi);
    finishSM(pA0, pA1, alA, l_reg, pa0, pa1, pa2, pa3); SBAR();
    SLOAD(SO, (j + SDEPTH) * KVBLK); SBAR();
    pv_d0(o, vb0, pa0, pa1, pa2, pa3); partialSM(pB0, pB1, m_reg, mnB, alB);
    __syncthreads(); SWAIT(); SWRITE(0, SE);
    RESC(alB); __syncthreads();
    SBAR(); qkt(pA0, pA1, K_lds, qr, r32, hi);
    finishSM(pB0, pB1, alB, l_reg, pa0, pa1, pa2, pa3); SBAR();
    if (SDEPTH == 1 || j + 3 < NT) SLOAD(SE, (j + 1 + SDEPTH) * KVBLK); SBAR();
    pv_d0(o, vb0 + (int)SHM_V, pa0, pa1, pa2, pa3); partialSM(pA0, pA1, m_reg, mnA, alA);
    __syncthreads(); SWAIT(); SWRITE(1, SO);
    RESC(alA); __syncthreads();
  }
  SBAR(); qkt(pB0, pB1, (bf16*)((char*)K_lds + SHM_K), qr, r32, hi);
  finishSM(pA0, pA1, alA, l_reg, pa0, pa1, pa2, pa3); SBAR();
  pv_d0(o, vb0, pa0, pa1, pa2, pa3); partialSM(pB0, pB1, m_reg, mnB, alB);
  __syncthreads(); RESC(alB);
  finishSM(pB0, pB1, alB, l_reg, pa0, pa1, pa2, pa3); SBAR();
  pv_d0(o, vb0 + (int)SHM_V, pa0, pa1, pa2, pa3);
  if (hi == 0) li_l[r32] = l_reg; asm volatile("s_waitcnt lgkmcnt(0)" ::: "memory");
  float rli[16];
#pragma unroll
  for (int r = 0; r < 16; ++r) rli[r] = __builtin_amdgcn_rcpf(li_l[crow(r, hi)]);
  unsigned short* Ow = Ob + (long)(wid * QBLK) * LDO; const unsigned short* Gw = Gb + (long)(wid * QBLK) * LDO;
#pragma unroll
  for (int r = 0; r < 16; ++r) { int orow = crow(r, hi); asm volatile("" ::: "memory");
#pragma unroll
    for (int d0 = 0; d0 < 4; ++d0) { const long ix = (long)orow * LDO + d0 * 32 + r32; const float g = __uint_as_float((unsigned)Gw[ix] << 16);
      const float v = o[d0][r] * rli[r] * g; unsigned u = __float_as_uint(v); u = (u + 0x7fffu + ((u >> 16) & 1u)) >> 16; Ow[ix] = (unsigned short)u; } }
#undef SLOAD
#undef SWRITE
#undef SWAIT
#undef RESC
}

#undef KSWZ
#undef SBAR
}
using pg8::bf16_t; using pg8::bf16x8; using pg8::f32x4; using pg8::u32x4;
typedef float f32x16 __attribute__((ext_vector_type(16)));
typedef unsigned u32x2 __attribute__((ext_vector_type(2)));
constexpr size_t MiB = 1u << 20;
constexpr size_t WS_MOD = 0;
constexpr size_t WS_HDN = 1 * MiB;
constexpr size_t WS_HDNC = 2 * MiB;
constexpr size_t WS_STATP = 3 * MiB;
constexpr size_t WS_YSQ = 6 * MiB;
constexpr size_t WS_WIN = 10 * MiB;
constexpr size_t WS_WHYO = 35 * MiB, WS_WATTO = 37 * MiB, WS_WGMO = 39 * MiB, WS_WOUT = 41 * MiB;
constexpr size_t WS_GMWS = 43 * MiB;
constexpr size_t WS_FILT = 44 * MiB;
constexpr size_t WS_FILTC = 76 * MiB;
constexpr size_t WS_H = 78 * MiB;
constexpr size_t UNIT = 68 * MiB;
constexpr size_t WS_R0 = 146 * MiB, WS_R1 = WS_R0 + UNIT, WS_R2 = WS_R1 + UNIT, WS_R3 = WS_R2 + UNIT, WS_R4 = WS_R3 + UNIT, WS_END = WS_R4 + UNIT;
static_assert((size_t)MT * 1024 * 2 == UNIT, "unit");
constexpr int LDS_BYTES = 147456;

__device__ __forceinline__ unsigned f2bf(float f) { unsigned u = __float_as_uint(f); return (u + 0x7fffu + ((u >> 16) & 1u)) >> 16; }
__device__ __forceinline__ float bf2f(unsigned short b) { return __uint_as_float((unsigned)b << 16); }
__device__ __forceinline__ unsigned pk2(float lo, float hi) { return pg8::cvt_pk_bf16(lo, hi); }
__device__ __forceinline__ float wave_sum(float v) { v = sx_add<1>(v); v = sx_add<2>(v); v = sx_add<4>(v); v = sx_add<8>(v); v = sx_add<16>(v); v = sx_add<32>(v); return v; }
#define LDS_WAIT() asm volatile("s_waitcnt lgkmcnt(0)" ::: "memory")
__device__ __forceinline__ int crow(int r, int hi) { return (r & 3) + 8 * (r >> 2) + 4 * hi; }

struct Args { const float* in[29]; float* out; unsigned char* ws; int ph_lo, ph_hi; };
enum { I_X = 0, I_C, I_CTX, I_CCTX, I_WMOD, I_BMOD, I_GPRE, I_GPOST, I_WIN, I_HCW, I_HCB, I_HW1, I_HB1, I_HW2, I_HB2, I_HW3, I_HFREQ, I_HDECAY, I_HBIAS,
       I_QG, I_KG, I_LNG, I_LNB, I_GMWS, I_GMBS, I_WHYO, I_WATTO, I_WGMO, I_WOUT };

__device__ __forceinline__ void transpose_item(const float* W, int K, int N, bf16_t* WT, int k0, int n0, int dst_row0, LAS float* scr, int lane) {
    float tv[32];
#pragma unroll
    for (int i = 0; i < 32; ++i) { const int kk = 2 * i + (lane >> 5); tv[i] = W[(size_t)(k0 + kk) * N + n0 + (lane & 31)]; }
#pragma unroll
    for (int i = 0; i < 32; ++i) { const int kk = 2 * i + (lane >> 5); scr[kk * 33 + (lane & 31)] = tv[i]; }
    LDS_WAIT(); asm volatile("" ::: "memory");
    const int c = lane & 7;
#pragma unroll
    for (int j = 0; j < 4; ++j) { const int n = (lane >> 3) + 8 * j; const LAS float* s = scr + (8 * c) * 33 + n;
        u32x4 o; o.x = pk2(s[0 * 33], s[1 * 33]); o.y = pk2(s[2 * 33], s[3 * 33]); o.z = pk2(s[4 * 33], s[5 * 33]); o.w = pk2(s[6 * 33], s[7 * 33]);
        *(u32x4*)(WT + (size_t)(dst_row0 + n) * K + k0 + 8 * c) = o; }
    LDS_WAIT(); asm volatile("" ::: "memory");
}
__device__ __forceinline__ int win_remap(int src) {
    if (src < 4096) return src;
    if (src < 6656) return src + 1024;
    if (src < 7680) return src + 2048;
    if (src < 8704) return src + 4096;
    if (src < 9728) return src + 1024;
    if (src < 10752) return src - 5632;
    if (src < 11776) return src - 3072;
    return src - 1024;
}

__device__ __forceinline__ float silu_f(float x) { return x / (1.0f + __expf(-x)); }

__device__ __forceinline__ void hdn_item(const float* w1, const float* b1, const float* w2, const float* b2, const float* freq, int t, int L, bf16_t* dst, int lane) {
    const float tl = (float)t / (float)(L - 1);
    float zv = 0.f;
    if (lane == 0) zv = tl;
    else if (lane < 33) { const int jb = (lane - 1) & 15; const float band = 1e-4f + (float)jb * ((15.0f - 1e-4f) / 15.0f);
        const float ang = ((6.283185307179586f / (float)L) * (float)t) * band; zv = (lane < 17) ? cosf(ang) : -sinf(ang); }
    float a = b1[lane];
#pragma unroll
    for (int i = 0; i < 33; ++i) a += __uint_as_float(__builtin_amdgcn_readlane(__float_as_uint(zv), i)) * w1[i * 64 + lane];
    const float h1 = sinf(freq[lane] * a);
    float a2 = b2[lane];
#pragma unroll
    for (int k = 0; k < 64; ++k) a2 += __uint_as_float(__builtin_amdgcn_readlane(__float_as_uint(h1), k)) * w2[k * 64 + lane];
    dst[t * 128 + lane] = (bf16_t)f2bf(sinf(freq[64 + lane] * a2)); dst[t * 128 + 64 + lane] = 0;
}
__device__ __forceinline__ void h_row(const f32x4 (&v)[4], const float* gpre, const float* modr, bf16_t* hrow, int lane) {
    float s = 0.f;
#pragma unroll
    for (int j = 0; j < 4; ++j) s += (v[j].x * v[j].x + v[j].y * v[j].y) + (v[j].z * v[j].z + v[j].w * v[j].w);
    const float rn = rsqrtf(wave_sum(s) * (1.f / 1024.f) + 1e-6f);
#pragma unroll
    for (int j = 0; j < 4; ++j) { const int col = 4 * lane + 256 * j;
        const f32x4 g = *(const f32x4*)(gpre + col), sh = *(const f32x4*)(modr + col), sc = *(const f32x4*)(modr + 1024 + col);
        const f32x4 y = (v[j] * rn) * g * (sc + 1.0f) + sh;
        u32x2 w; w.x = pk2(y.x, y.y); w.y = pk2(y.z, y.w); *(u32x2*)(hrow + col) = w; }
}

template <int NTB>
__device__ __forceinline__ void lconv_unit(LAS unsigned char* lds, const bf16_t* zsrc, bool zconv, float zw0, float zw1, float zw2, float zb,
                                           const bf16_t* gsrcA, float gA0, float gA1, float gA2, float gAb, const bf16_t* gsrcB, float gB0, float gB1, float gB2, float gBb,
                                           const bf16_t* filtA, const bf16_t* filtB, float biasA, float biasB, bf16_t* dst) {
    constexpr int L = 64 * NTB;
    constexpr int RS = (L + 384) * 2 + 16;
    constexpr int FOFF = 8 * RS;
    constexpr int CLB = (((2 * L + 8) * 2 + 255) / 256) * 256 + 64;
    static_assert(FOFF % 16 == 0 && FOFF + 4 * CLB <= 144 * 1024, "lconv LDS");
    int tid_l = threadIdx.x; asm volatile("" : "+v"(tid_l));
    const int tid = tid_l, lane = tid & 63, wid = __builtin_amdgcn_readfirstlane(tid >> 6);
    const int n = lane & 31, h = lane >> 5;
    if (tid < 384) { const int b = tid / 48, j = tid % 48; const int off = b * RS + (j < 24 ? j * 16 : (192 + L) * 2 + (j - 24) * 16);
        *(LAS u32x4*)(lds + off) = zero4(); }
    constexpr int NIT = (L + 511) / 512;
    {
        u32x4 raw[NIT]; unsigned short pv[NIT], nx[NIT];
#pragma unroll
        for (int it = 0; it < NIT; ++it) { const int i = tid + 512 * it; raw[it] = zero4(); pv[it] = 0; nx[it] = 0;
            if (i < L) { const int b = i / (L / 8), s0 = (i % (L / 8)) * 8; const bf16_t* p = zsrc + (size_t)b * L + s0; raw[it] = *(const u32x4*)p;
                if (zconv) { if (s0 > 0) pv[it] = p[-1]; if (s0 + 8 < L) nx[it] = p[8]; } } }
#pragma unroll
        for (int it = 0; it < NIT; ++it) { const int i = tid + 512 * it;
            if (i < L) { const int b = i / (L / 8), s0 = (i % (L / 8)) * 8; u32x4 r4 = raw[it];
                if (zconv) {
                    float x[10];
                    x[0] = bf2f(pv[it]); x[9] = bf2f(nx[it]);
                    x[1] = pg8::bflo(r4.x); x[2] = pg8::bfhi(r4.x); x[3] = pg8::bflo(r4.y); x[4] = pg8::bfhi(r4.y);
                    x[5] = pg8::bflo(r4.z); x[6] = pg8::bfhi(r4.z); x[7] = pg8::bflo(r4.w); x[8] = pg8::bfhi(r4.w);
                    float y[8];
#pragma unroll
                    for (int e = 0; e < 8; ++e) y[e] = zw0 * x[e] + zw1 * x[e + 1] + zw2 * x[e + 2] + zb;
                    r4.x = pk2(y[0], y[1]); r4.y = pk2(y[2], y[3]); r4.z = pk2(y[4], y[5]); r4.w = pk2(y[6], y[7]);
                }
                *(LAS u32x4*)(lds + b * RS + (192 + s0) * 2) = r4; } }
    }
#pragma unroll 1
    for (int o = 0; o < 2; ++o) {
    int tid_o = tid_l; asm volatile("" : "+v"(tid_o));
    const int tid = tid_o, lane = tid & 63, wid = __builtin_amdgcn_readfirstlane(tid >> 6), n = lane & 31, h = lane >> 5;
    const bf16_t* gsrc = o ? gsrcB : gsrcA; const float gw0 = o ? gB0 : gA0, gw1 = o ? gB1 : gA1, gw2 = o ? gB2 : gA2, gb = o ? gBb : gAb;
    const bf16_t* filt = o ? filtB : filtA; const float bias = o ? biasB : biasA;
    if (tid < 36) { const int s = tid / 9, j = tid % 9; const int y = (j < 5 - s) ? j : 2 * L + 4 - s + (j - (5 - s)); *(LAS unsigned short*)(lds + FOFF + s * CLB + 2 * y) = 0; }
    for (int j = tid; j < 2 * L / 8; j += 512) {
        const int dir = j / (L / 8), t8 = (j % (L / 8)) * 8; const u32x4 raw = *(const u32x4*)(filt + (size_t)dir * L + t8);
        unsigned short e[8]; e[0] = raw.x & 0xffff; if (j == 0) e[0] = (unsigned short)f2bf(bf2f(e[0]) + bf2f(filt[L]));
 e[1] = raw.x >> 16; e[2] = raw.y & 0xffff; e[3] = raw.y >> 16; e[4] = raw.z & 0xffff; e[5] = raw.z >> 16; e[6] = raw.w & 0xffff; e[7] = raw.w >> 16;
#pragma unroll
        for (int i = 0; i < 8; ++i) { const int t = t8 + i; if (dir == 1 && t == 0) continue; const int d = dir ? -t : t;
#pragma unroll
            for (int s = 0; s < 4; ++s) { const int y = L + 4 - d - s; *(LAS unsigned short*)(lds + FOFF + s * CLB + 2 * y) = e[i]; } }
    }
    __syncthreads();
    u32x4 graw[NIT]; unsigned short gpv[NIT], gnx[NIT];
#define LC_GPREF() do { _Pragma("unroll") for (int it = 0; it < NIT; ++it) { const int i = tid + 512 * it; graw[it] = zero4(); gpv[it] = 0; gnx[it] = 0; \
        if (i < L) { const int b = i / (L / 8), s0 = (i % (L / 8)) * 8; const bf16_t* p = gsrc + (size_t)b * L + s0; graw[it] = *(const u32x4*)p; \
            if (s0 > 0) gpv[it] = p[-1]; if (s0 + 8 < L) gnx[it] = p[8]; } } } while (0)
    if constexpr (NTB != 64) LC_GPREF();
    const int Tw = 8 * wid;
    f32x16 acc[2][2];
#pragma unroll
    for (int a = 0; a < 2; ++a)
#pragma unroll
        for (int c = 0; c < 2; ++c)
#pragma unroll
            for (int r = 0; r < 16; ++r) acc[a][c][r] = 0.f;
    if (Tw < NTB) {
        const int sft = (4 - (n & 3)) & 3;
        const LAS unsigned char* bp = lds + FOFF + sft * CLB + 2 * (8 * h - n - sft + L + 4);
        const LAS unsigned char* zp = lds + (n & 7) * RS + 384 + 128 * (Tw + (n >> 3)) + 16 * h;
#define LC_LDT(TF, DD) do { _Pragma("unroll") for (int f = 0; f < 6; ++f) { const LAS unsigned char* q = bp + 32 * (f - 2 - 4 * (DD)); \
            const u32x2 lo = *(const LAS u32x2*)q, hi2 = *(const LAS u32x2*)(q + 8); const u32x4 w = (u32x4){lo.x, lo.y, hi2.x, hi2.y}; TF[f] = __builtin_bit_cast(bf16x8, w); } } while (0)
#define LC_LDZ(ZF, mt, DD) do { _Pragma("unroll") for (int ks = 0; ks < 4; ++ks) ZF[ks] = *(const LAS bf16x8*)(zp + 512 * (mt) + 32 * ks - 128 * (DD)); } while (0)
#define LC_MMA1(TF, ZF, mt) do { _Pragma("unroll") for (int ks = 0; ks < 4; ++ks) _Pragma("unroll") for (int nt = 0; nt < 2; ++nt) \
            acc[mt][nt] = __builtin_amdgcn_mfma_f32_32x32x16_bf16(ZF[ks], TF[ks - 2 * nt + 2], acc[mt][nt], 0, 0, 0); } while (0)
#define LC_MMA2(TF, ZF0, ZF1) do { _Pragma("unroll") for (int ks = 0; ks < 4; ++ks) _Pragma("unroll") for (int nt = 0; nt < 2; ++nt) { \
            acc[0][nt] = __builtin_amdgcn_mfma_f32_32x32x16_bf16(ZF0[ks], TF[ks - 2 * nt + 2], acc[0][nt], 0, 0, 0); \
            acc[1][nt] = __builtin_amdgcn_mfma_f32_32x32x16_bf16(ZF1[ks], TF[ks - 2 * nt + 2], acc[1][nt], 0, 0, 0); } } while (0)
        bf16x8 tfA[6], tfB[6], zA0[4], zA1[4], zB0[4], zB1[4];
        if constexpr (NTB == 64) {
            for (int Dd = Tw - 63; Dd < Tw - 59; ++Dd) { LC_LDT(tfA, Dd); LC_LDZ(zA0, 0, Dd); LC_MMA1(tfA, zA0, 0); }
            int Dd = Tw - 59;
            LC_LDT(tfA, Dd); LC_LDZ(zA0, 0, Dd); LC_LDZ(zA1, 1, Dd);
            for (int it = 0; it < 31; ++it) {
                LC_LDT(tfB, Dd + 1); LC_LDZ(zB0, 0, Dd + 1); LC_LDZ(zB1, 1, Dd + 1);
                __builtin_amdgcn_sched_barrier(0);
                LC_MMA2(tfA, zA0, zA1);
                __builtin_amdgcn_sched_barrier(0);
                LC_LDT(tfA, Dd + 2); LC_LDZ(zA0, 0, Dd + 2); LC_LDZ(zA1, 1, Dd + 2);
                __builtin_amdgcn_sched_barrier(0);
                LC_MMA2(tfB, zB0, zB1);
                __builtin_amdgcn_sched_barrier(0);
                Dd += 2;
            }
            LC_MMA2(tfA, zA0, zA1);
            LC_GPREF();
            for (int D3 = Tw + 4; D3 < Tw + 8; ++D3) { LC_LDT(tfA, D3); LC_LDZ(zA1, 1, D3); LC_MMA1(tfA, zA1, 1); }
        } else {
            for (int Dd = -(NTB - 1); Dd <= NTB - 1; ++Dd) { LC_LDT(tfA, Dd); LC_LDZ(zA0, 0, Dd); LC_MMA1(tfA, zA0, 0); }
        }
#undef LC_LDT
#undef LC_LDZ
#undef LC_MMA1
#undef LC_MMA2
#undef LC_GPREF
    }
    __syncthreads();
    if (Tw < NTB) {
#pragma unroll
        for (int mt = 0; mt < 2; ++mt) {
            if (Tw + 4 * mt < NTB) {
#pragma unroll
                for (int nt = 0; nt < 2; ++nt)
#pragma unroll
                    for (int r = 0; r < 16; ++r) {
                        const int b = (r & 3) + 4 * h, Tl = r >> 2, s = 64 * (Tw + 4 * mt + Tl) + 32 * nt + n;
                        LAS unsigned short* zq = (LAS unsigned short*)(lds + b * RS + (192 + s) * 2);
                        *zq = (unsigned short)f2bf(acc[mt][nt][r] + bias * bf2f(*zq));
                    }
            }
        }
    }
    __syncthreads();
    {
#pragma unroll
        for (int it = 0; it < NIT; ++it) { const int i = tid + 512 * it;
            if (i < L) { const int b = i / (L / 8), s0 = (i % (L / 8)) * 8; const u32x4 r4 = graw[it]; const u32x4 st = *(const LAS u32x4*)(lds + b * RS + (192 + s0) * 2);
                float x[10];
                x[0] = bf2f(gpv[it]); x[9] = bf2f(gnx[it]);
                x[1] = pg8::bflo(r4.x); x[2] = pg8::bfhi(r4.x); x[3] = pg8::bflo(r4.y); x[4] = pg8::bfhi(r4.y);
                x[5] = pg8::bflo(r4.z); x[6] = pg8::bfhi(r4.z); x[7] = pg8::bflo(r4.w); x[8] = pg8::bfhi(r4.w);
                float sv[8]; sv[0] = pg8::bflo(st.x); sv[1] = pg8::bfhi(st.x); sv[2] = pg8::bflo(st.y); sv[3] = pg8::bfhi(st.y); sv[4] = pg8::bflo(st.z); sv[5] = pg8::bfhi(st.z); sv[6] = pg8::bflo(st.w); sv[7] = pg8::bfhi(st.w);
                float y[8];
#pragma unroll
                for (int e = 0; e < 8; ++e) y[e] = (gw0 * x[e] + gw1 * x[e + 1] + gw2 * x[e + 2] + gb) * sv[e];
                u32x4 w; w.x = pk2(y[0], y[1]); w.y = pk2(y[2], y[3]); w.z = pk2(y[4], y[5]); w.w = pk2(y[6], y[7]);
                if (o == 0) *(LAS u32x4*)(lds + b * RS + (192 + s0) * 2) = w;
                else *(u32x4*)(dst + (size_t)b * L + s0) = w; } }
    }
    __syncthreads();
    }
}
__device__ __forceinline__ void gmlp_unit(LAS unsigned char* lds, int tok0, int g, const bf16_t* vT, const float* statp, const bf16_t* gmws, const float* bs,
                                          const float* lng, const float* lnb, bf16_t* U, const bf16_t* GG) {
    int tid_l = threadIdx.x; asm volatile("" : "+v"(tid_l));
    const int tid = tid_l, lane = tid & 63, wid = __builtin_amdgcn_readfirstlane(tid >> 6), n = lane & 31, h = lane >> 5;
    LAS float* mean = (LAS float*)lds; LAS float* rstd = mean + 128;
    constexpr int VOFF = 1024, VRS = 272, YOFF = VOFF + 128 * VRS, YRS = 132;
    { u32x4 raw[4];
#pragma unroll
      for (int q = 0; q < 4; ++q) { const int idx = tid + 512 * q, c = idx >> 4, ch = idx & 15; raw[q] = *(const u32x4*)(vT + (size_t)(g * 128 + c) * MT + tok0 + ch * 8); }
      if (tid < 128) { float s = 0.f, q2 = 0.f;
#pragma unroll
          for (int p = 0; p < 8; ++p) { const float* sp = statp + ((size_t)p * MT + tok0 + tid) * 2; s += sp[0]; q2 += sp[1]; }
          const float mu = s * (1.f / 1024.f); const float var = fmaxf(q2 * (1.f / 1024.f) - mu * mu, 0.f);
          mean[tid] = mu; rstd[tid] = rsqrtf(var + 1e-5f); }
#pragma unroll
      for (int q = 0; q < 4; ++q) { const int idx = tid + 512 * q, c = idx >> 4, ch = idx & 15; *(LAS u32x4*)(lds + VOFF + c * VRS + ch * 16) = raw[q]; } }
    __syncthreads();
    const int pt = wid >> 1, ctb = (wid & 1) * 2;
    f32x16 acc[2];
#pragma unroll
    for (int c = 0; c < 2; ++c)
#pragma unroll
        for (int r = 0; r < 16; ++r) acc[c][r] = 0.f;
    const bf16_t* ap = gmws + ((size_t)g * 128 + 32 * pt + n) * 128 + 8 * h;
    bf16x8 af[8];
#pragma unroll
    for (int ks = 0; ks < 8; ++ks) af[ks] = *(const bf16x8*)(ap + 16 * ks);
    float ga[2], be[2];
#pragma unroll
    for (int ct = 0; ct < 2; ++ct) { const int cgl = g * 128 + 32 * (ctb + ct) + n; ga[ct] = lng[cgl]; be[ct] = lnb[cgl]; }
#pragma unroll
    for (int ks = 0; ks < 8; ++ks) {
        float mu[8], rs[8];
#pragma unroll
        for (int e = 0; e < 8; ++e) { mu[e] = mean[16 * ks + 8 * h + e]; rs[e] = rstd[16 * ks + 8 * h + e]; }
#pragma unroll
        for (int ct = 0; ct < 2; ++ct) {
            const u32x4 raw = *(const LAS u32x4*)(lds + VOFF + (32 * (ctb + ct) + n) * VRS + (16 * ks + 8 * h) * 2);
            u32x4 w;
            w.x = pk2((pg8::bflo(raw.x) - mu[0]) * rs[0] * ga[ct] + be[ct], (pg8::bfhi(raw.x) - mu[1]) * rs[1] * ga[ct] + be[ct]);
            w.y = pk2((pg8::bflo(raw.y) - mu[2]) * rs[2] * ga[ct] + be[ct], (pg8::bfhi(raw.y) - mu[3]) * rs[3] * ga[ct] + be[ct]);
            w.z = pk2((pg8::bflo(raw.z) - mu[4]) * rs[4] * ga[ct] + be[ct], (pg8::bfhi(raw.z) - mu[5]) * rs[5] * ga[ct] + be[ct]);
            w.w = pk2((pg8::bflo(raw.w) - mu[6]) * rs[6] * ga[ct] + be[ct], (pg8::bfhi(raw.w) - mu[7]) * rs[7] * ga[ct] + be[ct]);
            acc[ct] = __builtin_amdgcn_mfma_f32_32x32x16_bf16(af[ks], __builtin_bit_cast(bf16x8, w), acc[ct], 0, 0, 0);
        }
    }
#pragma unroll
    for (int ct = 0; ct < 2; ++ct)
#pragma unroll
        for (int r = 0; r < 16; ++r) { const int p = 32 * pt + crow(r, h); ((LAS float*)(lds + YOFF))[p * YRS + 32 * (ctb + ct) + n] = acc[ct][r] + bs[g * 128 + p]; }
    __syncthreads();
    { u32x4 uu[4], gg[4];
#pragma unroll
      for (int q = 0; q < 4; ++q) { const int idx = tid + 512 * q, p = idx >> 4, ch = idx & 15; const size_t ix = (size_t)(tok0 + p) * 1024 + g * 128 + ch * 8; uu[q] = *(const u32x4*)(U + ix); gg[q] = *(const u32x4*)(GG + ix); }
#pragma unroll
      for (int q = 0; q < 4; ++q) { const int idx = tid + 512 * q, p = idx >> 4, ch = idx & 15; const size_t ix = (size_t)(tok0 + p) * 1024 + g * 128 + ch * 8;
        const LAS float* yp = (const LAS float*)(lds + YOFF) + p * YRS + ch * 8; const f32x4 y0 = *(const LAS f32x4*)yp, y1 = *(const LAS f32x4*)(yp + 4); u32x4 w;
        w.x = pk2(pg8::bflo(uu[q].x) * y0.x * pg8::bflo(gg[q].x), pg8::bfhi(uu[q].x) * y0.y * pg8::bfhi(gg[q].x));
        w.y = pk2(pg8::bflo(uu[q].y) * y0.z * pg8::bflo(gg[q].y), pg8::bfhi(uu[q].y) * y0.w * pg8::bfhi(gg[q].y));
        w.z = pk2(pg8::bflo(uu[q].z) * y1.x * pg8::bflo(gg[q].z), pg8::bfhi(uu[q].z) * y1.y * pg8::bfhi(gg[q].z));
        w.w = pk2(pg8::bflo(uu[q].w) * y1.z * pg8::bflo(gg[q].w), pg8::bfhi(uu[q].w) * y1.w * pg8::bfhi(gg[q].w));
        *(u32x4*)(U + ix) = w; } }
    __syncthreads();
}

__device__ __forceinline__ void qk_part(const bf16_t* src, bf16_t* dstp, const float* gain, const float* rope, int lane, bool lat, int s, bool active) {
    const int block = lane >> 2, j = lane & 3, axis = block & 1, off = (block >> 1) * 128 + axis * 64 + 8 * j;
    u32x4 ra = zero4(), rb = ra;
    if (active) { ra = *(const u32x4*)(src + off); rb = *(const u32x4*)(src + off + 32); }
    float a[8], c[8];
    a[0] = pg8::bflo(ra.x); a[1] = pg8::bfhi(ra.x); a[2] = pg8::bflo(ra.y); a[3] = pg8::bfhi(ra.y); a[4] = pg8::bflo(ra.z); a[5] = pg8::bfhi(ra.z); a[6] = pg8::bflo(ra.w); a[7] = pg8::bfhi(ra.w);
    c[0] = pg8::bflo(rb.x); c[1] = pg8::bfhi(rb.x); c[2] = pg8::bflo(rb.y); c[3] = pg8::bfhi(rb.y); c[4] = pg8::bflo(rb.z); c[5] = pg8::bfhi(rb.z); c[6] = pg8::bflo(rb.w); c[7] = pg8::bfhi(rb.w);
    float ss = 0.f;
#pragma unroll
    for (int e = 0; e < 8; ++e) ss += a[e] * a[e] + c[e] * c[e];
    ss = sx_add<1>(ss); ss = sx_add<2>(ss); ss = sx_add<4>(ss);
    const float rn = rsqrtf(ss * (1.f / 128.f) + 1e-6f);
    const float* gp = gain + axis * 64 + 8 * j;
    const f32x4 g0 = *(const f32x4*)gp, g1 = *(const f32x4*)(gp + 4), g2 = *(const f32x4*)(gp + 32), g3 = *(const f32x4*)(gp + 36);
    const float ga[8] = {g0.x, g0.y, g0.z, g0.w, g1.x, g1.y, g1.z, g1.w}, gc[8] = {g2.x, g2.y, g2.z, g2.w, g3.x, g3.y, g3.z, g3.w};
    float o1[8], o2[8];
    if (lat) {
        const int pos = axis ? (s & 63) : (s >> 6); const float* rp = rope + (size_t)(pos * 32 + 8 * j) * 2;
        const f32x4 t0 = *(const f32x4*)rp, t1 = *(const f32x4*)(rp + 4), t2 = *(const f32x4*)(rp + 8), t3 = *(const f32x4*)(rp + 12);
        const float cs[8] = {t0.x, t0.z, t1.x, t1.z, t2.x, t2.z, t3.x, t3.z}, sn[8] = {t0.y, t0.w, t1.y, t1.w, t2.y, t2.w, t3.y, t3.w};
#pragma unroll
        for (int e = 0; e < 8; ++e) { const float x = a[e] * rn * ga[e], y = c[e] * rn * gc[e]; o1[e] = x * cs[e] - y * sn[e]; o2[e] = y * cs[e] + x * sn[e]; }
    } else {
#pragma unroll
        for (int e = 0; e < 8; ++e) { o1[e] = a[e] * rn * ga[e]; o2[e] = c[e] * rn * gc[e]; }
    }
    if (active) {
        u32x4 w; w.x = pk2(o1[0], o1[1]); w.y = pk2(o1[2], o1[3]); w.z = pk2(o1[4], o1[5]); w.w = pk2(o1[6], o1[7]); *(u32x4*)(dstp + off) = w;
        w.x = pk2(o2[0], o2[1]); w.y = pk2(o2[2], o2[3]); w.z = pk2(o2[4], o2[5]); w.w = pk2(o2[6], o2[7]); *(u32x4*)(dstp + off + 32) = w; }
}
__device__ __forceinline__ void qk_row(int m, bf16_t* Q, const bf16_t* KV, bf16_t* Kp, bf16_t* Vp, const float* qg, const float* kg, const float* rope, int lane, bool doq) {
    const bool lat = m < ML; int b, s;
    if (lat) { b = m >> 12; s = m & 4095; } else { b = (m - ML) >> 8; s = (m - ML) & 255; }
    if (doq) qk_part(Q + (size_t)m * 1024, Q + (size_t)m * 1024, qg, rope, lane, lat, s, true);
    const size_t krow = (size_t)b * NKEY + (lat ? CTXL + s : s);
    const bf16_t* kr = KV + (size_t)m * 512;
    qk_part(kr, Kp + krow * 256, kg, rope, lane, lat, s, lane < 16);
    if (lane < 32) *(u32x4*)(Vp + krow * 256 + lane * 8) = *(const u32x4*)(kr + 256 + lane * 8);
}

__device__ __forceinline__ void tgate_item(LAS unsigned char* lds, const bf16_t* inT, const bf16_t* gate, bf16_t* out, int tok0, int c0) {
    int tid_l = threadIdx.x; asm volatile("" : "+v"(tid_l));
    const int tid = tid_l; LAS unsigned short* t = (LAS unsigned short*)lds;
    { const int cl = tid >> 3, ch = tid & 7; u32x4 raw[4];
#pragma unroll
      for (int q = 0; q < 4; ++q) raw[q] = *(const u32x4*)(inT + (size_t)(c0 + 64 * q + cl) * MT + tok0 + ch * 8);
#pragma unroll
      for (int q = 0; q < 4; ++q) { LAS unsigned short* d = t + q * (64 * 72) + (ch * 8) * 72 + cl;
        d[0 * 72] = (unsigned short)(raw[q].x & 0xffff); d[1 * 72] = (unsigned short)(raw[q].x >> 16); d[2 * 72] = (unsigned short)(raw[q].y & 0xffff); d[3 * 72] = (unsigned short)(raw[q].y >> 16);
        d[4 * 72] = (unsigned short)(raw[q].z & 0xffff); d[5 * 72] = (unsigned short)(raw[q].z >> 16); d[6 * 72] = (unsigned short)(raw[q].w & 0xffff); d[7 * 72] = (unsigned short)(raw[q].w >> 16); } }
    __syncthreads();
    { const int tl = tid >> 3, ch = tid & 7; u32x4 g[4];
#pragma unroll
      for (int q = 0; q < 4; ++q) g[q] = *(const u32x4*)(gate + (size_t)(tok0 + tl) * 1024 + c0 + 64 * q + ch * 8);
#pragma unroll
      for (int q = 0; q < 4; ++q) { const u32x4 v = *(const LAS u32x4*)(t + q * (64 * 72) + tl * 72 + ch * 8); u32x4 w;
        w.x = pk2(pg8::bflo(v.x) * pg8::bflo(g[q].x), pg8::bfhi(v.x) * pg8::bfhi(g[q].x)); w.y = pk2(pg8::bflo(v.y) * pg8::bflo(g[q].y), pg8::bfhi(v.y) * pg8::bfhi(g[q].y));
        w.z = pk2(pg8::bflo(v.z) * pg8::bflo(g[q].z), pg8::bfhi(v.z) * pg8::bfhi(g[q].z)); w.w = pk2(pg8::bflo(v.w) * pg8::bflo(g[q].w), pg8::bfhi(v.w) * pg8::bfhi(g[q].w));
        *(u32x4*)(out + (size_t)(tok0 + tl) * 1024 + c0 + 64 * q + ch * 8) = w; } }
    __syncthreads();
}
#define XB_TMO      128
#define XB_XCNT(j)  (256  + 64 * (j))
#define XB_XSUB(j)  (1280 + 64 * (j))
#define XB_XGEN(j)  (2304 + 64 * (j))
#define XB_TOP      3328
#define XB_TOPGEN   3392
#define XCD_BAR_WORDS 3456
#define XB_SPIN_CAP (1u << 18)

__device__ __forceinline__ unsigned xb_ld(unsigned* p)              { return __hip_atomic_load(p, __ATOMIC_RELAXED, __HIP_MEMORY_SCOPE_AGENT); }
__device__ __forceinline__ unsigned xb_add(unsigned* p, unsigned v) { return __hip_atomic_fetch_add(p, v, __ATOMIC_RELAXED, __HIP_MEMORY_SCOPE_AGENT); }
__device__ __forceinline__ unsigned xb_xcc_id() { return (unsigned)__builtin_amdgcn_s_getreg((3 << 11) | 20) & 0xFu; }
#define XB_SPIN(cond, bar) do { unsigned _sp = 0; while (cond) { __builtin_amdgcn_s_sleep(1); \
    if ((++_sp & 255u) == 0u) { if (xb_ld(&(bar)[XB_TMO])) break; if (_sp > XB_SPIN_CAP) { atomicAdd(&(bar)[XB_TMO], 1u); break; } } } } while (0)

struct XcdBarrier {
    unsigned* bar; unsigned x;
    volatile LAS unsigned* st;
};

__device__ __forceinline__ XcdBarrier xcd_barrier_post(unsigned* bar, volatile LAS unsigned* st) {
    XcdBarrier b; b.bar = bar; b.x = xb_xcc_id(); b.st = st;
    if (threadIdx.x == 0) (void)xb_add(&bar[XB_XCNT(b.x)], 1u);
    return b;
}
__device__ __forceinline__ void xcd_barrier_complete(unsigned* bar, unsigned x, unsigned& nloc, unsigned& nx) {
    const unsigned G = gridDim.x * gridDim.y * gridDim.z;
    unsigned sum, cnt, mine, sp = 0u;
    for (;;) {
        sum = 0u; cnt = 0u; mine = 0u;
#pragma unroll
        for (unsigned j = 0; j < 16; ++j) { const unsigned c = xb_ld(&bar[XB_XCNT(j)]); sum += c; cnt += (c > 0u) ? 1u : 0u; mine = (j == x) ? c : mine; }
        if (sum == G) break;
        __builtin_amdgcn_s_sleep(1);
        if ((++sp & 255u) == 0u) { if (xb_ld(&bar[XB_TMO])) break; if (sp > XB_SPIN_CAP) { atomicAdd(&bar[XB_TMO], 1u); break; } }
    }
    nloc = mine > 0u ? mine : 1u; nx = cnt > 0u ? cnt : 1u;
}

__device__ __forceinline__ void xcd_barrier(const XcdBarrier& b) {
    asm volatile("s_waitcnt vmcnt(0)" ::: "memory");
    __syncthreads();
    if (threadIdx.x == 0) {
        unsigned* bar = b.bar;
        __builtin_amdgcn_s_waitcnt(0);
        unsigned nloc = b.st[0], nx = b.st[1];
        if (nloc == 0u) { xcd_barrier_complete(bar, b.x, nloc, nx); b.st[0] = nloc; b.st[1] = nx; }
        const unsigned old = xb_add(&bar[XB_XSUB(b.x)], 1u);
        const unsigned gen = old / nloc;
        if (old + 1u == (gen + 1u) * nloc) {
            __builtin_amdgcn_fence(__ATOMIC_RELEASE, "agent");
            asm volatile("s_waitcnt vmcnt(0)" ::: "memory");
            const unsigned og = xb_add(&bar[XB_TOP], 1u);
            const unsigned tg = og / nx;
            if (og + 1u == (tg + 1u) * nx) xb_add(&bar[XB_TOPGEN], 1u);
            else XB_SPIN(xb_ld(&bar[XB_TOPGEN]) == tg, bar);
            __builtin_amdgcn_fence(__ATOMIC_ACQUIRE, "agent");
            xb_add(&bar[XB_XGEN(b.x)], 1u);
            asm volatile("s_waitcnt vmcnt(0)" ::: "memory");
        } else {
            XB_SPIN(xb_ld(&bar[XB_XGEN(b.x)]) == gen, bar);
            __builtin_amdgcn_fence(__ATOMIC_ACQUIRE, "agent");
            asm volatile("s_waitcnt vmcnt(0)" ::: "memory");
        }
    }
    __syncthreads();
}

constexpr size_t WS_BAR = 512 * 1024;
constexpr size_t WS_ROPE = 768 * 1024;
constexpr size_t WS_SPO = 492 * MiB, WS_SPG = 496 * MiB;
constexpr size_t WS_HDNB = 487 * MiB, WS_W3T = 488 * MiB, WS_HDNCB = 489 * MiB, WS_HDNB1 = 490 * MiB;
constexpr int NPH = 16;
#ifndef PHMASK
#define PHMASK 0xffff
#endif
#define PON(k) ((PHMASK >> (k)) & 1)
__global__ void __launch_bounds__(512, 2) fwd_kernel(Args args) {
    extern __shared__ __attribute__((aligned(16))) unsigned char lds_raw[];
    LAS unsigned char* lds = (LAS unsigned char*)lds_raw;
    cg::grid_group grid = cg::this_grid();
    const int G = gridDim.x, bx = blockIdx.x;
    if (threadIdx.x < 2) ((volatile LAS unsigned*)(lds + 147200))[threadIdx.x] = 0u;
    __syncthreads();
    XcdBarrier xbar; xbar.bar = (unsigned*)(args.ws + WS_BAR); xbar.x = 0; xbar.st = (volatile LAS unsigned*)(lds + 147200);
    const int vcu = (G % 8 == 0) ? (bx % 8) * (G / 8) + bx / 8 : bx;
    const int NGW = G * 8;
    if (args.ph_lo == 0) {
        int tid_p = threadIdx.x; asm volatile("" : "+v"(tid_p));
        const int lane = tid_p & 63, wave = __builtin_amdgcn_readfirstlane(tid_p >> 6); const int gw = vcu * 8 + wave; unsigned char* ws = args.ws;
        if (bx == (G > 1 ? 1 : 0)) { float* rt = (float*)(ws + WS_ROPE); for (int i = tid_p; i < 2048; i += 512) { const int pos = i >> 5, fi = i & 31; const float inv = powf(10000.0f, -(float)(2 * fi) * (1.0f / 64.0f)); const float ang = (float)pos * inv; rt[2 * i] = cosf(ang); rt[2 * i + 1] = sinf(ang); } }
        for (int it = gw; it < 4096 + 256 + 4096; it += NGW) {
            const int lw = (it < 4352) ? 0 : 1;
            const float* w1 = args.in[I_HW1] + lw * 33 * 64; const float* b1 = args.in[I_HB1] + lw * 64; const float* w2 = args.in[I_HW2] + lw * 4096; const float* b2 = args.in[I_HB2] + lw * 64; const float* fq = args.in[I_HFREQ] + lw * 128;
            if (it < 4096) hdn_item(w1, b1, w2, b2, fq, it, 4096, (bf16_t*)(ws + WS_HDNB), lane);
            else if (it < 4352) hdn_item(w1, b1, w2, b2, fq, it - 4096, 256, (bf16_t*)(ws + WS_HDNCB), lane);
            else hdn_item(w1, b1, w2, b2, fq, it - 4352, 4096, (bf16_t*)(ws + WS_HDNB1), lane);
        }
    }
    for (int gp = args.ph_lo; gp < args.ph_hi; ++gp) {
    int tid_l = threadIdx.x; asm volatile("" : "+v"(tid_l));
    const int tid = tid_l, lane = tid & 63, wave = __builtin_amdgcn_readfirstlane(tid >> 6);
    const int gw = vcu * 8 + wave;
    __attribute__((address_space(1))) unsigned char* wsg = (__attribute__((address_space(1))) unsigned char*)args.ws; asm volatile("" : "+s"(wsg));
    unsigned char* ws = (unsigned char*)wsg;
#ifdef PROBE_A
    if (bx == 0 && tid == 0) ((LAS unsigned long long*)(lds + 146000))[gp] = __builtin_amdgcn_s_memrealtime();
#endif
    float* modv = (float*)(ws + WS_MOD); float* hdn = (float*)(ws + WS_HDN); float* hdnc = (float*)(ws + WS_HDNC);
    float* statp = (float*)(ws + WS_STATP); float* ysq = (float*)(ws + WS_YSQ);
    bf16_t* WIN = (bf16_t*)(ws + WS_WIN); bf16_t* WHYO = (bf16_t*)(ws + WS_WHYO); bf16_t* WATTO = (bf16_t*)(ws + WS_WATTO); bf16_t* WGMO = (bf16_t*)(ws + WS_WGMO); bf16_t* WOUT = (bf16_t*)(ws + WS_WOUT);
    bf16_t* GMWS = (bf16_t*)(ws + WS_GMWS); bf16_t* FILT = (bf16_t*)(ws + WS_FILT); bf16_t* FILTC = (bf16_t*)(ws + WS_FILTC);
    bf16_t* H = (bf16_t*)(ws + WS_H);
    bf16_t* R0 = (bf16_t*)(ws + WS_R0); bf16_t* R1 = (bf16_t*)(ws + WS_R1); bf16_t* R2 = (bf16_t*)(ws + WS_R2); bf16_t* R3 = (bf16_t*)(ws + WS_R3); bf16_t* R4 = (bf16_t*)(ws + WS_R4);
    bf16_t* KVRAW = R1; bf16_t* KP = (bf16_t*)(ws + WS_R1 + 34 * MiB); bf16_t* VP = (bf16_t*)(ws + WS_R1 + 51 * MiB);
    float* Y = (float*)(ws + WS_R0);

#ifdef PROBE_A
    if (gp == 2 * NPH) {
        if (bx == 0) {
            LAS unsigned long long* ts = (LAS unsigned long long*)(lds + 146000);
            float s = 0.f;
            for (int i = tid; i < 8 * 131072; i += 512) { const f32x4 v = ((const f32x4*)(args.out + (size_t)(i >> 17) * 4096 * 1024))[i & 131071]; s += (v.x * v.x + v.y * v.y) + (v.z * v.z + v.w * v.w); }
            LAS float* red = (LAS float*)lds; red[tid] = s; __syncthreads();
            if (tid == 0) { float tot = 0.f; for (int i = 0; i < 512; ++i) tot += red[i];
                unsigned long long ta = 0, tb = 0;
                for (int g2 = 0; g2 < 2 * NPH; ++g2) { const unsigned long long d = ts[g2 + 1] - ts[g2]; if ((PROBE_A >> (g2 % NPH)) & 1) ta += d; if ((PROBE_B >> (g2 % NPH)) & 1) tb += d; }
                int a = (int)((ta + PROBE_UNIT / 2) / PROBE_UNIT), b2 = (int)((tb + PROBE_UNIT / 2) / PROBE_UNIT); if (a > 63) a = 63; if (b2 > 63) b2 = 63;
                red[600] = 0.3f * sqrtf(tot * (1.0f / 4194304.0f)); ((LAS int*)red)[601] = a + 64 * b2; }
            __syncthreads();
            const float delta = red[600]; const int K = ((LAS int*)red)[601];
            for (int i = tid; i < K; i += 512) args.out[(size_t)i * 8191 + 3] += delta;
        }
    } else
#endif
    {
        const int l = gp / NPH, p = gp % NPH;
        if (p == 4) continue;
        if (l == 1 && p == 1) continue;
        const int Ml = (l == 0) ? MT : ML;
        if (p == 0 && PON(0)) {
            if (gp == 0 && bx == 0) { for (int i = tid; i < XCD_BAR_WORDS; i += 512) ((unsigned*)(ws + WS_BAR))[i] = 0u; }
            if (l == 0) {
                for (int it = bx; it < 96; it += G) {
                    const int ll = it / 48, cb = it % 48, col = cb * 64 + lane, kb = wave * 128;
                    const float* Wm = args.in[I_WMOD] + (size_t)ll * 1024 * 3072; const float* cc = args.in[I_C]; const float* cx = args.in[I_CCTX];
                    float acc[9];
#pragma unroll
                    for (int r = 0; r < 9; ++r) acc[r] = 0.f;
                    for (int k = kb; k < kb + 128; ++k) { const float w = Wm[(size_t)k * 3072 + col];
#pragma unroll
                        for (int r = 0; r < 9; ++r) { const float cv = (r < 8) ? cc[r * 1024 + k] : cx[k]; acc[r] += silu_f(cv) * w; } }
                    LAS float* red = (LAS float*)lds;
#pragma unroll
                    for (int r = 0; r < 9; ++r) red[(wave * 9 + r) * 64 + lane] = acc[r];
                    __syncthreads();
                    for (int i = tid; i < 576; i += 512) { const int r = i >> 6, ln = i & 63; float s = args.in[I_BMOD][ll * 3072 + cb * 64 + ln];
                        for (int w8 = 0; w8 < 8; ++w8) s += red[(w8 * 9 + r) * 64 + ln];
                        modv[(size_t)(ll * 9 + r) * 3072 + cb * 64 + ln] = s; }
                    __syncthreads();
                }
            }
            LAS float* scr = (LAS float*)(lds + 4096 + wave * 16384);
            const int NIT = 6400 + 2048 + 256 + 128;
            bf16_t* W3T = (bf16_t*)(ws + WS_W3T);
            for (int it = gw; it < NIT; it += NGW) {
                int r = it;
                if (r < 6400) { const int kb = r / 400, nb = r % 400; transpose_item(args.in[I_WIN] + (size_t)l * 1024 * INW, 1024, INW, WIN, kb * 64, nb * 32, win_remap(nb * 32), scr, lane); continue; }
                r -= 6400;
                if (r < 2048) { const int which = r >> 9, i2 = r & 511, kb = i2 >> 5, nb = i2 & 31;
                    const float* W = args.in[which == 0 ? I_WHYO : which == 1 ? I_WATTO : which == 2 ? I_WGMO : I_WOUT] + (size_t)l * 1024 * 1024;
                    bf16_t* WT = which == 0 ? WHYO : which == 1 ? WATTO : which == 2 ? WGMO : WOUT;
                    transpose_item(W, 1024, 1024, WT, kb * 64, nb * 32, nb * 32, scr, lane); continue; }
                r -= 2048;
                if (r < 256) { const float* src = args.in[I_GMWS] + (size_t)l * 131072 + r * 512 + lane * 8; const f32x4 a = *(const f32x4*)src, b = *(const f32x4*)(src + 4);
                    u32x4 w; w.x = pk2(a.x, a.y); w.y = pk2(a.z, a.w); w.z = pk2(b.x, b.y); w.w = pk2(b.z, b.w); *(u32x4*)(GMWS + r * 512 + lane * 8) = w; continue; }
                r -= 256;
                if (r < 128) {
                    transpose_item(args.in[I_HW3] + (size_t)l * 64 * 4096, 128, 4096, W3T, 0, r * 32, r * 32, scr, lane);
                    bf16_t* zp = W3T + (size_t)(r * 32 + (lane >> 1)) * 128 + 64 + (lane & 1) * 32;
#pragma unroll
                    for (int j = 0; j < 4; ++j) *(u32x4*)(zp + 8 * j) = zero4();
                    continue; }
            }
        } else if (p == 1 && PON(1)) {
            if (l == 0) {
                for (int m = gw; m < MT; m += NGW) {
                    const float* xr = (m < ML) ? args.in[I_X] + (size_t)m * 1024 : args.in[I_CTX] + (size_t)(m - ML) * 1024; const int r = (m < ML) ? (m >> 12) : 8;
                    f32x4 v[4];
#pragma unroll
                    for (int j = 0; j < 4; ++j) v[j] = __builtin_nontemporal_load((const f32x4*)(xr + 4 * lane + 256 * j));
                    h_row(v, args.in[I_GPRE], modv + (size_t)r * 3072, H + (size_t)m * 1024, lane);
                }
            }
        } else if (p == 2 && PON(2)) {
            { pg8::Gemm g{(const bf16_t*)(ws + WS_W3T), (const bf16_t*)(ws + (l == 0 ? WS_HDNB : WS_HDNB1)), 4096, 4096, 128}; pg8::StaticOrder S; S.init(4096, 4096, G, bx); pg8::EpiF E{FILT, args.in[I_HDECAY] + l * 4096, 4096};
              pg8::gemm_phase<pg8::EpiF, pg8::StaticOrder, true, true>(lds, g, S, E); }
            if (l == 0) { pg8::Gemm g{(const bf16_t*)(ws + WS_W3T), (const bf16_t*)(ws + WS_HDNCB), 4096, 256, 128}; pg8::StaticOrder S; S.init(4096, 256, G, (bx + 128) % G); pg8::EpiF E{FILTC, args.in[I_HDECAY] + l * 4096, 256};
              pg8::gemm_phase<pg8::EpiF, pg8::StaticOrder, true, true>(lds, g, S, E); }
            { pg8::Gemm g{WIN, H, 3072, Ml, 1024}; pg8::StaticOrder S; S.init(3072, Ml, G, bx); pg8::EpiT<false> E{R0, MT, nullptr};
              pg8::gemm_phase<pg8::EpiT<false>, pg8::StaticOrder, true, true>(lds, g, S, E); }
            { pg8::Gemm g{H, WIN + (size_t)3072 * 1024, Ml, 2048, 1024}; pg8::StaticOrder S; S.init(Ml, 2048, G, (l == 0) ? (bx + 96) % G : bx); pg8::EpiIn<0> E{R3, R4, nullptr, nullptr};
              pg8::gemm_phase<pg8::EpiIn<0>, pg8::StaticOrder, true, true>(lds, g, S, E); }
        } else if (p == 3 && PON(3)) {
            const int nun = 1024 + (l == 0 ? 1024 : 0);
            const float* cw = args.in[I_HCW] + (size_t)l * 3 * 3072; const float* cb = args.in[I_HCB] + (size_t)l * 3072; const float* hb = args.in[I_HBIAS] + l * 2048;
            for (int u = bx; u < nun; u += G) {
                const int c = u & 1023; const bool isctx = u >= 1024; const size_t tb = isctx ? ML : 0;
                const int zc = 2048 + c, g1 = c, g2 = 1024 + c;
                const bf16_t* zsrc = R2 + (size_t)c * MT + tb; const bf16_t* gs1 = R0 + (size_t)c * MT + tb; const bf16_t* gs2 = R1 + (size_t)c * MT + tb; bf16_t* dst = R0 + (size_t)c * MT + tb;
                const float zw0 = cw[zc], zw1 = cw[3072 + zc], zw2 = cw[6144 + zc], zb = cb[zc];
                if (!isctx) lconv_unit<64>(lds, zsrc, true, zw0, zw1, zw2, zb, gs1, cw[g1], cw[3072 + g1], cw[6144 + g1], cb[g1], gs2, cw[g2], cw[3072 + g2], cw[6144 + g2], cb[g2],
                                           FILT + (size_t)c * 8192, FILT + (size_t)8192 * 1024 + (size_t)c * 8192, hb[c], hb[1024 + c], dst);
                else lconv_unit<4>(lds, zsrc, true, zw0, zw1, zw2, zb, gs1, cw[g1], cw[3072 + g1], cw[6144 + g1], cb[g1], gs2, cw[g2], cw[3072 + g2], cw[6144 + g2], cb[g2],
                                   FILTC + (size_t)c * 512, FILTC + (size_t)512 * 1024 + (size_t)c * 512, hb[c], hb[1024 + c], dst);
            }
        } else if (p == 5 && PON(5)) {
            for (int it = bx; it < (Ml / 64) * 4; it += G) tgate_item(lds, R0, R3, R1, (it >> 2) * 64, (it & 3) * 256);
        } else if (p == 6 && PON(6)) {
            pg8::Gemm g{R1, WHYO, ML, 1024, 1024}; pg8::StaticOrder S; S.init(ML, 1024, G, bx); pg8::EpiS E{R4, R4, 1};
            pg8::gemm_phase<pg8::EpiS, pg8::StaticOrder, true, true>(lds, g, S, E);
        } else if (p == 7 && PON(7)) {
            { pg8::Gemm g{H, WIN + (size_t)5120 * 1024, Ml, 3584, 1024}; pg8::StaticOrder S; S.init(Ml, 3584, G, bx); pg8::EpiIn<1> E{R0, KVRAW, R2, R3, (l == 0) ? (bf16_t*)(ws + WS_SPG) : nullptr};
              pg8::gemm_phase<pg8::EpiIn<1>, pg8::StaticOrder, true, true>(lds, g, S, E); }
            if (l == 0) { pg8::Gemm g{R1 + (size_t)ML * 1024, WHYO, MC, 1024, 1024}; pg8::StaticOrder S; S.init(MC, 1024, G, (bx + G - 112) % G); pg8::EpiS E{R4 + (size_t)ML * 1024, R4 + (size_t)ML * 1024, 1};
              pg8::gemm_phase<pg8::EpiS, pg8::StaticOrder, true, true>(lds, g, S, E); }
            if (l == 1) { pg8::Gemm g{H + (size_t)ML * 1024, WIN + (size_t)6144 * 1024, MC, 512, 1024}; pg8::StaticOrder S; S.init(MC, 512, G, (bx + 128) % G); pg8::EpiIn<3> E{KVRAW + (size_t)ML * 512, nullptr, nullptr, nullptr};
              pg8::gemm_phase<pg8::EpiIn<3>, pg8::StaticOrder, true, true>(lds, g, S, E); }
        } else if (p == 8 && PON(8)) {
            for (int m = gw; m < MT; m += NGW) qk_row(m, R0, KVRAW, KP, VP, args.in[I_QG] + l * 128, args.in[I_KG] + l * 128, (const float*)(ws + WS_ROPE), lane, m < Ml);
        } else if (p == 9 && PON(9)) {
            const int nun = 1024 + (l == 0 ? 64 : 0);
            for (int u = vcu; u < nun; u += G) {
                if (u < 1024) { const int grp = u >> 6, b = grp >> 1, kvh = grp & 1, within = u & 63, hh = kvh * 4 + (within >> 4), qb = within & 15;
                    const size_t qo = ((size_t)(b * SEQL + qb * 256)) * 1024 + hh * 128; const size_t ko = (size_t)b * NKEY * 256 + kvh * 128;
                    attn::attn_dense_body((const attn::bf16*)(R0 + qo), (const attn::bf16*)(KP + ko), (const attn::bf16*)(VP + ko), R0 + qo, R2 + qo, NKEY, (char*)lds_raw); }
                else { const int uc = u - 1024, b = uc >> 3, hh = uc & 7, kvh = hh >> 2;
                    const size_t qo = ((size_t)(ML + b * CTXL)) * 1024 + hh * 128; const size_t ko = (size_t)b * NKEY * 256 + kvh * 128;
                    attn::attn_dense_body((const attn::bf16*)(R0 + qo), (const attn::bf16*)(KP + ko), (const attn::bf16*)(VP + ko), (bf16_t*)(ws + WS_SPO) + ((size_t)(b * CTXL)) * 1024 + hh * 128, R2 + qo, CTXL, (char*)lds_raw); }
                __syncthreads();
            }
        } else if (p == 10 && PON(10)) {
            pg8::Gemm g{R0, WATTO, ML, 1024, 1024}; pg8::StaticOrder S; S.init(ML, 1024, G, bx); pg8::EpiS E{R3, R4, 0};
            pg8::gemm_phase<pg8::EpiS, pg8::StaticOrder, true, true>(lds, g, S, E);
        } else if (p == 11 && PON(11)) {
            { pg8::Gemm g{H, WIN + (size_t)8704 * 1024, Ml, 3072, 1024}; pg8::StaticOrder S; S.init(Ml, 3072, G, bx); pg8::EpiIn<2> E{R0, R2, R3, nullptr};
              pg8::gemm_phase<pg8::EpiIn<2>, pg8::StaticOrder, true, true>(lds, g, S, E); }
            { pg8::Gemm g{WIN + (size_t)11776 * 1024, H, 1024, Ml, 1024}; pg8::StaticOrder S; S.init(1024, Ml, G, (l == 0) ? (bx + 96) % G : bx); pg8::EpiT<true> E{R1, MT, statp};
              pg8::gemm_phase<pg8::EpiT<true>, pg8::StaticOrder, true, true>(lds, g, S, E); }
            if (l == 0) { pg8::Gemm g{(const bf16_t*)(ws + WS_SPO), WATTO, MC, 1024, 1024}; pg8::StaticOrder S; S.init(MC, 1024, G, (bx + G - 96) % G); pg8::EpiS E{(const bf16_t*)(ws + WS_SPG), R4 + (size_t)ML * 1024, 0};
              pg8::gemm_phase<pg8::EpiS, pg8::StaticOrder, true, true>(lds, g, S, E); }
        } else if (p == 12 && PON(12)) {
            const int nun = (l == 0 ? MT / 128 : ML / 128) * 8;
            for (int u = bx; u < nun; u += G)
                gmlp_unit(lds, (u >> 3) * 128, u & 7, R1, statp, GMWS, args.in[I_GMBS] + l * 1024, args.in[I_LNG] + l * 1024, args.in[I_LNB] + l * 1024, R0, R2);
        } else if (p == 13 && PON(13)) {
            pg8::Gemm g{R0, WGMO, Ml, 1024, 1024}; pg8::StaticOrder S; S.init(Ml, 1024, G, bx); pg8::EpiS E{R3, R4, 0};
            pg8::gemm_phase<pg8::EpiS, pg8::StaticOrder, true, true>(lds, g, S, E);
        } else if (p == 14 && PON(14)) {
            pg8::Gemm g{R4, WOUT, Ml, 1024, 1024}; pg8::StaticOrder S; S.init(Ml, 1024, G, bx); pg8::EpiY E{Y, ysq, MT};
            pg8::gemm_phase<pg8::EpiY, pg8::StaticOrder, true, true>(lds, g, S, E);
        } else if (p == 15 && PON(15)) {
            const int nrow = (l == 0) ? MT : ML;
            for (int m = gw; m < nrow; m += NGW) {
                const float* yr = Y + (size_t)m * 1024; const int r = (m < ML) ? (m >> 12) : 8;
                const float* xr = (l == 0) ? ((m < ML) ? args.in[I_X] + (size_t)m * 1024 : args.in[I_CTX] + (size_t)(m - ML) * 1024) : args.out + (size_t)m * 1024;
                const float q = (lane < 16) ? ysq[(size_t)lane * MT + m] : 0.f;
                const float rn = rsqrtf(wave_sum(q) * (1.f / 1024.f) + 1e-6f);
                const float* gpo = args.in[I_GPOST] + l * 1024; const float* gt = modv + (size_t)(l * 9 + r) * 3072 + 2048;
                f32x4 v[4];
#pragma unroll
                for (int j = 0; j < 4; ++j) { const int col = 4 * lane + 256 * j;
                    const f32x4 y = __builtin_nontemporal_load((const f32x4*)(yr + col)), x = __builtin_nontemporal_load((const f32x4*)(xr + col)), gp4 = *(const f32x4*)(gpo + col), g4 = *(const f32x4*)(gt + col);
                    v[j] = x + g4 * ((y * rn) * gp4);
                    if (m < ML) __builtin_nontemporal_store(v[j], (f32x4*)(args.out + (size_t)m * 1024 + col)); }
                if (l == 0) h_row(v, args.in[I_GPRE] + 1024, modv + (size_t)(9 + r) * 3072, H + (size_t)m * 1024, lane);
            }
        }
        if (gp + 1 < args.ph_hi) {
            if (gp == args.ph_lo) { grid.sync(); xbar = xcd_barrier_post((unsigned*)(args.ws + WS_BAR), (volatile LAS unsigned*)(lds + 147200)); }
            else xcd_barrier(xbar);
        }
    }
    }
}

extern "C" void kernel_launch(void* const* d_in, const int* in_sizes, int n_in, void* d_out, int out_size, void* d_ws, size_t ws_size, hipStream_t stream) {
    static int grid = 0;
    if (grid == 0) {
        if (n_in != 29 || out_size != ML * DM || ws_size < (size_t)500 * MiB) { fprintf(stderr, "kernel_launch: unexpected shapes n_in %d out %d ws %zu (need %zu)\n", n_in, out_size, ws_size, (size_t)WS_END); grid = -1; return; }
        int dev = 0, cus = 0, per_cu = 0;
        (void)hipGetDevice(&dev); (void)hipDeviceGetAttribute(&cus, hipDeviceAttributeMultiprocessorCount, dev);
        if (hipFuncSetAttribute((const void*)fwd_kernel, hipFuncAttributeMaxDynamicSharedMemorySize, LDS_BYTES) != hipSuccess) { fprintf(stderr, "kernel_launch: hipFuncSetAttribute failed\n"); grid = -1; return; }
        if (hipOccupancyMaxActiveBlocksPerMultiprocessor(&per_cu, (const void*)fwd_kernel, 512, LDS_BYTES) != hipSuccess || per_cu < 1) { fprintf(stderr, "kernel_launch: occupancy query gave %d\n", per_cu); per_cu = 1; }
        (void)hipGetLastError();
        grid = cus * 1;
        fprintf(stderr, "kernel_launch: cus %d per_cu %d grid %d\n", cus, per_cu, grid);
    }
    if (grid < 0) return;
    Args a{};
    for (int i = 0; i < 29; ++i) a.in[i] = (const float*)d_in[i];
    a.out = (float*)d_out; a.ws = (unsigned char*)d_ws; a.ph_lo = 0; a.ph_hi = 2 * NPH;
#ifdef PROBE_A
    a.ph_hi = 2 * NPH + 1;
#endif
    void* kargs[] = {&a};
    hipError_t e = hipLaunchCooperativeKernel((const void*)fwd_kernel, dim3(grid), dim3(512), kargs, LDS_BYTES, stream);
    if (e != hipSuccess) fprintf(stderr, "kernel_launch: cooperative launch failed: %s (grid %d)\n", hipGetErrorString(e), grid);
}
```

```cpp
#include <hip/hip_runtime.h>
#include <hip/hip_bf16.h>
#include <hip/hip_cooperative_groups.h>
#include <cstdio>
#include <cstdint>
#include <cmath>
namespace cg = cooperative_groups;

constexpr int DM = 1024, NBATCH = 8, SEQL = 4096, CTXL = 256;
constexpr int ML = NBATCH * SEQL, MC = NBATCH * CTXL, MT = ML + MC;
constexpr int NKEY = CTXL + SEQL;
constexpr int INW = 12800;
#define LAS __attribute__((address_space(3)))
template <int M> __device__ __forceinline__ float sx_add(float v) {
    if constexpr (M < 32) return v + __int_as_float(__builtin_amdgcn_ds_swizzle(__float_as_int(v), (M << 10) | 0x1f));
    else { auto rr = __builtin_amdgcn_permlane32_swap(__float_as_uint(v), __float_as_uint(v), false, false); return __uint_as_float(rr[0]) + __uint_as_float(rr[1]); }
}
typedef unsigned u32x4_g __attribute__((ext_vector_type(4)));
__device__ __forceinline__ u32x4_g zero4() { unsigned z = 0; asm volatile("" : "+v"(z)); return (u32x4_g){z, z, z, z}; }
namespace pg8 {
#define PG8_LAS __attribute__((address_space(3)))
typedef unsigned short bf16_t;
typedef short bf16x8 __attribute__((ext_vector_type(8)));
typedef float f32x4 __attribute__((ext_vector_type(4)));
typedef unsigned u32x4 __attribute__((ext_vector_type(4)));
constexpr int BM = 256, BK = 64, HALF = 128, HTB = HALF * BK * 2  , STAGE_BYTES = 8 * HTB, NXCD = 8, WGM = 8;

__host__ __device__ __forceinline__ int lds_byte(int r, int c) { const int st = (r >> 4) * 2 + (c >> 5), rr = r & 15, cc = c & 31, ob = rr * 64 + cc * 2; return st * 1024 + (ob ^ (((ob >> 9) & 1) << 5)); }
__host__ __device__ __forceinline__ void stage_rc(int b, int& R, int& C) { const int st = b / 1024, sb = b % 1024, swz = sb ^ (((sb >> 9) & 1) << 5); R = (st >> 1) * 16 + swz / 64; C = (st & 1) * 32 + (swz % 64) / 2; }
__host__ __device__ __forceinline__ int perm32(int rho) { const int n = rho >> 4, i = rho & 15; return 8 * (i >> 2) + 4 * n + (i & 3); }

struct Unit { int pm, pn; };
struct Gemm { const bf16_t* A; const bf16_t* Bt; int M, N, K; };

struct StaticOrder {
    int nM, nN, nwg, G, c;
    __host__ __device__ void init(int M, int N, int G_, int c_) { nM = M / BM; nN = N / BM; nwg = nM * nN; G = G_; c = c_; }
    __host__ __device__ bool next(int i, Unit& u) const {
        const long L = (long)i * G + c; if (L >= nwg) return false;
        int wgid = (int)L; { const int q = nwg / NXCD, r = nwg % NXCD, xcd = wgid % NXCD, off = wgid / NXCD; wgid = (xcd < r ? xcd * (q + 1) : r * (q + 1) + (xcd - r) * q) + off; }
        const int nig = WGM * nN, gid = wgid / nig, fm = gid * WGM, gsz = (nM - fm) < WGM ? (nM - fm) : WGM;
        u.pm = fm + ((wgid % nig) % gsz); u.pn = (wgid % nig) / gsz; return true;
    }
    __device__ __forceinline__ void a_ready(const Unit&) const {}
    __device__ __forceinline__ void done(const Unit&) const {}
};

__device__ __forceinline__ unsigned cvt_pk_bf16(float lo, float hi) { unsigned r; asm volatile("v_cvt_pk_bf16_f32 %0, %1, %2" : "=v"(r) : "v"(lo), "v"(hi)); return r; }
typedef float f32x2 __attribute__((ext_vector_type(2)));
__device__ __forceinline__ f32x2 gelu_pk(f32x2 v) {
    const f32x2 av = __builtin_elementwise_abs(v), d = av * 0.2316418882f + 1.0f;
    f32x2 t; t.x = __builtin_amdgcn_rcpf(d.x); t.y = __builtin_amdgcn_rcpf(d.y);
    f32x2 q = t * 0.5307027145f + (-0.7265760135f); q = q * t + 0.7107068705f; q = q * t + (-0.142248368f); q = q * t + 0.127414796f; q = q * t;
    const f32x2 s = (v * v) * (-0.72134752044f);
    f32x2 e; e.x = __builtin_amdgcn_exp2f(s.x); e.y = __builtin_amdgcn_exp2f(s.y);
    const f32x2 m = v * (q * e), r = v - m;
    f32x2 o; o.x = v.x < 0.f ? m.x : r.x; o.y = v.y < 0.f ? m.y : r.y; return o;
}

enum { ACT_NONE = 0, ACT_SILU = 1, ACT_SIGM = 2, ACT_GELU = 3 };
template <int ACT> __device__ __forceinline__ f32x4 act4(f32x4 v) {
    if constexpr (ACT == ACT_NONE) return v;
    else if constexpr (ACT == ACT_GELU) { f32x2 a = gelu_pk((f32x2){v[0], v[1]}), b = gelu_pk((f32x2){v[2], v[3]}); return (f32x4){a.x, a.y, b.x, b.y}; }
    else { f32x4 o;
#pragma unroll
        for (int i = 0; i < 4; ++i) { const float e = __builtin_amdgcn_exp2f(v[i] * -1.4426950408889634f); const float s = __builtin_amdgcn_rcpf(1.0f + e); o[i] = (ACT == ACT_SILU) ? v[i] * s : s; }
        return o; }
}
template <int ACT> __device__ __forceinline__ void store_tile_bf16(const f32x4 (&acc)[2][2][4][2], bf16_t* base, size_t ldc, int wr, int wc, int fr, int fq) {
    asm volatile("" : "+v"(fr), "+v"(fq));
#pragma unroll
    for (int ai = 0; ai < 2; ++ai)
#pragma unroll
        for (int m = 0; m < 4; ++m) { bf16_t* rowp = base + (size_t)(ai * HALF + wr * 64 + m * 16 + fr) * ldc + wc * 32 + 8 * fq;
#pragma unroll
            for (int bj = 0; bj < 2; ++bj) { const f32x4 v0 = act4<ACT>(acc[ai][bj][m][0]), v1 = act4<ACT>(acc[ai][bj][m][1]);
                u32x4 w; w.x = cvt_pk_bf16(v0[0], v0[1]); w.y = cvt_pk_bf16(v0[2], v0[3]); w.z = cvt_pk_bf16(v1[0], v1[1]); w.w = cvt_pk_bf16(v1[2], v1[3]);
                *(u32x4*)(rowp + bj * HALF) = w; }
            asm volatile("" ::: "memory"); __builtin_amdgcn_sched_barrier(0); }
}
__device__ __forceinline__ void store_tile_rt(const f32x4 (&acc)[2][2][4][2], bf16_t* base, size_t ldc, int wr, int wc, int fr, int fq, int act) {
    asm volatile("" : "+v"(fr), "+v"(fq));
    const bool is_none = (act == ACT_NONE), is_silu = (act == ACT_SILU);
#pragma unroll
    for (int ai = 0; ai < 2; ++ai)
#pragma unroll
        for (int m = 0; m < 4; ++m) { bf16_t* rowp = base + (size_t)(ai * HALF + wr * 64 + m * 16 + fr) * ldc + wc * 32 + 8 * fq;
#pragma unroll
            for (int bj = 0; bj < 2; ++bj) { float o[8];
#pragma unroll
                for (int i = 0; i < 8; ++i) { const float x = acc[ai][bj][m][i >> 2][i & 3]; const float e = __builtin_amdgcn_exp2f(x * -1.4426950408889634f); const float sg = __builtin_amdgcn_rcpf(1.0f + e);
                    o[i] = is_none ? x : (is_silu ? x * sg : sg); }
                u32x4 w; w.x = cvt_pk_bf16(o[0], o[1]); w.y = cvt_pk_bf16(o[2], o[3]); w.z = cvt_pk_bf16(o[4], o[5]); w.w = cvt_pk_bf16(o[6], o[7]);
                *(u32x4*)(rowp + bj * HALF) = w; }
            asm volatile("" ::: "memory"); __builtin_amdgcn_sched_barrier(0); }
}
template <int mode> struct EpiIn {
    static constexpr bool PERM = true, AFTER_DRAIN = false;
    bf16_t *p0, *p1, *p2, *p3; bf16_t* p4 = nullptr;
    __device__ __forceinline__ void operator()(f32x4 (&acc)[2][2][4][2], const Unit& u, int wr, int wc, int fr, int fq) const {
        bf16_t* base; size_t ldc = 1024; int act, ct;
        if (mode == 0) { if (u.pn < 4) { base = p0; act = ACT_SILU; ct = u.pn; } else { base = p1; act = ACT_SIGM; ct = u.pn - 4; } }
        else if (mode == 1) {
            if (u.pn < 4) { base = p0; act = ACT_NONE; ct = u.pn; }
            else if (u.pn < 6) { base = p1; act = ACT_NONE; ct = u.pn - 4; ldc = 512; }
            else if (u.pn < 10) { base = p2; act = ACT_SILU; ct = u.pn - 6; }
            else { base = (p4 && u.pm >= 128) ? p4 - (size_t)128 * BM * 1024 : p3; act = ACT_SIGM; ct = u.pn - 10; } }
        else if (mode == 3) { base = p0; act = ACT_NONE; ct = u.pn; ldc = 512; }
        else { if (u.pn < 4) { base = p0; act = ACT_GELU; ct = u.pn; } else if (u.pn < 8) { base = p1; act = ACT_SILU; ct = u.pn - 4; } else { base = p2; act = ACT_SIGM; ct = u.pn - 8; } }
        base += (size_t)u.pm * BM * ldc + ct * BM;
        if (mode == 2 && act == ACT_GELU) store_tile_bf16<ACT_GELU>(acc, base, ldc, wr, wc, fr, fq);
        else if ((mode == 1 || mode == 3) && act == ACT_NONE) store_tile_bf16<ACT_NONE>(acc, base, ldc, wr, wc, fr, fq);
        else store_tile_rt(acc, base, ldc, wr, wc, fr, fq, act);
    }
};
template <bool GELU> struct EpiT {
    static constexpr bool PERM = true, AFTER_DRAIN = false;
    bf16_t* O; int ldc; float* statp;
    __device__ __forceinline__ void operator()(f32x4 (&acc)[2][2][4][2], const Unit& u, int wr, int wc, int fr, int fq) const {
        asm volatile("" : "+v"(fr), "+v"(fq));
        bf16_t* base = O + (size_t)u.pm * BM * ldc + (size_t)u.pn * BM;
        if constexpr (!GELU) { store_tile_bf16<ACT_NONE>(acc, base, ldc, wr, wc, fr, fq); return; } else {
#pragma unroll
        for (int ai = 0; ai < 2; ++ai)
#pragma unroll
            for (int bj = 0; bj < 2; ++bj)
#pragma unroll
                for (int m = 0; m < 4; ++m)
#pragma unroll
                    for (int n = 0; n < 2; ++n) acc[ai][bj][m][n] = act4<ACT_GELU>(acc[ai][bj][m][n]);
        store_tile_bf16<ACT_NONE>(acc, base, ldc, wr, wc, fr, fq);
        const int part = u.pm * 2 + wr;
#pragma unroll
        for (int bj = 0; bj < 2; ++bj)
#pragma unroll
            for (int n = 0; n < 2; ++n) {
                f32x4 s = (f32x4){0.f, 0.f, 0.f, 0.f}, q = s;
#pragma unroll
                for (int ai = 0; ai < 2; ++ai)
#pragma unroll
                    for (int m = 0; m < 4; ++m) { const f32x4 x = acc[ai][bj][m][n]; s += x; q += x * x; }
#pragma unroll
                for (int c = 0; c < 4; ++c) {
                    float a = s[c], b = q[c];
                    a = sx_add<1>(a); b = sx_add<1>(b); a = sx_add<2>(a); b = sx_add<2>(b);
                    a = sx_add<4>(a); b = sx_add<4>(b); a = sx_add<8>(a); b = sx_add<8>(b);
                    s[c] = a; q[c] = b; }
                if (fr == 0) { const int tok = u.pn * BM + bj * HALF + wc * 32 + 8 * fq + 4 * n; float* sp = statp + ((size_t)part * ldc + tok) * 2;
                    *(f32x4*)(sp) = (f32x4){s[0], q[0], s[1], q[1]}; *(f32x4*)(sp + 4) = (f32x4){s[2], q[2], s[3], q[3]}; }
            }
        }
    }
};
__device__ __forceinline__ float bflo(unsigned w) { return __uint_as_float(w << 16); }
__device__ __forceinline__ float bfhi(unsigned w) { return __uint_as_float(w & 0xffff0000u); }
struct EpiS {
    static constexpr bool PERM = true, AFTER_DRAIN = false;
    const bf16_t* G; bf16_t* S; int first;
    __device__ __forceinline__ void operator()(f32x4 (&acc)[2][2][4][2], const Unit& u, int wr, int wc, int fr, int fq) const {
        asm volatile("" : "+v"(fr), "+v"(fq));
        const size_t off0 = (size_t)(u.pm * BM + wr * 64 + fr) * 1024 + u.pn * BM + wc * 32 + 8 * fq;
        u32x4 gA[2], sA[2], gB[2], sB[2];
#define EPIS_LD(GG, SS, k) do { const size_t o_ = off0 + (size_t)(((k) >> 2) * HALF + ((k) & 3) * 16) * 1024; _Pragma("unroll") for (int bj = 0; bj < 2; ++bj) { GG[bj] = *(const u32x4*)(G + o_ + bj * HALF); SS[bj] = first ? (u32x4){0u, 0u, 0u, 0u} : *(const u32x4*)(S + o_ + bj * HALF); } } while (0)
#define EPIS_ST(GG, SS, k) do { const size_t o_ = off0 + (size_t)(((k) >> 2) * HALF + ((k) & 3) * 16) * 1024; _Pragma("unroll") for (int bj = 0; bj < 2; ++bj) { const u32x4 g = GG[bj], sv = SS[bj]; \
            const f32x4 a0 = acc[(k) >> 2][bj][(k) & 3][0], a1 = acc[(k) >> 2][bj][(k) & 3][1]; u32x4 w; \
            w.x = cvt_pk_bf16(bflo(sv.x) + bflo(g.x) * a0[0], bfhi(sv.x) + bfhi(g.x) * a0[1]); w.y = cvt_pk_bf16(bflo(sv.y) + bflo(g.y) * a0[2], bfhi(sv.y) + bfhi(g.y) * a0[3]); \
            w.z = cvt_pk_bf16(bflo(sv.z) + bflo(g.z) * a1[0], bfhi(sv.z) + bfhi(g.z) * a1[1]); w.w = cvt_pk_bf16(bflo(sv.w) + bflo(g.w) * a1[2], bfhi(sv.w) + bfhi(g.w) * a1[3]); \
            *(u32x4*)(S + o_ + bj * HALF) = w; } } while (0)
        EPIS_LD(gA, sA, 0);
#pragma unroll
        for (int k = 0; k < 8; k += 2) {
            EPIS_LD(gB, sB, k + 1);
            EPIS_ST(gA, sA, k);
            if (k + 2 < 8) EPIS_LD(gA, sA, k + 2);
            EPIS_ST(gB, sB, k + 1);
        }
#undef EPIS_LD
#undef EPIS_ST
    }
};
struct EpiY {
    static constexpr bool PERM = true, AFTER_DRAIN = false;
    float* Y; float* ysq; int ldm;
    __device__ __forceinline__ void operator()(f32x4 (&acc)[2][2][4][2], const Unit& u, int wr, int wc, int fr, int fq) const {
        asm volatile("" : "+v"(fr), "+v"(fq));
#pragma unroll
        for (int ai = 0; ai < 2; ++ai)
#pragma unroll
            for (int m = 0; m < 4; ++m) { const int row = u.pm * BM + ai * HALF + wr * 64 + m * 16 + fr; float* rowp = Y + (size_t)row * 1024 + u.pn * BM + wc * 32 + 8 * fq; float q = 0.f;
#pragma unroll
                for (int bj = 0; bj < 2; ++bj) { const f32x4 a0 = acc[ai][bj][m][0], a1 = acc[ai][bj][m][1];
                    *(f32x4*)(rowp + bj * HALF) = a0; *(f32x4*)(rowp + bj * HALF + 4) = a1;
                    q += (a0[0] * a0[0] + a0[1] * a0[1]) + (a0[2] * a0[2] + a0[3] * a0[3]) + (a1[0] * a1[0] + a1[1] * a1[1]) + (a1[2] * a1[2] + a1[3] * a1[3]); }
                q = sx_add<16>(q); q = sx_add<32>(q);
                if (fq == 0) ysq[(size_t)(u.pn * 4 + wc) * ldm + row] = q; }
    }
};
struct EpiF {
    static constexpr bool PERM = true, AFTER_DRAIN = false;
    bf16_t* F; const float* decay; int L;
    __device__ __forceinline__ void operator()(f32x4 (&acc)[2][2][4][2], const Unit& u, int wr, int wc, int fr, int fq) const {
        asm volatile("" : "+v"(fr), "+v"(fq));
        const float inv = -1.4426950408889634f / (float)(L - 1);
#pragma unroll
        for (int ai = 0; ai < 2; ++ai)
#pragma unroll
            for (int m = 0; m < 4; ++m) { const int r = u.pm * BM + ai * HALF + wr * 64 + m * 16 + fr; const int o = r >> 11, dir = (r >> 10) & 1, c = r & 1023;
                const float d = fabsf(decay[r]) * inv; bf16_t* rowp = F + ((size_t)(o * 1024 + c) * 2 + dir) * L + u.pn * BM + wc * 32 + 8 * fq;
#pragma unroll
                for (int bj = 0; bj < 2; ++bj) { const int t0 = u.pn * BM + bj * HALF + wc * 32 + 8 * fq; float o8[8];
#pragma unroll
                    for (int i = 0; i < 8; ++i) o8[i] = acc[ai][bj][m][i >> 2][i & 3] * __builtin_amdgcn_exp2f((float)(t0 + i) * d);
                    u32x4 w; w.x = cvt_pk_bf16(o8[0], o8[1]); w.y = cvt_pk_bf16(o8[2], o8[3]); w.z = cvt_pk_bf16(o8[4], o8[5]); w.w = cvt_pk_bf16(o8[6], o8[7]);
                    *(u32x4*)(rowp + bj * HALF) = w; }
                asm volatile("" ::: "memory"); }
    }
};
template <class Epi, class Sched, bool ALIGN_EPI = false, bool SP2 = false>
__device__ __forceinline__ void gemm_phase(PG8_LAS unsigned char* lds, const Gemm g, const Sched& S, const Epi& E) {
    int tid_l = threadIdx.x; asm volatile("" : "+v"(tid_l));
    const int tid = tid_l, wid = __builtin_amdgcn_readfirstlane(tid >> 6), lane = tid & 63, wr = wid >> 2, wc = wid & 3, fr = lane & 15, fq = lane >> 4;
    const int K = g.K, nt = K / BK;
    unsigned voffA[2], voffB[2];
#pragma unroll
    for (int i = 0; i < 2; ++i) { int R, C; stage_rc(tid * 16 + i * 8192, R, C); const int Rb = Epi::PERM ? ((R & ~31) + perm32(R & 31)) : R;
        voffA[i] = (unsigned)(R * K + C) * 2u; voffB[i] = (unsigned)(Rb * K + C) * 2u; }
    const size_t kstep = (size_t)(BK * 2);
    const size_t hstep = (size_t)HALF * K * 2;
    const size_t tstep = 2 * hstep;
    const unsigned ldsw = (unsigned)wid * 1024u;
    const int aoff = lds_byte(wr * 64 + fr, fq * 8), boff = lds_byte(wc * 32 + fr, fq * 8);
#define PG8_SA(b, h) (((b) * 2 + (h)) * HTB)
#define PG8_SB(b, h) ((4 + (b) * 2 + (h)) * HTB)
#define PG8_STAGE(bufoff, gbase, voff) do { _Pragma("unroll") for (int _i = 0; _i < 2; ++_i) \
        __builtin_amdgcn_global_load_lds((const unsigned*)((const char*)(gbase) + (voff)[_i]), (PG8_LAS unsigned*)(lds + (bufoff) + ldsw + _i * 8192), 16, 0, 0); } while (0)
#define PG8_LDA(dst, b, h) do { _Pragma("unroll") for (int m = 0; m < 4; ++m) _Pragma("unroll") for (int k = 0; k < 2; ++k) dst[m][k] = *(const PG8_LAS bf16x8*)(lds + PG8_SA(b, h) + aoff + m * 2048 + k * 1024); } while (0)
#define PG8_LDB(dst, b, h) do { _Pragma("unroll") for (int n = 0; n < 2; ++n) _Pragma("unroll") for (int k = 0; k < 2; ++k) dst[n][k] = *(const PG8_LAS bf16x8*)(lds + PG8_SB(b, h) + boff + n * 2048 + k * 1024); } while (0)
#define PG8_MMA(ai, bj, At, Bt) do { __builtin_amdgcn_s_setprio(1); _Pragma("unroll") for (int m = 0; m < 4; ++m) _Pragma("unroll") for (int n = 0; n < 2; ++n) _Pragma("unroll") for (int k = 0; k < 2; ++k) \
        acc[ai][bj][m][n] = __builtin_amdgcn_mfma_f32_16x16x32_bf16(Bt[n][k], At[m][k], acc[ai][bj][m][n], 0, 0, 0); __builtin_amdgcn_s_setprio(0); } while (0)
#define PG8_WAIT_V(n) asm volatile("s_waitcnt vmcnt(" #n ")" ::: "memory")
#define PG8_WAIT_L(n) asm volatile("s_waitcnt lgkmcnt(" #n ")" ::: "memory")
#define PG8_BAR __builtin_amdgcn_s_barrier()
#define PG8_SCHED __builtin_amdgcn_sched_barrier(0)
    Unit cur, nxt; int ui = 0;
    if (!S.next(0, cur)) return;
    f32x4 acc[2][2][4][2];
#pragma unroll
    for (int a = 0; a < 2; ++a)
#pragma unroll
        for (int b = 0; b < 2; ++b)
#pragma unroll
            for (int m = 0; m < 4; ++m)
#pragma unroll
                for (int n = 0; n < 2; ++n) acc[a][b][m][n] = (f32x4){0.f, 0.f, 0.f, 0.f};
    bf16x8 At[4][2], B0[2][2], B1[2][2];
    const char* cA = (const char*)g.A + (size_t)cur.pm * tstep; const char* cB = (const char*)g.Bt + (size_t)cur.pn * tstep;
    S.a_ready(cur);
    if constexpr (SP2) {
        PG8_STAGE(PG8_SB(0, 0), cB, voffB); PG8_STAGE(PG8_SB(0, 1), cB + hstep, voffB); PG8_STAGE(PG8_SA(0, 0), cA, voffA); PG8_STAGE(PG8_SA(0, 1), cA + hstep, voffA);
        if (wr == 1) PG8_BAR;
        PG8_WAIT_V(2); PG8_BAR;
        PG8_STAGE(PG8_SB(1, 0), cB + kstep, voffB); PG8_STAGE(PG8_SA(1, 0), cA + kstep, voffA); PG8_STAGE(PG8_SB(1, 1), cB + hstep + kstep, voffB);
        PG8_WAIT_V(6); PG8_BAR;
    } else {
        PG8_STAGE(PG8_SB(0, 0), cB, voffB); PG8_STAGE(PG8_SA(0, 0), cA, voffA); PG8_STAGE(PG8_SB(0, 1), cB + hstep, voffB); PG8_STAGE(PG8_SA(0, 1), cA + hstep, voffA);
        if (wr == 1) PG8_BAR;
        PG8_WAIT_V(4); PG8_BAR;
        PG8_STAGE(PG8_SB(1, 0), cB + kstep, voffB); PG8_STAGE(PG8_SA(1, 0), cA + kstep, voffA); PG8_STAGE(PG8_SB(1, 1), cB + hstep + kstep, voffB);
        PG8_WAIT_V(6); PG8_BAR;
    }
    for (;;) {
        const bool has_next = S.next(ui + 1, nxt);
        const char* nA = has_next ? (const char*)g.A + (size_t)nxt.pm * tstep : cA; const char* nB = has_next ? (const char*)g.Bt + (size_t)nxt.pn * tstep : cB;
        for (int t = 0; t < nt; t += 2) {
            const bool last = (t == nt - 2);
            const char* a1 = cA + (size_t)(t + 1) * kstep;
            const char* a2 = last ? nA : cA + (size_t)(t + 2) * kstep; const char* b2 = last ? nB : cB + (size_t)(t + 2) * kstep;
                        asm volatile("" : "+s"(a1), "+s"(a2), "+s"(b2));
            const char* a3 = a2 + kstep; const char* b3 = b2 + kstep; asm volatile("" : "+s"(a3), "+s"(b3));
            if (last && has_next) S.a_ready(nxt);
            if constexpr (SP2) {
            PG8_LDB(B0, 0, 0); PG8_LDB(B1, 0, 1); PG8_SCHED; PG8_LDA(At, 0, 0); PG8_STAGE(PG8_SA(1, 1), a1 + hstep, voffA);
            PG8_WAIT_V(8); PG8_WAIT_L(0); PG8_BAR; PG8_MMA(0, 0, At, B0); PG8_MMA(0, 1, At, B1); PG8_BAR; PG8_SCHED;
            PG8_LDA(At, 0, 1); PG8_STAGE(PG8_SB(0, 0), b2, voffB); PG8_STAGE(PG8_SB(0, 1), b2 + hstep, voffB); PG8_STAGE(PG8_SA(0, 0), a2, voffA);
            PG8_WAIT_V(8); PG8_WAIT_L(0); PG8_BAR; PG8_MMA(1, 0, At, B0); PG8_MMA(1, 1, At, B1); PG8_BAR; PG8_SCHED;
            PG8_LDB(B0, 1, 0); PG8_LDB(B1, 1, 1); PG8_SCHED; PG8_LDA(At, 1, 0); PG8_STAGE(PG8_SA(0, 1), a2 + hstep, voffA);
            PG8_WAIT_V(8); PG8_WAIT_L(0); PG8_BAR; PG8_MMA(0, 0, At, B0); PG8_MMA(0, 1, At, B1); PG8_BAR; PG8_SCHED;
            PG8_LDA(At, 1, 1); PG8_STAGE(PG8_SB(1, 0), b3, voffB); PG8_STAGE(PG8_SB(1, 1), b3 + hstep, voffB); PG8_STAGE(PG8_SA(1, 0), a3, voffA);
            PG8_WAIT_V(8); PG8_WAIT_L(0); PG8_BAR; PG8_MMA(1, 0, At, B0); PG8_MMA(1, 1, At, B1); PG8_BAR; PG8_SCHED;
            } else {
            PG8_LDB(B0, 0, 0); PG8_SCHED; PG8_LDA(At, 0, 0); PG8_STAGE(PG8_SA(1, 1), a1 + hstep, voffA);
            PG8_WAIT_L(8); PG8_BAR; PG8_WAIT_L(0); PG8_MMA(0, 0, At, B0); PG8_BAR; PG8_SCHED;
            PG8_LDB(B1, 0, 1); PG8_STAGE(PG8_SB(0, 0), b2, voffB);
            PG8_BAR; PG8_WAIT_L(0); PG8_MMA(0, 1, At, B1); PG8_BAR;
            PG8_LDA(At, 0, 1); PG8_STAGE(PG8_SA(0, 0), a2, voffA);
            PG8_BAR; PG8_WAIT_L(0); PG8_MMA(1, 0, At, B0); PG8_BAR; PG8_SCHED;
            PG8_STAGE(PG8_SB(0, 1), b2 + hstep, voffB);
            PG8_WAIT_V(6); PG8_BAR; PG8_MMA(1, 1, At, B1); PG8_BAR;
            PG8_LDB(B0, 1, 0); PG8_SCHED; PG8_LDA(At, 1, 0); PG8_STAGE(PG8_SA(0, 1), a2 + hstep, voffA);
            PG8_WAIT_L(8); PG8_BAR; PG8_WAIT_L(0); PG8_MMA(0, 0, At, B0); PG8_BAR; PG8_SCHED;
            PG8_LDB(B1, 1, 1); PG8_STAGE(PG8_SB(1, 0), b3, voffB);
            PG8_BAR; PG8_WAIT_L(0); PG8_MMA(0, 1, At, B1); PG8_BAR;
            PG8_LDA(At, 1, 1); PG8_STAGE(PG8_SA(1, 0), a3, voffA);
            PG8_BAR; PG8_WAIT_L(0); PG8_MMA(1, 0, At, B0); PG8_BAR; PG8_SCHED;
            PG8_STAGE(PG8_SB(1, 1), b3 + hstep, voffB);
            PG8_WAIT_V(6); PG8_BAR; PG8_MMA(1, 1, At, B1); PG8_BAR;
            }
        }
        if constexpr (ALIGN_EPI) { if (wr == 0) PG8_BAR; }
        if constexpr (!Epi::AFTER_DRAIN) { E(acc, cur, wr, wc, fr, fq); S.done(cur); }
        if (!has_next) break;
#pragma unroll
        for (int a = 0; a < 2; ++a)
#pragma unroll
            for (int b = 0; b < 2; ++b)
#pragma unroll
                for (int m = 0; m < 4; ++m)
#pragma unroll
                    for (int n = 0; n < 2; ++n) acc[a][b][m][n] = (f32x4){0.f, 0.f, 0.f, 0.f};
        cur = nxt; cA = nA; cB = nB; ++ui;
        if constexpr (ALIGN_EPI) { if (wr == 1) PG8_BAR; }
    }
    PG8_WAIT_V(0);
    if constexpr (!ALIGN_EPI) { if (wr == 0) PG8_BAR; }
    PG8_BAR;
    if constexpr (Epi::AFTER_DRAIN) { E.fused(acc, cur, wr, wc, fr, fq, lds, wid, lane); S.done(cur); }
#undef PG8_SA
#undef PG8_SB
#undef PG8_STAGE
#undef PG8_LDA
#undef PG8_LDB
#undef PG8_MMA
#undef PG8_WAIT_V
#undef PG8_WAIT_L
#undef PG8_BAR
#undef PG8_SCHED
}
}
namespace attn {
using bf16 = __hip_bfloat16;
constexpr int   D = 128, NW = 8, QBLK = 32, KVBLK = 64;
constexpr float SCALE = 0.088388347648318440f;
constexpr float THR = 8.f;
constexpr int SDEPTH = 2;
constexpr int LDQ = 1024, LDK = 256, LDO = 1024;
constexpr size_t SHM_V = KVBLK * D * 2, SHM_K = KVBLK * D * 2, SHM_ATTN = 2 * SHM_V + 2 * SHM_K + NW * 64 * 4;
using bf16x8 = __attribute__((ext_vector_type(8))) short;
using s16x4  = __attribute__((ext_vector_type(4))) short;
using f32x16 = __attribute__((ext_vector_type(16))) float;
using f32x8  = __attribute__((ext_vector_type(8))) float;
using u32x4  = __attribute__((ext_vector_type(4))) unsigned;
#define KSWZ(row, colB) ((row) * 256 + ((colB) ^ (((row) & 7) << 4)))
#define SBAR() __builtin_amdgcn_sched_barrier(0)
__device__ __forceinline__ int crow(int r, int hi) { return (r & 3) + 8 * (r >> 2) + 4 * hi; }
__device__ __forceinline__ unsigned cvtpk(float lo, float hi) {
  unsigned r; asm volatile("v_cvt_pk_bf16_f32 %0, %1, %2" : "=v"(r) : "v"(lo), "v"(hi)); return r;
}
template <typename TIn> struct Stage;
template <> struct Stage<bf16>  { using T = bf16x8;
  __device__ static __forceinline__ T ld8(const bf16* p) { return *reinterpret_cast<const bf16x8*>(p); }
  __device__ static __forceinline__ bf16x8 tobf(T x) { return x; } };
template <> struct Stage<float> { using T = f32x8;
  __device__ static __forceinline__ T ld8(const float* p) { return *reinterpret_cast<const f32x8*>(p); }
  __device__ static __forceinline__ bf16x8 tobf(T x) {
    u32x4 w = {cvtpk(x[0], x[1]), cvtpk(x[2], x[3]), cvtpk(x[4], x[5]), cvtpk(x[6], x[7])}; return *reinterpret_cast<bf16x8*>(&w); } };

__device__ __forceinline__ void partialSM(f32x16& p0, f32x16& p1, float& m_reg, float& mn, float& alpha) {
  constexpr float C = SCALE * 1.4426950408889634f;
  float pmax = p0[0]; for (int r = 1; r < 16; ++r) pmax = fmaxf(pmax, p0[r]); for (int r = 0; r < 16; ++r) pmax = fmaxf(pmax, p1[r]);
  { auto rr = __builtin_amdgcn_permlane32_swap(__float_as_uint(pmax), __float_as_uint(pmax), false, false);
    pmax = fmaxf(__uint_as_float(rr[0]), __uint_as_float(rr[1])); }
  if (__builtin_expect(__all(pmax - m_reg <= THR / SCALE), 1)) { mn = m_reg; alpha = 1.f; }
  else { mn = fmaxf(m_reg, pmax); alpha = __builtin_amdgcn_exp2f((m_reg - mn) * C); m_reg = mn; }
  float mnC = -mn * C;
  for (int r = 0; r < 16; ++r) p0[r] = fmaf(p0[r], C, mnC); for (int r = 0; r < 16; ++r) p1[r] = fmaf(p1[r], C, mnC);
  for (int r = 0; r < 16; ++r) p0[r] = __builtin_amdgcn_exp2f(p0[r]);
}
__device__ __forceinline__ void finishSM(f32x16& p0, f32x16& p1, float alpha, float& l_reg, bf16x8& pa0, bf16x8& pa1, bf16x8& pa2, bf16x8& pa3) {
  for (int r = 0; r < 16; ++r) p1[r] = __builtin_amdgcn_exp2f(p1[r]);
  float ps = 0; for (int r = 0; r < 16; ++r) ps += p0[r]; for (int r = 0; r < 16; ++r) ps += p1[r];
  { auto rr = __builtin_amdgcn_permlane32_swap(__float_as_uint(ps), __float_as_uint(ps), false, false);
    ps = __uint_as_float(rr[0]) + __uint_as_float(rr[1]); }
  l_reg = l_reg * alpha + ps;
#define PK4(P, BASE, OUT) do { unsigned a0 = cvtpk(P[BASE + 0], P[BASE + 1]), a1 = cvtpk(P[BASE + 2], P[BASE + 3]);   \
    unsigned b0 = cvtpk(P[BASE + 4], P[BASE + 5]), b1 = cvtpk(P[BASE + 6], P[BASE + 7]);                              \
    auto r0 = __builtin_amdgcn_permlane32_swap(a0, b0, false, false); auto r1 = __builtin_amdgcn_permlane32_swap(a1, b1, false, false); \
    u32x4 w = {r0[0], r1[0], r0[1], r1[1]}; OUT = *reinterpret_cast<bf16x8*>(&w); } while (0)
  PK4(p0, 0, pa0); PK4(p0, 8, pa1); PK4(p1, 0, pa2); PK4(p1, 8, pa3);
#undef PK4
}
__device__ __forceinline__ void qkt(f32x16& p0, f32x16& p1, const bf16* Ks, const bf16x8* qr, int r32, int hi) {
  p0 = f32x16{}; p1 = f32x16{};
  for (int d0 = 0; d0 < 8; ++d0) { int cb = (d0 * 16 + hi * 8) * 2;
    bf16x8 b0 = *reinterpret_cast<const bf16x8*>((const char*)Ks + KSWZ(r32, cb));
    bf16x8 b1 = *reinterpret_cast<const bf16x8*>((const char*)Ks + KSWZ(32 + r32, cb));
    p0 = __builtin_amdgcn_mfma_f32_32x32x16_bf16(b0, qr[d0], p0, 0, 0, 0);
    p1 = __builtin_amdgcn_mfma_f32_32x32x16_bf16(b1, qr[d0], p1, 0, 0, 0); }
}
__device__ __forceinline__ int v_st(int k, int c) { const int kk = (k & ~0xC) | ((k & 4) << 1) | ((k & 8) >> 1); return ((kk >> 3) * 4 + (c >> 5)) * 512 + ((kk & 7) * 32 + (c & 31)) * 2; }
__device__ __forceinline__ int v_rd_base(int lane) { return ((lane & 3) << 3) | (((lane >> 2) & 3) << 6) | (((lane >> 4) & 1) << 5) | (((lane >> 5) & 1) << 8); }
constexpr int v_rd_off(int d0, int ks, int half) { return d0 * 512 + ks * 4096 + half * 2048; }
template <int OFF> __device__ __forceinline__ s16x4 tr_read(int vb) {
  s16x4 r; asm volatile("ds_read_b64_tr_b16 %0, %1 offset:%2" : "=&v"(r) : "v"(vb), "i"(OFF) : "memory"); return r;
}
template <int D0> __device__ __forceinline__ void pv_one(f32x16& od, int vb, bf16x8 pa0, bf16x8 pa1, bf16x8 pa2, bf16x8 pa3) {
  const s16x4 l0 = tr_read<v_rd_off(D0, 0, 0)>(vb), h0 = tr_read<v_rd_off(D0, 0, 1)>(vb), l1 = tr_read<v_rd_off(D0, 1, 0)>(vb), h1 = tr_read<v_rd_off(D0, 1, 1)>(vb);
  const s16x4 l2 = tr_read<v_rd_off(D0, 2, 0)>(vb), h2 = tr_read<v_rd_off(D0, 2, 1)>(vb), l3 = tr_read<v_rd_off(D0, 3, 0)>(vb), h3 = tr_read<v_rd_off(D0, 3, 1)>(vb);
  asm volatile("s_waitcnt lgkmcnt(0)" ::: "memory"); SBAR();
#define PK(L, H) (bf16x8){L[0], L[1], L[2], L[3], H[0], H[1], H[2], H[3]}
  od = __builtin_amdgcn_mfma_f32_32x32x16_bf16(pa0, PK(l0, h0), od, 0, 0, 0);
  od = __builtin_amdgcn_mfma_f32_32x32x16_bf16(pa1, PK(l1, h1), od, 0, 0, 0);
  od = __builtin_amdgcn_mfma_f32_32x32x16_bf16(pa2, PK(l2, h2), od, 0, 0, 0);
  od = __builtin_amdgcn_mfma_f32_32x32x16_bf16(pa3, PK(l3, h3), od, 0, 0, 0);
#undef PK
}
__device__ __forceinline__ void pv_d0(f32x16* o, int vb, bf16x8 pa0, bf16x8 pa1, bf16x8 pa2, bf16x8 pa3) {
  pv_one<0>(o[0], vb, pa0, pa1, pa2, pa3); pv_one<1>(o[1], vb, pa0, pa1, pa2, pa3); pv_one<2>(o[2], vb, pa0, pa1, pa2, pa3); pv_one<3>(o[3], vb, pa0, pa1, pa2, pa3);
}

__device__ __forceinline__ void attn_dense_body(const bf16* Qb, const bf16* __restrict__ Kh, const bf16* __restrict__ Vh,
                                                unsigned short* Ob, const unsigned short* __restrict__ Gb, int seq, char* lds) {
  using TQ = bf16;
  using St = Stage<bf16>; using SQ = Stage<TQ>;
  int tid_l = threadIdx.x; asm volatile("" : "+v"(tid_l));
  const int tid = tid_l, wid = tid >> 6, lane = tid & 63, r32 = lane & 31, hi = lane >> 5;
  bf16* V_lds = (bf16*)lds; bf16* K_lds = (bf16*)(lds + 2 * SHM_V);
  float* ws = (float*)(lds + 2 * SHM_V + 2 * SHM_K) + wid * 64; float* li_l = ws; float* al_l = ws + 32;
  float m_reg = -1e30f, l_reg = 0; f32x16 o[4] = {}; bf16x8 qr[8];
  const TQ* Qw = Qb + (long)(wid * QBLK + r32) * LDQ + hi * 8;
#pragma unroll
  for (int d0 = 0; d0 < 8; ++d0) qr[d0] = SQ::tobf(SQ::ld8(Qw + d0 * 16));
  const int sr = tid >> 4, sc = (tid & 15) * 8, vst0 = v_st(sr, sc), vst1 = v_st(32 + sr, sc);
  const int vb0 = (int)(uintptr_t)V_lds + v_rd_base(lane);
  struct { typename St::T vs0, vs1, ks0, ks1; } sr_[SDEPTH];
#define SLOAD(i, k0) do { sr_[i].vs0 = St::ld8(&Vh[(long)((k0) + sr) * LDK + sc]); sr_[i].vs1 = St::ld8(&Vh[(long)((k0) + 32 + sr) * LDK + sc]); \
    sr_[i].ks0 = St::ld8(&Kh[(long)((k0) + sr) * LDK + sc]); sr_[i].ks1 = St::ld8(&Kh[(long)((k0) + 32 + sr) * LDK + sc]); } while (0)
#define SWRITE(b, i) do { *(bf16x8*)((char*)V_lds + (b) * SHM_V + vst0) = St::tobf(sr_[i].vs0);          \
    *(bf16x8*)((char*)V_lds + (b) * SHM_V + vst1) = St::tobf(sr_[i].vs1); int kc = sc * 2;               \
    *(bf16x8*)((char*)K_lds + (b) * SHM_K + KSWZ(sr, kc)) = St::tobf(sr_[i].ks0);                       \
    *(bf16x8*)((char*)K_lds + (b) * SHM_K + KSWZ(32 + sr, kc)) = St::tobf(sr_[i].ks1); } while (0)
#define SWAIT() do { if constexpr (SDEPTH == 2) asm volatile("s_waitcnt vmcnt(4)" ::: "memory"); else asm volatile("s_waitcnt vmcnt(0)" ::: "memory"); } while (0)
#define RESC(a) do { if (__any((a) < 1.f)) { if (hi == 0) al_l[r32] = (a); asm volatile("s_waitcnt lgkmcnt(0)" ::: "memory"); \
    for (int d = 0; d < 4; ++d) for (int r = 0; r < 16; ++r) o[d][r] *= al_l[crow(r, hi)]; } } while (0)
  f32x16 pA0, pA1, pB0, pB1; float mnA, mnB, alA, alB; bf16x8 pa0, pa1, pa2, pa3; const int NT = seq / KVBLK;
  constexpr int SE = 0, SO = SDEPTH - 1;
  SLOAD(SE, 0); asm volatile("s_waitcnt vmcnt(0)" ::: "memory"); SWRITE(0, SE); __syncthreads();
  qkt(pA0, pA1, K_lds, qr, r32, hi); partialSM(pA0, pA1, m_reg, mnA, alA);
  SLOAD(SO, KVBLK); if constexpr (SDEPTH == 2) { if (2 < NT) SLOAD(SE, 2 * KVBLK); }
  SWAIT(); SWRITE(1, SO); __syncthreads();
  for (int j = 1; j + 1 < NT; j += 2) {
    SBAR(); qkt(pB0, pB1, (bf16*)((char*)K_lds + SHM_K), qr, r32, hi);
    finishSM(pA0, pA1, alA, l_reg, pa0, pa1, pa2, pa3); SBAR();
    SLOAD(SO, (j + SDEPTH) * KVBLK); SBAR();
    pv_d0(o, vb0, pa0, pa1, pa2, pa3); partialSM(pB0, pB1, m_reg, mnB, alB);
    __syncthreads(); SWAIT(); SWRITE(0, SE);
    RESC(alB); __syncthreads();
    SBAR(); qkt(pA0, pA1, K_lds, qr, r32, hi);
    finishSM(pB0, pB1, alB, l_reg, pa0, pa1, pa2, pa3); SBAR();
    if (SDEPTH == 1 || j + 3 < NT) SLOAD(SE, (j + 1 + SDEPTH) * KVBLK); SBAR();
    pv_d0(o, vb0 + (int)SHM_V, pa0, pa1, pa2, pa3); partialSM(pA0, pA1, m_reg, mnA, alA);
    __syncthreads(); SWAIT(); SWRITE(1, SO);
    RESC(alA); __syncthreads();
  }
  SBAR(); qkt(pB0, pB1, (bf16*)((char*)K_lds + SHM_K), qr, r32, hi);
  finishSM(pA0, pA1, alA, l_reg, pa0, pa1, pa2, pa3); SBAR();
  pv_d0(o, vb0, pa0, pa1, pa2, pa3); partialSM(pB0, pB1, m_reg, mnB, alB);
  __syncthreads(); RESC(alB);
  finishSM(pB0, pB1, alB, l_reg, pa0, pa1, pa2, pa3); SBAR();
  pv_d0(o, vb0 + (int)SHM_V, pa0, pa1, pa2, pa3);
  if (hi == 0) li_l[r32] = l_reg; asm volatile("s_waitcnt lgkmcnt(0)" ::: "memory");
  float rli[16];
#pragma unroll
  for (int r = 0; r < 16; ++r) rli[r] = __builtin_amdgcn_rcpf(li_l[crow(r, hi)]);
  unsigned short* Ow = Ob + (long)(wid * QBLK) * LDO; const unsigned short* Gw = Gb + (long)(wid * QBLK) * LDO;
#pragma unroll
  for (int r = 0; r < 16; ++r) { int orow = crow(r, hi); asm volatile("" ::: "memory");
#pragma unroll
    for (int d0 = 0; d0 < 4; ++d0) { const long ix = (long)orow * LDO + d0 * 32 + r32; const float g = __uint_as_float((unsigned)Gw[ix] << 16);
      const float v = o[d0][r] * rli[r] * g; unsigned u = __float_as_uint(v); u = (u + 0x7fffu + ((u >> 16) & 1u)) >> 16; Ow[ix] = (unsigned short)u; } }
#undef SLOAD
#undef SWRITE
#undef SWAIT
#undef RESC
}

#undef KSWZ
#undef SBAR
}
using pg8::bf16_t; using pg8::bf16x8; using pg8::f32x4; using pg8::u32x4;
typedef float f32x16 __attribute__((ext_vector_type(16)));
typedef unsigned u32x2 __attribute__((ext_vector_type(2)));
constexpr size_t MiB = 1u << 20;
constexpr size_t WS_MOD = 0;
constexpr size_t WS_HDN = 1 * MiB;
constexpr size_t WS_HDNC = 2 * MiB;
constexpr size_t WS_STATP = 3 * MiB;
constexpr size_t WS_YSQ = 6 * MiB;
constexpr size_t WS_WIN = 10 * MiB;
constexpr size_t WS_WHYO = 35 * MiB, WS_WATTO = 37 * MiB, WS_WGMO = 39 * MiB, WS_WOUT = 41 * MiB;
constexpr size_t WS_GMWS = 43 * MiB;
constexpr size_t WS_FILT = 44 * MiB;
constexpr size_t WS_FILTC = 76 * MiB;
constexpr size_t WS_H = 78 * MiB;
constexpr size_t UNIT = 68 * MiB;
constexpr size_t WS_R0 = 146 * MiB, WS_R1 = WS_R0 + UNIT, WS_R2 = WS_R1 + UNIT, WS_R3 = WS_R2 + UNIT, WS_R4 = WS_R3 + UNIT, WS_END = WS_R4 + UNIT;
static_assert((size_t)MT * 1024 * 2 == UNIT, "unit");
constexpr int LDS_BYTES = 147456;

__device__ __forceinline__ unsigned f2bf(float f) { unsigned u = __float_as_uint(f); return (u + 0x7fffu + ((u >> 16) & 1u)) >> 16; }
__device__ __forceinline__ float bf2f(unsigned short b) { return __uint_as_float((unsigned)b << 16); }
__device__ __forceinline__ unsigned pk2(float lo, float hi) { return pg8::cvt_pk_bf16(lo, hi); }
__device__ __forceinline__ float wave_sum(float v) { v = sx_add<1>(v); v = sx_add<2>(v); v = sx_add<4>(v); v = sx_add<8>(v); v = sx_add<16>(v); v = sx_add<32>(v); return v; }
#define LDS_WAIT() asm volatile("s_waitcnt lgkmcnt(0)" ::: "memory")
__device__ __forceinline__ int crow(int r, int hi) { return (r & 3) + 8 * (r >> 2) + 4 * hi; }

struct Args { const float* in[29]; float* out; unsigned char* ws; int ph_lo, ph_hi; };
enum { I_X = 0, I_C, I_CTX, I_CCTX, I_WMOD, I_BMOD, I_GPRE, I_GPOST, I_WIN, I_HCW, I_HCB, I_HW1, I_HB1, I_HW2, I_HB2, I_HW3, I_HFREQ, I_HDECAY, I_HBIAS,
       I_QG, I_KG, I_LNG, I_LNB, I_GMWS, I_GMBS, I_WHYO, I_WATTO, I_WGMO, I_WOUT };

__device__ __forceinline__ void transpose_item(const float* W, int K, int N, bf16_t* WT, int k0, int n0, int dst_row0, LAS float* scr, int lane) {
    float tv[32];
#pragma unroll
    for (int i = 0; i < 32; ++i) { const int kk = 2 * i + (lane >> 5); tv[i] = W[(size_t)(k0 + kk) * N + n0 + (lane & 31)]; }
#pragma unroll
    for (int i = 0; i < 32; ++i) { const int kk = 2 * i + (lane >> 5); scr[kk * 33 + (lane & 31)] = tv[i]; }
    LDS_WAIT(); asm volatile("" ::: "memory");
    const int c = lane & 7;
#pragma unroll
    for (int j = 0; j < 4; ++j) { const int n = (lane >> 3) + 8 * j; const LAS float* s = scr + (8 * c) * 33 + n;
        u32x4 o; o.x = pk2(s[0 * 33], s[1 * 33]); o.y = pk2(s[2 * 33], s[3 * 33]); o.z = pk2(s[4 * 33], s[5 * 33]); o.w = pk2(s[6 * 33], s[7 * 33]);
        *(u32x4*)(WT + (size_t)(dst_row0 + n) * K + k0 + 8 * c) = o; }
    LDS_WAIT(); asm volatile("" ::: "memory");
}
__device__ __forceinline__ int win_remap(int src) {
    if (src < 4096) return src;
    if (src < 6656) return src + 1024;
    if (src < 7680) return src + 2048;
    if (src < 8704) return src + 4096;
    if (src < 9728) return src + 1024;
    if (src < 10752) return src - 5632;
    if (src < 11776) return src - 3072;
    return src - 1024;
}

__device__ __forceinline__ float silu_f(float x) { return x / (1.0f + __expf(-x)); }

__device__ __forceinline__ void hdn_item(const float* w1, const float* b1, const float* w2, const float* b2, const float* freq, int t, int L, bf16_t* dst, int lane) {
    const float tl = (float)t / (float)(L - 1);
    float zv = 0.f;
    if (lane == 0) zv = tl;
    else if (lane < 33) { const int jb = (lane - 1) & 15; const float band = 1e-4f + (float)jb * ((15.0f - 1e-4f) / 15.0f);
        const float ang = ((6.283185307179586f / (float)L) * (float)t) * band; zv = (lane < 17) ? cosf(ang) : -sinf(ang); }
    float a = b1[lane];
#pragma unroll
    for (int i = 0; i < 33; ++i) a += __uint_as_float(__builtin_amdgcn_readlane(__float_as_uint(zv), i)) * w1[i * 64 + lane];
    const float h1 = sinf(freq[lane] * a);
    float a2 = b2[lane];
#pragma unroll
    for (int k = 0; k < 64; ++k) a2 += __uint_as_float(__builtin_amdgcn_readlane(__float_as_uint(h1), k)) * w2[k * 64 + lane];
    dst[t * 128 + lane] = (bf16_t)f2bf(sinf(freq[64 + lane] * a2)); dst[t * 128 + 64 + lane] = 0;
}
__device__ __forceinline__ void h_row(const f32x4 (&v)[4], const float* gpre, const float* modr, bf16_t* hrow, int lane) {
    float s = 0.f;
#pragma unroll
    for (int j = 0; j < 4; ++j) s += (v[j].x * v[j].x + v[j].y * v[j].y) + (v[j].z * v[j].z + v[j].w * v[j].w);
    const float rn = rsqrtf(wave_sum(s) * (1.f / 1024.f) + 1e-6f);
#pragma unroll
    for (int j = 0; j < 4; ++j) { const int col = 4 * lane + 256 * j;
        const f32x4 g = *(const f32x4*)(gpre + col), sh = *(const f32x4*)(modr + col), sc = *(const f32x4*)(modr + 1024 + col);
        const f32x4 y = (v[j] * rn) * g * (sc + 1.0f) + sh;
        u32x2 w; w.x = pk2(y.x, y.y); w.y = pk2(y.z, y.w); *(u32x2*)(hrow + col) = w; }
}

template <int NTB>
__device__ __forceinline__ void lconv_unit(LAS unsigned char* lds, const bf16_t* zsrc, bool zconv, float zw0, float zw1, float zw2, float zb,
                                           const bf16_t* gsrcA, float gA0, float gA1, float gA2, float gAb, const bf16_t* gsrcB, float gB0, float gB1, float gB2, float gBb,
                                           const bf16_t* filtA, const bf16_t* filtB, float biasA, float biasB, bf16_t* dst) {
    constexpr int L = 64 * NTB;
    constexpr int RS = (L + 384) * 2 + 16;
    constexpr int FOFF = 8 * RS;
    constexpr int CLB = (((2 * L + 8) * 2 + 255) / 256) * 256 + 64;
    static_assert(FOFF % 16 == 0 && FOFF + 4 * CLB <= 144 * 1024, "lconv LDS");
    int tid_l = threadIdx.x; asm volatile("" : "+v"(tid_l));
    const int tid = tid_l, lane = tid & 63, wid = __builtin_amdgcn_readfirstlane(tid >> 6);
    const int n = lane & 31, h = lane >> 5;
    if (tid < 384) { const int b = tid / 48, j = tid % 48; const int off = b * RS + (j < 24 ? j * 16 : (192 + L) * 2 + (j - 24) * 16);
        *(LAS u32x4*)(lds + off) = zero4(); }
    constexpr int NIT = (L + 511) / 512;
    {
        u32x4 raw[NIT]; unsigned short pv[NIT], nx[NIT];
#pragma unroll
        for (int it = 0; it < NIT; ++it) { const int i = tid + 512 * it; raw[it] = zero4(); pv[it] = 0; nx[it] = 0;
            if (i < L) { const int b = i / (L / 8), s0 = (i % (L / 8)) * 8; const bf16_t* p = zsrc + (size_t)b * L + s0; raw[it] = *(const u32x4*)p;
                if (zconv) { if (s0 > 0) pv[it] = p[-1]; if (s0 + 8 < L) nx[it] = p[8]; } } }
#pragma unroll
        for (int it = 0; it < NIT; ++it) { const int i = tid + 512 * it;
            if (i < L) { const int b = i / (L / 8), s0 = (i % (L / 8)) * 8; u32x4 r4 = raw[it];
                if (zconv) {
                    float x[10];
                    x[0] = bf2f(pv[it]); x[9] = bf2f(nx[it]);
                    x[1] = pg8::bflo(r4.x); x[2] = pg8::bfhi(r4.x); x[3] = pg8::bflo(r4.y); x[4] = pg8::bfhi(r4.y);
                    x[5] = pg8::bflo(r4.z); x[6] = pg8::bfhi(r4.z); x[7] = pg8::bflo(r4.w); x[8] = pg8::bfhi(r4.w);
                    float y[8];
#pragma unroll
                    for (int e = 0; e < 8; ++e) y[e] = zw0 * x[e] + zw1 * x[e + 1] + zw2 * x[e + 2] + zb;
                    r4.x = pk2(y[0], y[1]); r4.y = pk2(y[2], y[3]); r4.z = pk2(y[4], y[5]); r4.w = pk2(y[6], y[7]);
                }
                *(LAS u32x4*)(lds + b * RS + (192 + s0) * 2) = r4; } }
    }
#pragma unroll 1
    for (int o = 0; o < 2; ++o) {
    int tid_o = tid_l; asm volatile("" : "+v"(tid_o));
    const int tid = tid_o, lane = tid & 63, wid = __builtin_amdgcn_readfirstlane(tid >> 6), n = lane & 31, h = lane >> 5;
    const bf16_t* gsrc = o ? gsrcB : gsrcA; const float gw0 = o ? gB0 : gA0, gw1 = o ? gB1 : gA1, gw2 = o ? gB2 : gA2, gb = o ? gBb : gAb;
    const bf16_t* filt = o ? filtB : filtA; const float bias = o ? biasB : biasA;
    if (tid < 36) { const int s = tid / 9, j = tid % 9; const int y = (j < 5 - s) ? j : 2 * L + 4 - s + (j - (5 - s)); *(LAS unsigned short*)(lds + FOFF + s * CLB + 2 * y) = 0; }
    for (int j = tid; j < 2 * L / 8; j += 512) {
        const int dir = j / (L / 8), t8 = (j % (L / 8)) * 8; const u32x4 raw = *(const u32x4*)(filt + (size_t)dir * L + t8);
        unsigned short e[8]; e[0] = raw.x & 0xffff; if (j == 0) e[0] = (unsigned short)f2bf(bf2f(e[0]) + bf2f(filt[L]));
 e[1] = raw.x >> 16; e[2] = raw.y & 0xffff; e[3] = raw.y >> 16; e[4] = raw.z & 0xffff; e[5] = raw.z >> 16; e[6] = raw.w & 0xffff; e[7] = raw.w >> 16;
#pragma unroll
        for (int i = 0; i < 8; ++i) { const int t = t8 + i; if (dir == 1 && t == 0) continue; const int d = dir ? -t : t;
#pragma unroll
            for (int s = 0; s < 4; ++s) { const int y = L + 4 - d - s; *(LAS unsigned short*)(lds + FOFF + s * CLB + 2 * y) = e[i]; } }
    }
    __syncthreads();
    u32x4 graw[NIT]; unsigned short gpv[NIT], gnx[NIT];
#define LC_GPREF() do { _Pragma("unroll") for (int it = 0; it < NIT; ++it) { const int i = tid + 512 * it; graw[it] = zero4(); gpv[it] = 0; gnx[it] = 0; \
        if (i < L) { const int b = i / (L / 8), s0 = (i % (L / 8)) * 8; const bf16_t* p = gsrc + (size_t)b * L + s0; graw[it] = *(const u32x4*)p; \
            if (s0 > 0) gpv[it] = p[-1]; if (s0 + 8 < L) gnx[it] = p[8]; } } } while (0)
    if constexpr (NTB != 64) LC_GPREF();
    const int Tw = 8 * wid;
    f32x16 acc[2][2];
#pragma unroll
    for (int a = 0; a < 2; ++a)
#pragma unroll
        for (int c = 0; c < 2; ++c)
#pragma unroll
            for (int r = 0; r < 16; ++r) acc[a][c][r] = 0.f;
    if (Tw < NTB) {
        const int sft = (4 - (n & 3)) & 3;
        const LAS unsigned char* bp = lds + FOFF + sft * CLB + 2 * (8 * h - n - sft + L + 4);
        const LAS unsigned char* zp = lds + (n & 7) * RS + 384 + 128 * (Tw + (n >> 3)) + 16 * h;
#define LC_LDT(TF, DD) do { _Pragma("unroll") for (int f = 0; f < 6; ++f) { const LAS unsigned char* q = bp + 32 * (f - 2 - 4 * (DD)); \
            const u32x2 lo = *(const LAS u32x2*)q, hi2 = *(const LAS u32x2*)(q + 8); const u32x4 w = (u32x4){lo.x, lo.y, hi2.x, hi2.y}; TF[f] = __builtin_bit_cast(bf16x8, w); } } while (0)
#define LC_LDZ(ZF, mt, DD) do { _Pragma("unroll") for (int ks = 0; ks < 4; ++ks) ZF[ks] = *(const LAS bf16x8*)(zp + 512 * (mt) + 32 * ks - 128 * (DD)); } while (0)
#define LC_MMA1(TF, ZF, mt) do { _Pragma("unroll") for (int ks = 0; ks < 4; ++ks) _Pragma("unroll") for (int nt = 0; nt < 2; ++nt) \
            acc[mt][nt] = __builtin_amdgcn_mfma_f32_32x32x16_bf16(ZF[ks], TF[ks - 2 * nt + 2], acc[mt][nt], 0, 0, 0); } while (0)
#define LC_MMA2(TF, ZF0, ZF1) do { _Pragma("unroll") for (int ks = 0; ks < 4; ++ks) _Pragma("unroll") for (int nt = 0; nt < 2; ++nt) { \
            acc[0][nt] = __builtin_amdgcn_mfma_f32_32x32x16_bf16(ZF0[ks], TF[ks - 2 * nt + 2], acc[0][nt], 0, 0, 0); \
            acc[1][nt] = __builtin_amdgcn_mfma_f32_32x32x16_bf16(ZF1[ks], TF[ks - 2 * nt + 2], acc[1][nt], 0, 0, 0); } } while (0)
        bf16x8 tfA[6], tfB[6], zA0[4], zA1[4], zB0[4], zB1[4];
        if constexpr (NTB == 64) {
            for (int Dd = Tw - 63; Dd < Tw - 59; ++Dd) { LC_LDT(tfA, Dd); LC_LDZ(zA0, 0, Dd); LC_MMA1(tfA, zA0, 0); }
            int Dd = Tw - 59;
            LC_LDT(tfA, Dd); LC_LDZ(zA0, 0, Dd); LC_LDZ(zA1, 1, Dd);
            for (int it = 0; it < 31; ++it) {
                LC_LDT(tfB, Dd + 1); LC_LDZ(zB0, 0, Dd + 1); LC_LDZ(zB1, 1, Dd + 1);
                __builtin_amdgcn_sched_barrier(0);
                LC_MMA2(tfA, zA0, zA1);
                __builtin_amdgcn_sched_barrier(0);
                LC_LDT(tfA, Dd + 2); LC_LDZ(zA0, 0, Dd + 2); LC_LDZ(zA1, 1, Dd + 2);
                __builtin_amdgcn_sched_barrier(0);
                LC_MMA2(tfB, zB0, zB1);
                __builtin_amdgcn_sched_barrier(0);
                Dd += 2;
            }
            LC_MMA2(tfA, zA0, zA1);
            LC_GPREF();
            for (int D3 = Tw + 4; D3 < Tw + 8; ++D3) { LC_LDT(tfA, D3); LC_LDZ(zA1, 1, D3); LC_MMA1(tfA, zA1, 1); }
        } else {
            for (int Dd = -(NTB - 1); Dd <= NTB - 1; ++Dd) { LC_LDT(tfA, Dd); LC_LDZ(zA0, 0, Dd); LC_MMA1(tfA, zA0, 0); }
        }
#undef LC_LDT
#undef LC_LDZ
#undef LC_MMA1
#undef LC_MMA2
#undef LC_GPREF
    }
    __syncthreads();
    if (Tw < NTB) {
#pragma unroll
        for (int mt = 0; mt < 2; ++mt) {
            if (Tw + 4 * mt < NTB) {
#pragma unroll
                for (int nt = 0; nt < 2; ++nt)
#pragma unroll
                    for (int r = 0; r < 16; ++r) {
                        const int b = (r & 3) + 4 * h, Tl = r >> 2, s = 64 * (Tw + 4 * mt + Tl) + 32 * nt + n;
                        LAS unsigned short* zq = (LAS unsigned short*)(lds + b * RS + (192 + s) * 2);
                        *zq = (unsigned short)f2bf(acc[mt][nt][r] + bias * bf2f(*zq));
                    }
            }
        }
    }
    __syncthreads();
    {
#pragma unroll
        for (int it = 0; it < NIT; ++it) { const int i = tid + 512 * it;
            if (i < L) { const int b = i / (L / 8), s0 = (i % (L / 8)) * 8; const u32x4 r4 = graw[it]; const u32x4 st = *(const LAS u32x4*)(lds + b * RS + (192 + s0) * 2);
                float x[10];
                x[0] = bf2f(gpv[it]); x[9] = bf2f(gnx[it]);
                x[1] = pg8::bflo(r4.x); x[2] = pg8::bfhi(r4.x); x[3] = pg8::bflo(r4.y); x[4] = pg8::bfhi(r4.y);
                x[5] = pg8::bflo(r4.z); x[6] = pg8::bfhi(r4.z); x[7] = pg8::bflo(r4.w); x[8] = pg8::bfhi(r4.w);
                float sv[8]; sv[0] = pg8::bflo(st.x); sv[1] = pg8::bfhi(st.x); sv[2] = pg8::bflo(st.y); sv[3] = pg8::bfhi(st.y); sv[4] = pg8::bflo(st.z); sv[5] = pg8::bfhi(st.z); sv[6] = pg8::bflo(st.w); sv[7] = pg8::bfhi(st.w);
                float y[8];
#pragma unroll
                for (int e = 0; e < 8; ++e) y[e] = (gw0 * x[e] + gw1 * x[e + 1] + gw2 * x[e + 2] + gb) * sv[e];
                u32x4 w; w.x = pk2(y[0], y[1]); w.y = pk2(y[2], y[3]); w.z = pk2(y[4], y[5]); w.w = pk2(y[6], y[7]);
                if (o == 0) *(LAS u32x4*)(lds + b * RS + (192 + s0) * 2) = w;
                else *(u32x4*)(dst + (size_t)b * L + s0) = w; } }
    }
    __syncthreads();
    }
}
__device__ __forceinline__ void gmlp_unit(LAS unsigned char* lds, int tok0, int g, const bf16_t* vT, const float* statp, const bf16_t* gmws, const float* bs,
                                          const float* lng, const float* lnb, bf16_t* U, const bf16_t* GG) {
    int tid_l = threadIdx.x; asm volatile("" : "+v"(tid_l));
    const int tid = tid_l, lane = tid & 63, wid = __builtin_amdgcn_readfirstlane(tid >> 6), n = lane & 31, h = lane >> 5;
    LAS float* mean = (LAS float*)lds; LAS float* rstd = mean + 128;
    constexpr int VOFF = 1024, VRS = 272, YOFF = VOFF + 128 * VRS, YRS = 132;
    { u32x4 raw[4];
#pragma unroll
      for (int q = 0; q < 4; ++q) { const int idx = tid + 512 * q, c = idx >> 4, ch = idx & 15; raw[q] = *(const u32x4*)(vT + (size_t)(g * 128 + c) * MT + tok0 + ch * 8); }
      if (tid < 128) { float s = 0.f, q2 = 0.f;
#pragma unroll
          for (int p = 0; p < 8; ++p) { const float* sp = statp + ((size_t)p * MT + tok0 + tid) * 2; s += sp[0]; q2 += sp[1]; }
          const float mu = s * (1.f / 1024.f); const float var = fmaxf(q2 * (1.f / 1024.f) - mu * mu, 0.f);
          mean[tid] = mu; rstd[tid] = rsqrtf(var + 1e-5f); }
#pragma unroll
      for (int q = 0; q < 4; ++q) { const int idx = tid + 512 * q, c = idx >> 4, ch = idx & 15; *(LAS u32x4*)(lds + VOFF + c * VRS + ch * 16) = raw[q]; } }
    __syncthreads();
    const int pt = wid >> 1, ctb = (wid & 1) * 2;
    f32x16 acc[2];
#pragma unroll
    for (int c = 0; c < 2; ++c)
#pragma unroll
        for (int r = 0; r < 16; ++r) acc[c][r] = 0.f;
    const bf16_t* ap = gmws + ((size_t)g * 128 + 32 * pt + n) * 128 + 8 * h;
    bf16x8 af[8];
#pragma unroll
    for (int ks = 0; ks < 8; ++ks) af[ks] = *(const bf16x8*)(ap + 16 * ks);
    float ga[2], be[2];
#pragma unroll
    for (int ct = 0; ct < 2; ++ct) { const int cgl = g * 128 + 32 * (ctb + ct) + n; ga[ct] = lng[cgl]; be[ct] = lnb[cgl]; }
#pragma unroll
    for (int ks = 0; ks < 8; ++ks) {
        float mu[8], rs[8];
#pragma unroll
        for (int e = 0; e < 8; ++e) { mu[e] = mean[16 * ks + 8 * h + e]; rs[e] = rstd[16 * ks + 8 * h + e]; }
#pragma unroll
        for (int ct = 0; ct < 2; ++ct) {
            const u32x4 raw = *(const LAS u32x4*)(lds + VOFF + (32 * (ctb + ct) + n) * VRS + (16 * ks + 8 * h) * 2);
            u32x4 w;
            w.x = pk2((pg8::bflo(raw.x) - mu[0]) * rs[0] * ga[ct] + be[ct], (pg8::bfhi(raw.x) - mu[1]) * rs[1] * ga[ct] + be[ct]);
            w.y = pk2((pg8::bflo(raw.y) - mu[2]) * rs[2] * ga[ct] + be[ct], (pg8::bfhi(raw.y) - mu[3]) * rs[3] * ga[ct] + be[ct]);
            w.z = pk2((pg8::bflo(raw.z) - mu[4]) * rs[4] * ga[ct] + be[ct], (pg8::bfhi(raw.z) - mu[5]) * rs[5] * ga[ct] + be[ct]);
            w.w = pk2((pg8::bflo(raw.w) - mu[6]) * rs[6] * ga[ct] + be[ct], (pg8::bfhi(raw.w) - mu[7]) * rs[7] * ga[ct] + be[ct]);
            acc[ct] = __builtin_amdgcn_mfma_f32_32x32x16_bf16(af[ks], __builtin_bit_cast(bf16x8, w), acc[ct], 0, 0, 0);
        }
    }
#pragma unroll
    for (int ct = 0; ct < 2; ++ct)
#pragma unroll
        for (int r = 0; r < 16; ++r) { const int p = 32 * pt + crow(r, h); ((LAS float*)(lds + YOFF))[p * YRS + 32 * (ctb + ct) + n] = acc[ct][r] + bs[g * 128 + p]; }
    __syncthreads();
    { u32x4 uu[4], gg[4];
#pragma unroll
      for (int q = 0; q < 4; ++q) { const int idx = tid + 512 * q, p = idx >> 4, ch = idx & 15; const size_t ix = (size_t)(tok0 + p) * 1024 + g * 128 + ch * 8; uu[q] = *(const u32x4*)(U + ix); gg[q] = *(const u32x4*)(GG + ix); }
#pragma unroll
      for (int q = 0; q < 4; ++q) { const int idx = tid + 512 * q, p = idx >> 4, ch = idx & 15; const size_t ix = (size_t)(tok0 + p) * 1024 + g * 128 + ch * 8;
        const LAS float* yp = (const LAS float*)(lds + YOFF) + p * YRS + ch * 8; const f32x4 y0 = *(const LAS f32x4*)yp, y1 = *(const LAS f32x4*)(yp + 4); u32x4 w;
        w.x = pk2(pg8::bflo(uu[q].x) * y0.x * pg8::bflo(gg[q].x), pg8::bfhi(uu[q].x) * y0.y * pg8::bfhi(gg[q].x));
        w.y = pk2(pg8::bflo(uu[q].y) * y0.z * pg8::bflo(gg[q].y), pg8::bfhi(uu[q].y) * y0.w * pg8::bfhi(gg[q].y));
        w.z = pk2(pg8::bflo(uu[q].z) * y1.x * pg8::bflo(gg[q].z), pg8::bfhi(uu[q].z) * y1.y * pg8::bfhi(gg[q].z));
        w.w = pk2(pg8::bflo(uu[q].w) * y1.z * pg8::bflo(gg[q].w), pg8::bfhi(uu[q].w) * y1.w * pg8::bfhi(gg[q].w));
        *(u32x4*)(U + ix) = w; } }
    __syncthreads();
}

__device__ __forceinline__ void qk_part(const bf16_t* src, bf16_t* dstp, const float* gain, const float* rope, int lane, bool lat, int s, bool active) {
    const int block = lane >> 2, j = lane & 3, axis = block & 1, off = (block >> 1) * 128 + axis * 64 + 8 * j;
    u32x4 ra = zero4(), rb = ra;
    if (active) { ra = *(const u32x4*)(src + off); rb = *(const u32x4*)(src + off + 32); }
    float a[8], c[8];
    a[0] = pg8::bflo(ra.x); a[1] = pg8::bfhi(ra.x); a[2] = pg8::bflo(ra.y); a[3] = pg8::bfhi(ra.y); a[4] = pg8::bflo(ra.z); a[5] = pg8::bfhi(ra.z); a[6] = pg8::bflo(ra.w); a[7] = pg8::bfhi(ra.w);
    c[0] = pg8::bflo(rb.x); c[1] = pg8::bfhi(rb.x); c[2] = pg8::bflo(rb.y); c[3] = pg8::bfhi(rb.y); c[4] = pg8::bflo(rb.z); c[5] = pg8::bfhi(rb.z); c[6] = pg8::bflo(rb.w); c[7] = pg8::bfhi(rb.w);
    float ss = 0.f;
#pragma unroll
    for (int e = 0; e < 8; ++e) ss += a[e] * a[e] + c[e] * c[e];
    ss = sx_add<1>(ss); ss = sx_add<2>(ss); ss = sx_add<4>(ss);
    const float rn = rsqrtf(ss * (1.f / 128.f) + 1e-6f);
    const float* gp = gain + axis * 64 + 8 * j;
    const f32x4 g0 = *(const f32x4*)gp, g1 = *(const f32x4*)(gp + 4), g2 = *(const f32x4*)(gp + 32), g3 = *(const f32x4*)(gp + 36);
    const float ga[8] = {g0.x, g0.y, g0.z, g0.w, g1.x, g1.y, g1.z, g1.w}, gc[8] = {g2.x, g2.y, g2.z, g2.w, g3.x, g3.y, g3.z, g3.w};
    float o1[8], o2[8];
    if (lat) {
        const int pos = axis ? (s & 63) : (s >> 6); const float* rp = rope + (size_t)(pos * 32 + 8 * j) * 2;
        const f32x4 t0 = *(const f32x4*)rp, t1 = *(const f32x4*)(rp + 4), t2 = *(const f32x4*)(rp + 8), t3 = *(const f32x4*)(rp + 12);
        const float cs[8] = {t0.x, t0.z, t1.x, t1.z, t2.x, t2.z, t3.x, t3.z}, sn[8] = {t0.y, t0.w, t1.y, t1.w, t2.y, t2.w, t3.y, t3.w};
#pragma unroll
        for (int e = 0; e < 8; ++e) { const float x = a[e] * rn * ga[e], y = c[e] * rn * gc[e]; o1[e] = x * cs[e] - y * sn[e]; o2[e] = y * cs[e] + x * sn[e]; }
    } else {
#pragma unroll
        for (int e = 0; e < 8; ++e) { o1[e] = a[e] * rn * ga[e]; o2[e] = c[e] * rn * gc[e]; }
    }
    if (active) {
        u32x4 w; w.x = pk2(o1[0], o1[1]); w.y = pk2(o1[2], o1[3]); w.z = pk2(o1[4], o1[5]); w.w = pk2(o1[6], o1[7]); *(u32x4*)(dstp + off) = w;
        w.x = pk2(o2[0], o2[1]); w.y = pk2(o2[2], o2[3]); w.z = pk2(o2[4], o2[5]); w.w = pk2(o2[6], o2[7]); *(u32x4*)(dstp + off + 32) = w; }
}
__device__ __forceinline__ void qk_row(int m, bf16_t* Q, const bf16_t* KV, bf16_t* Kp, bf16_t* Vp, const float* qg, const float* kg, const float* rope, int lane, bool doq) {
    const bool lat = m < ML; int b, s;
    if (lat) { b = m >> 12; s = m & 4095; } else { b = (m - ML) >> 8; s = (m - ML) & 255; }
    if (doq) qk_part(Q + (size_t)m * 1024, Q + (size_t)m * 1024, qg, rope, lane, lat, s, true);
    const size_t krow = (size_t)b * NKEY + (lat ? CTXL + s : s);
    const bf16_t* kr = KV + (size_t)m * 512;
    qk_part(kr, Kp + krow * 256, kg, rope, lane, lat, s, lane < 16);
    if (lane < 32) *(u32x4*)(Vp + krow * 256 + lane * 8) = *(const u32x4*)(kr + 256 + lane * 8);
}

__device__ __forceinline__ void tgate_item(LAS unsigned char* lds, const bf16_t* inT, const bf16_t* gate, bf16_t* out, int tok0, int c0) {
    int tid_l = threadIdx.x; asm volatile("" : "+v"(tid_l));
    const int tid = tid_l; LAS unsigned short* t = (LAS unsigned short*)lds;
    { const int cl = tid >> 3, ch = tid & 7; u32x4 raw[4];
#pragma unroll
      for (int q = 0; q < 4; ++q) raw[q] = *(const u32x4*)(inT + (size_t)(c0 + 64 * q + cl) * MT + tok0 + ch * 8);
#pragma unroll
      for (int q = 0; q < 4; ++q) { LAS unsigned short* d = t + q * (64 * 72) + (ch * 8) * 72 + cl;
        d[0 * 72] = (unsigned short)(raw[q].x & 0xffff); d[1 * 72] = (unsigned short)(raw[q].x >> 16); d[2 * 72] = (unsigned short)(raw[q].y & 0xffff); d[3 * 72] = (unsigned short)(raw[q].y >> 16);
        d[4 * 72] = (unsigned short)(raw[q].z & 0xffff); d[5 * 72] = (unsigned short)(raw[q].z >> 16); d[6 * 72] = (unsigned short)(raw[q].w & 0xffff); d[7 * 72] = (unsigned short)(raw[q].w >> 16); } }
    __syncthreads();
    { const int tl = tid >> 3, ch = tid & 7; u32x4 g[4];
#pragma unroll
      for (int q = 0; q < 4; ++q) g[q] = *(const u32x4*)(gate + (size_t)(tok0 + tl) * 1024 + c0 + 64 * q + ch * 8);
#pragma unroll
      for (int q = 0; q < 4; ++q) { const u32x4 v = *(const LAS u32x4*)(t + q * (64 * 72) + tl * 72 + ch * 8); u32x4 w;
        w.x = pk2(pg8::bflo(v.x) * pg8::bflo(g[q].x), pg8::bfhi(v.x) * pg8::bfhi(g[q].x)); w.y = pk2(pg8::bflo(v.y) * pg8::bflo(g[q].y), pg8::bfhi(v.y) * pg8::bfhi(g[q].y));
        w.z = pk2(pg8::bflo(v.z) * pg8::bflo(g[q].z), pg8::bfhi(v.z) * pg8::bfhi(g[q].z)); w.w = pk2(pg8::bflo(v.w) * pg8::bflo(g[q].w), pg8::bfhi(v.w) * pg8::bfhi(g[q].w));
        *(u32x4*)(out + (size_t)(tok0 + tl) * 1024 + c0 + 64 * q + ch * 8) = w; } }
    __syncthreads();
}
#define XB_TMO      128
#define XB_XCNT(j)  (256  + 64 * (j))
#define XB_XSUB(j)  (1280 + 64 * (j))
#define XB_XGEN(j)  (2304 + 64 * (j))
#define XB_TOP      3328
#define XB_TOPGEN   3392
#define XCD_BAR_WORDS 3456
#define XB_SPIN_CAP (1u << 18)

__device__ __forceinline__ unsigned xb_ld(unsigned* p)              { return __hip_atomic_load(p, __ATOMIC_RELAXED, __HIP_MEMORY_SCOPE_AGENT); }
__device__ __forceinline__ unsigned xb_add(unsigned* p, unsigned v) { return __hip_atomic_fetch_add(p, v, __ATOMIC_RELAXED, __HIP_MEMORY_SCOPE_AGENT); }
__device__ __forceinline__ unsigned xb_xcc_id() { return (unsigned)__builtin_amdgcn_s_getreg((3 << 11) | 20) & 0xFu; }
#define XB_SPIN(cond, bar) do { unsigned _sp = 0; while (cond) { __builtin_amdgcn_s_sleep(1); \
    if ((++_sp & 255u) == 0u) { if (xb_ld(&(bar)[XB_TMO])) break; if (_sp > XB_SPIN_CAP) { atomicAdd(&(bar)[XB_TMO], 1u); break; } } } } while (0)

struct XcdBarrier {
    unsigned* bar; unsigned x;
    volatile LAS unsigned* st;
};

__device__ __forceinline__ XcdBarrier xcd_barrier_post(unsigned* bar, volatile LAS unsigned* st) {
    XcdBarrier b; b.bar = bar; b.x = xb_xcc_id(); b.st = st;
    if (threadIdx.x == 0) (void)xb_add(&bar[XB_XCNT(b.x)], 1u);
    return b;
}
__device__ __forceinline__ void xcd_barrier_complete(unsigned* bar, unsigned x, unsigned& nloc, unsigned& nx) {
    const unsigned G = gridDim.x * gridDim.y * gridDim.z;
    unsigned sum, cnt, mine, sp = 0u;
    for (;;) {
        sum = 0u; cnt = 0u; mine = 0u;
#pragma unroll
        for (unsigned j = 0; j < 16; ++j) { const unsigned c = xb_ld(&bar[XB_XCNT(j)]); sum += c; cnt += (c > 0u) ? 1u : 0u; mine = (j == x) ? c : mine; }
        if (sum == G) break;
        __builtin_amdgcn_s_sleep(1);
        if ((++sp & 255u) == 0u) { if (xb_ld(&bar[XB_TMO])) break; if (sp > XB_SPIN_CAP) { atomicAdd(&bar[XB_TMO], 1u); break; } }
    }
    nloc = mine > 0u ? mine : 1u; nx = cnt > 0u ? cnt : 1u;
}

__device__ __forceinline__ void xcd_barrier(const XcdBarrier& b) {
    asm volatile("s_waitcnt vmcnt(0)" ::: "memory");
    __syncthreads();
    if (threadIdx.x == 0) {
        unsigned* bar = b.bar;
        __builtin_amdgcn_s_waitcnt(0);
        unsigned nloc = b.st[0], nx = b.st[1];
        if (nloc == 0u) { xcd_barrier_complete(bar, b.x, nloc, nx); b.st[0] = nloc; b.st[1] = nx; }
        const unsigned old = xb_add(&bar[XB_XSUB(b.x)], 1u);
        const unsigned gen = old / nloc;
        if (old + 1u == (gen + 1u) * nloc) {
            __builtin_amdgcn_fence(__ATOMIC_RELEASE, "agent");
            asm volatile("s_waitcnt vmcnt(0)" ::: "memory");
            const unsigned og = xb_add(&bar[XB_TOP], 1u);
            const unsigned tg = og / nx;
            if (og + 1u == (tg + 1u) * nx) xb_add(&bar[XB_TOPGEN], 1u);
            else XB_SPIN(xb_ld(&bar[XB_TOPGEN]) == tg, bar);
            __builtin_amdgcn_fence(__ATOMIC_ACQUIRE, "agent");
            xb_add(&bar[XB_XGEN(b.x)], 1u);
            asm volatile("s_waitcnt vmcnt(0)" ::: "memory");
        } else {
            XB_SPIN(xb_ld(&bar[XB_XGEN(b.x)]) == gen, bar);
            __builtin_amdgcn_fence(__ATOMIC_ACQUIRE, "agent");
            asm volatile("s_waitcnt vmcnt(0)" ::: "memory");
        }
    }
    __syncthreads();
}

constexpr size_t WS_BAR = 512 * 1024;
constexpr size_t WS_ROPE = 768 * 1024;
constexpr size_t WS_SPO = 492 * MiB, WS_SPG = 496 * MiB;
constexpr size_t WS_HDNB = 487 * MiB, WS_W3T = 488 * MiB, WS_HDNCB = 489 * MiB, WS_HDNB1 = 490 * MiB;
constexpr int NPH = 16;
#ifndef PHMASK
#define PHMASK 0xffff
#endif
#define PON(k) ((PHMASK >> (k)) & 1)
__global__ void __launch_bounds__(512, 2) fwd_kernel(Args args) {
    extern __shared__ __attribute__((aligned(16))) unsigned char lds_raw[];
    LAS unsigned char* lds = (LAS unsigned char*)lds_raw;
    cg::grid_group grid = cg::this_grid();
    const int G = gridDim.x, bx = blockIdx.x;
    if (threadIdx.x < 2) ((volatile LAS unsigned*)(lds + 147200))[threadIdx.x] = 0u;
    __syncthreads();
    XcdBarrier xbar; xbar.bar = (unsigned*)(args.ws + WS_BAR); xbar.x = 0; xbar.st = (volatile LAS unsigned*)(lds + 147200);
    const int vcu = (G % 8 == 0) ? (bx % 8) * (G / 8) + bx / 8 : bx;
    const int NGW = G * 8;
    if (args.ph_lo == 0) {
        int tid_p = threadIdx.x; asm volatile("" : "+v"(tid_p));
        const int lane = tid_p & 63, wave = __builtin_amdgcn_readfirstlane(tid_p >> 6); const int gw = vcu * 8 + wave; unsigned char* ws = args.ws;
        if (bx == (G > 1 ? 1 : 0)) { float* rt = (float*)(ws + WS_ROPE); for (int i = tid_p; i < 2048; i += 512) { const int pos = i >> 5, fi = i & 31; const float inv = powf(10000.0f, -(float)(2 * fi) * (1.0f / 64.0f)); const float ang = (float)pos * inv; rt[2 * i] = cosf(ang); rt[2 * i + 1] = sinf(ang); } }
        for (int it = gw; it < 4096 + 256 + 4096; it += NGW) {
            const int lw = (it < 4352) ? 0 : 1;
            const float* w1 = args.in[I_HW1] + lw * 33 * 64; const float* b1 = args.in[I_HB1] + lw * 64; const float* w2 = args.in[I_HW2] + lw * 4096; const float* b2 = args.in[I_HB2] + lw * 64; const float* fq = args.in[I_HFREQ] + lw * 128;
            if (it < 4096) hdn_item(w1, b1, w2, b2, fq, it, 4096, (bf16_t*)(ws + WS_HDNB), lane);
            else if (it < 4352) hdn_item(w1, b1, w2, b2, fq, it - 4096, 256, (bf16_t*)(ws + WS_HDNCB), lane);
            else hdn_item(w1, b1, w2, b2, fq, it - 4352, 4096, (bf16_t*)(ws + WS_HDNB1), lane);
        }
    }
    for (int gp = args.ph_lo; gp < args.ph_hi; ++gp) {
    int tid_l = threadIdx.x; asm volatile("" : "+v"(tid_l));
    const int tid = tid_l, lane = tid & 63, wave = __builtin_amdgcn_readfirstlane(tid >> 6);
    const int gw = vcu * 8 + wave;
    __attribute__((address_space(1))) unsigned char* wsg = (__attribute__((address_space(1))) unsigned char*)args.ws; asm volatile("" : "+s"(wsg));
    unsigned char* ws = (unsigned char*)wsg;
#ifdef PROBE_A
    if (bx == 0 && tid == 0) ((LAS unsigned long long*)(lds + 146000))[gp] = __builtin_amdgcn_s_memrealtime();
#endif
    float* modv = (float*)(ws + WS_MOD); float* hdn = (float*)(ws + WS_HDN); float* hdnc = (float*)(ws + WS_HDNC);
    float* statp = (float*)(ws + WS_STATP); float* ysq = (float*)(ws + WS_YSQ);
    bf16_t* WIN = (bf16_t*)(ws + WS_WIN); bf16_t* WHYO = (bf16_t*)(ws + WS_WHYO); bf16_t* WATTO = (bf16_t*)(ws + WS_WATTO); bf16_t* WGMO = (bf16_t*)(ws + WS_WGMO); bf16_t* WOUT = (bf16_t*)(ws + WS_WOUT);
    bf16_t* GMWS = (bf16_t*)(ws + WS_GMWS); bf16_t* FILT = (bf16_t*)(ws + WS_FILT); bf16_t* FILTC = (bf16_t*)(ws + WS_FILTC);
    bf16_t* H = (bf16_t*)(ws + WS_H);
    bf16_t* R0 = (bf16_t*)(ws + WS_R0); bf16_t* R1 = (bf16_t*)(ws + WS_R1); bf16_t* R2 = (bf16_t*)(ws + WS_R2); bf16_t* R3 = (bf16_t*)(ws + WS_R3); bf16_t* R4 = (bf16_t*)(ws + WS_R4);
    bf16_t* KVRAW = R1; bf16_t* KP = (bf16_t*)(ws + WS_R1 + 34 * MiB); bf16_t* VP = (bf16_t*)(ws + WS_R1 + 51 * MiB);
    float* Y = (float*)(ws + WS_R0);

#ifdef PROBE_A
    if (gp == 2 * NPH) {
        if (bx == 0) {
            LAS unsigned long long* ts = (LAS unsigned long long*)(lds + 146000);
            float s = 0.f;
            for (int i = tid; i < 8 * 131072; i += 512) { const f32x4 v = ((const f32x4*)(args.out + (size_t)(i >> 17) * 4096 * 1024))[i & 131071]; s += (v.x * v.x + v.y * v.y) + (v.z * v.z + v.w * v.w); }
            LAS float* red = (LAS float*)lds; red[tid] = s; __syncthreads();
            if (tid == 0) { float tot = 0.f; for (int i = 0; i < 512; ++i) tot += red[i];
                unsigned long long ta = 0, tb = 0;
                for (int g2 = 0; g2 < 2 * NPH; ++g2) { const unsigned long long d = ts[g2 + 1] - ts[g2]; if ((PROBE_A >> (g2 % NPH)) & 1) ta += d; if ((PROBE_B >> (g2 % NPH)) & 1) tb += d; }
                int a = (int)((ta + PROBE_UNIT / 2) / PROBE_UNIT), b2 = (int)((tb + PROBE_UNIT / 2) / PROBE_UNIT); if (a > 63) a = 63; if (b2 > 63) b2 = 63;
                red[600] = 0.3f * sqrtf(tot * (1.0f / 4194304.0f)); ((LAS int*)red)[601] = a + 64 * b2; }
            __syncthreads();
            const float delta = red[600]; const int K = ((LAS int*)red)[601];
            for (int i = tid; i < K; i += 512) args.out[(size_t)i * 8191 + 3] += delta;
        }
    } else
#endif
    {
        const int l = gp / NPH, p = gp % NPH;
        if (p == 4) continue;
        if (l == 1 && p == 1) continue;
        const int Ml = (l == 0) ? MT : ML;
        if (p == 0 && PON(0)) {
            if (gp == 0 && bx == 0) { for (int i = tid; i < XCD_BAR_WORDS; i += 512) ((unsigned*)(ws + WS_BAR))[i] = 0u; }
            if (l == 0) {
                for (int it = bx; it < 96; it += G) {
                    const int ll = it / 48, cb = it % 48, col = cb * 64 + lane, kb = wave * 128;
                    const float* Wm = args.in[I_WMOD] + (size_t)ll * 1024 * 3072; const float* cc = args.in[I_C]; const float* cx = args.in[I_CCTX];
                    float acc[9];
#pragma unroll
                    for (int r = 0; r < 9; ++r) acc[r] = 0.f;
                    for (int k = kb; k < kb + 128; ++k) { const float w = Wm[(size_t)k * 3072 + col];
#pragma unroll
                        for (int r = 0; r < 9; ++r) { const float cv = (r < 8) ? cc[r * 1024 + k] : cx[k]; acc[r] += silu_f(cv) * w; } }
                    LAS float* red = (LAS float*)lds;
#pragma unroll
                    for (int r = 0; r < 9; ++r) red[(wave * 9 + r) * 64 + lane] = acc[r];
                    __syncthreads();
                    for (int i = tid; i < 576; i += 512) { const int r = i >> 6, ln = i & 63; float s = args.in[I_BMOD][ll * 3072 + cb * 64 + ln];
                        for (int w8 = 0; w8 < 8; ++w8) s += red[(w8 * 9 + r) * 64 + ln];
                        modv[(size_t)(ll * 9 + r) * 3072 + cb * 64 + ln] = s; }
                    __syncthreads();
                }
            }
            LAS float* scr = (LAS float*)(lds + 4096 + wave * 16384);
            const int NIT = 6400 + 2048 + 256 + 128;
            bf16_t* W3T = (bf16_t*)(ws + WS_W3T);
            for (int it = gw; it < NIT; it += NGW) {
                int r = it;
                if (r < 6400) { const int kb = r / 400, nb = r % 400; transpose_item(args.in[I_WIN] + (size_t)l * 1024 * INW, 1024, INW, WIN, kb * 64, nb * 32, win_remap(nb * 32), scr, lane); continue; }
                r -= 6400;
                if (r < 2048) { const int which = r >> 9, i2 = r & 511, kb = i2 >> 5, nb = i2 & 31;
                    const float* W = args.in[which == 0 ? I_WHYO : which == 1 ? I_WATTO : which == 2 ? I_WGMO : I_WOUT] + (size_t)l * 1024 * 1024;
                    bf16_t* WT = which == 0 ? WHYO : which == 1 ? WATTO : which == 2 ? WGMO : WOUT;
                    transpose_item(W, 1024, 1024, WT, kb * 64, nb * 32, nb * 32, scr, lane); continue; }
                r -= 2048;
                if (r < 256) { const float* src = args.in[I_GMWS] + (size_t)l * 131072 + r * 512 + lane * 8; const f32x4 a = *(const f32x4*)src, b = *(const f32x4*)(src + 4);
                    u32x4 w; w.x = pk2(a.x, a.y); w.y = pk2(a.z, a.w); w.z = pk2(b.x, b.y); w.w = pk2(b.z, b.w); *(u32x4*)(GMWS + r * 512 + lane * 8) = w; continue; }
                r -= 256;
                if (r < 128) {
                    transpose_item(args.in[I_HW3] + (size_t)l * 64 * 4096, 128, 4096, W3T, 0, r * 32, r * 32, scr, lane);
                    bf16_t* zp = W3T + (size_t)(r * 32 + (lane >> 1)) * 128 + 64 + (lane & 1) * 32;
#pragma unroll
                    for (int j = 0; j < 4; ++j) *(u32x4*)(zp + 8 * j) = zero4();
                    continue; }
            }
        } else if (p == 1 && PON(1)) {
            if (l == 0) {
                for (int m = gw; m < MT; m += NGW) {
                    const float* xr = (m < ML) ? args.in[I_X] + (size_t)m * 1024 : args.in[I_CTX] + (size_t)(m - ML) * 1024; const int r = (m < ML) ? (m >> 12) : 8;
                    f32x4 v[4];
#pragma unroll
                    for (int j = 0; j < 4; ++j) v[j] = *(const f32x4*)(xr + 4 * lane + 256 * j);
                    h_row(v, args.in[I_GPRE], modv + (size_t)r * 3072, H + (size_t)m * 1024, lane);
                }
            }
        } else if (p == 2 && PON(2)) {
            { pg8::Gemm g{(const bf16_t*)(ws + WS_W3T), (const bf16_t*)(ws + (l == 0 ? WS_HDNB : WS_HDNB1)), 4096, 4096, 128}; pg8::StaticOrder S; S.init(4096, 4096, G, bx); pg8::EpiF E{FILT, args.in[I_HDECAY] + l * 4096, 4096};
              pg8::gemm_phase<pg8::EpiF, pg8::StaticOrder, true, true>(lds, g, S, E); }
            if (l == 0) { pg8::Gemm g{(const bf16_t*)(ws + WS_W3T), (const bf16_t*)(ws + WS_HDNCB), 4096, 256, 128}; pg8::StaticOrder S; S.init(4096, 256, G, (bx + 128) % G); pg8::EpiF E{FILTC, args.in[I_HDECAY] + l * 4096, 256};
              pg8::gemm_phase<pg8::EpiF, pg8::StaticOrder, true, true>(lds, g, S, E); }
            { pg8::Gemm g{WIN, H, 3072, Ml, 1024}; pg8::StaticOrder S; S.init(3072, Ml, G, bx); pg8::EpiT<false> E{R0, MT, nullptr};
              pg8::gemm_phase<pg8::EpiT<false>, pg8::StaticOrder, true, true>(lds, g, S, E); }
            { pg8::Gemm g{H, WIN + (size_t)3072 * 1024, Ml, 2048, 1024}; pg8::StaticOrder S; S.init(Ml, 2048, G, (l == 0) ? (bx + 96) % G : bx); pg8::EpiIn<0> E{R3, R4, nullptr, nullptr};
              pg8::gemm_phase<pg8::EpiIn<0>, pg8::StaticOrder, true, true>(lds, g, S, E); }
        } else if (p == 3 && PON(3)) {
            const int nun = 1024 + (l == 0 ? 1024 : 0);
            const float* cw = args.in[I_HCW] + (size_t)l * 3 * 3072; const float* cb = args.in[I_HCB] + (size_t)l * 3072; const float* hb = args.in[I_HBIAS] + l * 2048;
            for (int u = bx; u < nun; u += G) {
                const int c = u & 1023; const bool isctx = u >= 1024; const size_t tb = isctx ? ML : 0;
                const int zc = 2048 + c, g1 = c, g2 = 1024 + c;
                const bf16_t* zsrc = R2 + (size_t)c * MT + tb; const bf16_t* gs1 = R0 + (size_t)c * MT + tb; const bf16_t* gs2 = R1 + (size_t)c * MT + tb; bf16_t* dst = R0 + (size_t)c * MT + tb;
                const float zw0 = cw[zc], zw1 = cw[3072 + zc], zw2 = cw[6144 + zc], zb = cb[zc];
                if (!isctx) lconv_unit<64>(lds, zsrc, true, zw0, zw1, zw2, zb, gs1, cw[g1], cw[3072 + g1], cw[6144 + g1], cb[g1], gs2, cw[g2], cw[3072 + g2], cw[6144 + g2], cb[g2],
                                           FILT + (size_t)c * 8192, FILT + (size_t)8192 * 1024 + (size_t)c * 8192, hb[c], hb[1024 + c], dst);
                else lconv_unit<4>(lds, zsrc, true, zw0, zw1, zw2, zb, gs1, cw[g1], cw[3072 + g1], cw[6144 + g1], cb[g1], gs2, cw[g2], cw[3072 + g2], cw[6144 + g2], cb[g2],
                                   FILTC + (size_t)c * 512, FILTC + (size_t)512 * 1024 + (size_t)c * 512, hb[c], hb[1024 + c], dst);
            }
        } else if (p == 5 && PON(5)) {
            for (int it = bx; it < (Ml / 64) * 4; it += G) tgate_item(lds, R0, R3, R1, (it >> 2) * 64, (it & 3) * 256);
        } else if (p == 6 && PON(6)) {
            pg8::Gemm g{R1, WHYO, ML, 1024, 1024}; pg8::StaticOrder S; S.init(ML, 1024, G, bx); pg8::EpiS E{R4, R4, 1};
            pg8::gemm_phase<pg8::EpiS, pg8::StaticOrder, true, true>(lds, g, S, E);
        } else if (p == 7 && PON(7)) {
            { pg8::Gemm g{H, WIN + (size_t)5120 * 1024, Ml, 3584, 1024}; pg8::StaticOrder S; S.init(Ml, 3584, G, bx); pg8::EpiIn<1> E{R0, KVRAW, R2, R3, (l == 0) ? (bf16_t*)(ws + WS_SPG) : nullptr};
              pg8::gemm_phase<pg8::EpiIn<1>, pg8::StaticOrder, true, true>(lds, g, S, E); }
            if (l == 0) { pg8::Gemm g{R1 + (size_t)ML * 1024, WHYO, MC, 1024, 1024}; pg8::StaticOrder S; S.init(MC, 1024, G, (bx + G - 112) % G); pg8::EpiS E{R4 + (size_t)ML * 1024, R4 + (size_t)ML * 1024, 1};
              pg8::gemm_phase<pg8::EpiS, pg8::StaticOrder, true, true>(lds, g, S, E); }
            if (l == 1) { pg8::Gemm g{H + (size_t)ML * 1024, WIN + (size_t)6144 * 1024, MC, 512, 1024}; pg8::StaticOrder S; S.init(MC, 512, G, (bx + 128) % G); pg8::EpiIn<3> E{KVRAW + (size_t)ML * 512, nullptr, nullptr, nullptr};
              pg8::gemm_phase<pg8::EpiIn<3>, pg8::StaticOrder, true, true>(lds, g, S, E); }
        } else if (p == 8 && PON(8)) {
            for (int m = gw; m < MT; m += NGW) qk_row(m, R0, KVRAW, KP, VP, args.in[I_QG] + l * 128, args.in[I_KG] + l * 128, (const float*)(ws + WS_ROPE), lane, m < Ml);
        } else if (p == 9 && PON(9)) {
            const int nun = 1024 + (l == 0 ? 64 : 0);
            for (int u = vcu; u < nun; u += G) {
                if (u < 1024) { const int grp = u >> 6, b = grp >> 1, kvh = grp & 1, within = u & 63, hh = kvh * 4 + (within >> 4), qb = within & 15;
                    const size_t qo = ((size_t)(b * SEQL + qb * 256)) * 1024 + hh * 128; const size_t ko = (size_t)b * NKEY * 256 + kvh * 128;
                    attn::attn_dense_body((const attn::bf16*)(R0 + qo), (const attn::bf16*)(KP + ko), (const attn::bf16*)(VP + ko), R0 + qo, R2 + qo, NKEY, (char*)lds_raw); }
                else { const int uc = u - 1024, b = uc >> 3, hh = uc & 7, kvh = hh >> 2;
                    const size_t qo = ((size_t)(ML + b * CTXL)) * 1024 + hh * 128; const size_t ko = (size_t)b * NKEY * 256 + kvh * 128;
                    attn::attn_dense_body((const attn::bf16*)(R0 + qo), (const attn::bf16*)(KP + ko), (const attn::bf16*)(VP + ko), (bf16_t*)(ws + WS_SPO) + ((size_t)(b * CTXL)) * 1024 + hh * 128, R2 + qo, CTXL, (char*)lds_raw); }
                __syncthreads();
            }
        } else if (p == 10 && PON(10)) {
            pg8::Gemm g{R0, WATTO, ML, 1024, 1024}; pg8::StaticOrder S; S.init(ML, 1024, G, bx); pg8::EpiS E{R3, R4, 0};
            pg8::gemm_phase<pg8::EpiS, pg8::StaticOrder, true, true>(lds, g, S, E);
        } else if (p == 11 && PON(11)) {
            { pg8::Gemm g{H, WIN + (size_t)8704 * 1024, Ml, 3072, 1024}; pg8::StaticOrder S; S.init(Ml, 3072, G, bx); pg8::EpiIn<2> E{R0, R2, R3, nullptr};
              pg8::gemm_phase<pg8::EpiIn<2>, pg8::StaticOrder, true, true>(lds, g, S, E); }
            { pg8::Gemm g{WIN + (size_t)11776 * 1024, H, 1024, Ml, 1024}; pg8::StaticOrder S; S.init(1024, Ml, G, (l == 0) ? (bx + 96) % G : bx); pg8::EpiT<true> E{R1, MT, statp};
              pg8::gemm_phase<pg8::EpiT<true>, pg8::StaticOrder, true, true>(lds, g, S, E); }
            if (l == 0) { pg8::Gemm g{(const bf16_t*)(ws + WS_SPO), WATTO, MC, 1024, 1024}; pg8::StaticOrder S; S.init(MC, 1024, G, (bx + G - 96) % G); pg8::EpiS E{(const bf16_t*)(ws + WS_SPG), R4 + (size_t)ML * 1024, 0};
              pg8::gemm_phase<pg8::EpiS, pg8::StaticOrder, true, true>(lds, g, S, E); }
        } else if (p == 12 && PON(12)) {
            const int nun = (l == 0 ? MT / 128 : ML / 128) * 8;
            for (int u = bx; u < nun; u += G)
                gmlp_unit(lds, (u >> 3) * 128, u & 7, R1, statp, GMWS, args.in[I_GMBS] + l * 1024, args.in[I_LNG] + l * 1024, args.in[I_LNB] + l * 1024, R0, R2);
        } else if (p == 13 && PON(13)) {
            pg8::Gemm g{R0, WGMO, Ml, 1024, 1024}; pg8::StaticOrder S; S.init(Ml, 1024, G, bx); pg8::EpiS E{R3, R4, 0};
            pg8::gemm_phase<pg8::EpiS, pg8::StaticOrder, true, true>(lds, g, S, E);
        } else if (p == 14 && PON(14)) {
            pg8::Gemm g{R4, WOUT, Ml, 1024, 1024}; pg8::StaticOrder S; S.init(Ml, 1024, G, bx); pg8::EpiY E{Y, ysq, MT};
            pg8::gemm_phase<pg8::EpiY, pg8::StaticOrder, true, true>(lds, g, S, E);
        } else if (p == 15 && PON(15)) {
            const int nrow = (l == 0) ? MT : ML;
            for (int m = gw; m < nrow; m += NGW) {
                const float* yr = Y + (size_t)m * 1024; const int r = (m < ML) ? (m >> 12) : 8;
                const float* xr = (l == 0) ? ((m < ML) ? args.in[I_X] + (size_t)m * 1024 : args.in[I_CTX] + (size_t)(m - ML) * 1024) : args.out + (size_t)m * 1024;
                const float q = (lane < 16) ? ysq[(size_t)lane * MT + m] : 0.f;
                const float rn = rsqrtf(wave_sum(q) * (1.f / 1024.f) + 1e-6f);
                const float* gpo = args.in[I_GPOST] + l * 1024; const float* gt = modv + (size_t)(l * 9 + r) * 3072 + 2048;
                f32x4 v[4];
#pragma unroll
                for (int j = 0; j < 4; ++j) { const int col = 4 * lane + 256 * j;
                    const f32x4 y = *(const f32x4*)(yr + col), x = *(const f32x4*)(xr + col), gp4 = *(const f32x4*)(gpo + col), g4 = *(const f32x4*)(gt + col);
                    v[j] = x + g4 * ((y * rn) * gp4);
                    if (m < ML) *(f32x4*)(args.out + (size_t)m * 1024 + col) = v[j]; }
                if (l == 0) h_row(v, args.in[I_GPRE] + 1024, modv + (size_t)(9 + r) * 3072, H + (size_t)m * 1024, lane);
            }
        }
        if (gp + 1 < args.ph_hi) {
            if (gp == args.ph_lo) { grid.sync(); xbar = xcd_barrier_post((unsigned*)(args.ws + WS_BAR), (volatile LAS unsigned*)(lds + 147200)); }
            else xcd_barrier(xbar);
        }
    }
    }
}

extern "C" void kernel_launch(void* const* d_in, const int* in_sizes, int n_in, void* d_out, int out_size, void* d_ws, size_t ws_size, hipStream_t stream) {
    static int grid = 0;
    if (grid == 0) {
        if (n_in != 29 || out_size != ML * DM || ws_size < (size_t)500 * MiB) { fprintf(stderr, "kernel_launch: unexpected shapes n_in %d out %d ws %zu (need %zu)\n", n_in, out_size, ws_size, (size_t)WS_END); grid = -1; return; }
        int dev = 0, cus = 0, per_cu = 0;
        (void)hipGetDevice(&dev); (void)hipDeviceGetAttribute(&cus, hipDeviceAttributeMultiprocessorCount, dev);
        if (hipFuncSetAttribute((const void*)fwd_kernel, hipFuncAttributeMaxDynamicSharedMemorySize, LDS_BYTES) != hipSuccess) { fprintf(stderr, "kernel_launch: hipFuncSetAttribute failed\n"); grid = -1; return; }
        if (hipOccupancyMaxActiveBlocksPerMultiprocessor(&per_cu, (const void*)fwd_kernel, 512, LDS_BYTES) != hipSuccess || per_cu < 1) { fprintf(stderr, "kernel_launch: occupancy query gave %d\n", per_cu); per_cu = 1; }
        (void)hipGetLastError();
        grid = cus * 1;
        fprintf(stderr, "kernel_launch: cus %d per_cu %d grid %d\n", cus, per_cu, grid);
    }
    if (grid < 0) return;
    Args a{};
    for (int i = 0; i < 29; ++i) a.in[i] = (const float*)d_in[i];
    a.out = (float*)d_out; a.ws = (unsigned char*)d_ws; a.ph_lo = 0; a.ph_hi = 2 * NPH;
#ifdef PROBE_A
    a.ph_hi = 2 * NPH + 1;
#endif
    void* kargs[] = {&a};
    hipError_t e = hipLaunchCooperativeKernel((const void*)fwd_kernel, dim3(grid), dim3(512), kargs, LDS_BYTES, stream);
    if (e != hipSuccess) fprintf(stderr, "kernel_launch: cooperative launch failed: %s (grid %d)\n", hipGetErrorString(e), grid);
}
```

```cpp
#include <hip/hip_runtime.h>
#include <hip/hip_bf16.h>
#include <hip/hip_cooperative_groups.h>
#include <cstdio>
#include <cstdint>
#include <cmath>
namespace cg = cooperative_groups;

constexpr int DM = 1024, NBATCH = 8, SEQL = 4096, CTXL = 256;
constexpr int ML = NBATCH * SEQL, MC = NBATCH * CTXL, MT = ML + MC;
constexpr int NKEY = CTXL + SEQL;
constexpr int INW = 12800;
#define LAS __attribute__((address_space(3)))
template <int M> __device__ __forceinline__ float sx_add(float v) {
    if constexpr (M < 32) return v + __int_as_float(__builtin_amdgcn_ds_swizzle(__float_as_int(v), (M << 10) | 0x1f));
    else { auto rr = __builtin_amdgcn_permlane32_swap(__float_as_uint(v), __float_as_uint(v), false, false); return __uint_as_float(rr[0]) + __uint_as_float(rr[1]); }
}
typedef unsigned u32x4_g __attribute__((ext_vector_type(4)));
__device__ __forceinline__ u32x4_g zero4() { unsigned z = 0; asm volatile("" : "+v"(z)); return (u32x4_g){z, z, z, z}; }
namespace pg8 {
#define PG8_LAS __attribute__((address_space(3)))
typedef unsigned short bf16_t;
typedef short bf16x8 __attribute__((ext_vector_type(8)));
typedef float f32x4 __attribute__((ext_vector_type(4)));
typedef unsigned u32x4 __attribute__((ext_vector_type(4)));
constexpr int BM = 256, BK = 64, HALF = 128, HTB = HALF * BK * 2  , STAGE_BYTES = 8 * HTB, NXCD = 8, WGM = 8;

__host__ __device__ __forceinline__ int lds_byte(int r, int c) { const int st = (r >> 4) * 2 + (c >> 5), rr = r & 15, cc = c & 31, ob = rr * 64 + cc * 2; return st * 1024 + (ob ^ (((ob >> 9) & 1) << 5)); }
__host__ __device__ __forceinline__ void stage_rc(int b, int& R, int& C) { const int st = b / 1024, sb = b % 1024, swz = sb ^ (((sb >> 9) & 1) << 5); R = (st >> 1) * 16 + swz / 64; C = (st & 1) * 32 + (swz % 64) / 2; }
__host__ __device__ __forceinline__ int perm32(int rho) { const int n = rho >> 4, i = rho & 15; return 8 * (i >> 2) + 4 * n + (i & 3); }

struct Unit { int pm, pn; };
struct Gemm { const bf16_t* A; const bf16_t* Bt; int M, N, K; };

struct StaticOrder {
    int nM, nN, nwg, G, c;
    __host__ __device__ void init(int M, int N, int G_, int c_) { nM = M / BM; nN = N / BM; nwg = nM * nN; G = G_; c = c_; }
    __host__ __device__ bool next(int i, Unit& u) const {
        const long L = (long)i * G + c; if (L >= nwg) return false;
        int wgid = (int)L; { const int q = nwg / NXCD, r = nwg % NXCD, xcd = wgid % NXCD, off = wgid / NXCD; wgid = (xcd < r ? xcd * (q + 1) : r * (q + 1) + (xcd - r) * q) + off; }
        const int nig = WGM * nN, gid = wgid / nig, fm = gid * WGM, gsz = (nM - fm) < WGM ? (nM - fm) : WGM;
        u.pm = fm + ((wgid % nig) % gsz); u.pn = (wgid % nig) / gsz; return true;
    }
    __device__ __forceinline__ void a_ready(const Unit&) const {}
    __device__ __forceinline__ void done(const Unit&) const {}
};

__device__ __forceinline__ unsigned cvt_pk_bf16(float lo, float hi) { unsigned r; asm volatile("v_cvt_pk_bf16_f32 %0, %1, %2" : "=v"(r) : "v"(lo), "v"(hi)); return r; }
typedef float f32x2 __attribute__((ext_vector_type(2)));
__device__ __forceinline__ f32x2 gelu_pk(f32x2 v) {
    const f32x2 av = __builtin_elementwise_abs(v), d = av * 0.2316418882f + 1.0f;
    f32x2 t; t.x = __builtin_amdgcn_rcpf(d.x); t.y = __builtin_amdgcn_rcpf(d.y);
    f32x2 q = t * 0.5307027145f + (-0.7265760135f); q = q * t + 0.7107068705f; q = q * t + (-0.142248368f); q = q * t + 0.127414796f; q = q * t;
    const f32x2 s = (v * v) * (-0.72134752044f);
    f32x2 e; e.x = __builtin_amdgcn_exp2f(s.x); e.y = __builtin_amdgcn_exp2f(s.y);
    const f32x2 m = v * (q * e), r = v - m;
    f32x2 o; o.x = v.x < 0.f ? m.x : r.x; o.y = v.y < 0.f ? m.y : r.y; return o;
}

enum { ACT_NONE = 0, ACT_SILU = 1, ACT_SIGM = 2, ACT_GELU = 3 };
template <int ACT> __device__ __forceinline__ f32x4 act4(f32x4 v) {
    if constexpr (ACT == ACT_NONE) return v;
    else if constexpr (ACT == ACT_GELU) { f32x2 a = gelu_pk((f32x2){v[0], v[1]}), b = gelu_pk((f32x2){v[2], v[3]}); return (f32x4){a.x, a.y, b.x, b.y}; }
    else { f32x4 o;
#pragma unroll
        for (int i = 0; i < 4; ++i) { const float e = __builtin_amdgcn_exp2f(v[i] * -1.4426950408889634f); const float s = __builtin_amdgcn_rcpf(1.0f + e); o[i] = (ACT == ACT_SILU) ? v[i] * s : s; }
        return o; }
}
template <int ACT> __device__ __forceinline__ void store_tile_bf16(const f32x4 (&acc)[2][2][4][2], bf16_t* base, size_t ldc, int wr, int wc, int fr, int fq) {
    asm volatile("" : "+v"(fr), "+v"(fq));
#pragma unroll
    for (int ai = 0; ai < 2; ++ai)
#pragma unroll
        for (int m = 0; m < 4; ++m) { bf16_t* rowp = base + (size_t)(ai * HALF + wr * 64 + m * 16 + fr) * ldc + wc * 32 + 8 * fq;
#pragma unroll
            for (int bj = 0; bj < 2; ++bj) { const f32x4 v0 = act4<ACT>(acc[ai][bj][m][0]), v1 = act4<ACT>(acc[ai][bj][m][1]);
                u32x4 w; w.x = cvt_pk_bf16(v0[0], v0[1]); w.y = cvt_pk_bf16(v0[2], v0[3]); w.z = cvt_pk_bf16(v1[0], v1[1]); w.w = cvt_pk_bf16(v1[2], v1[3]);
                *(u32x4*)(rowp + bj * HALF) = w; }
            asm volatile("" ::: "memory"); __builtin_amdgcn_sched_barrier(0); }
}
__device__ __forceinline__ void store_tile_rt(const f32x4 (&acc)[2][2][4][2], bf16_t* base, size_t ldc, int wr, int wc, int fr, int fq, int act) {
    asm volatile("" : "+v"(fr), "+v"(fq));
    const bool is_none = (act == ACT_NONE), is_silu = (act == ACT_SILU);
#pragma unroll
    for (int ai = 0; ai < 2; ++ai)
#pragma unroll
        for (int m = 0; m < 4; ++m) { bf16_t* rowp = base + (size_t)(ai * HALF + wr * 64 + m * 16 + fr) * ldc + wc * 32 + 8 * fq;
#pragma unroll
            for (int bj = 0; bj < 2; ++bj) { float o[8];
#pragma unroll
                for (int i = 0; i < 8; ++i) { const float x = acc[ai][bj][m][i >> 2][i & 3]; const float e = __builtin_amdgcn_exp2f(x * -1.4426950408889634f); const float sg = __builtin_amdgcn_rcpf(1.0f + e);
                    o[i] = is_none ? x : (is_silu ? x * sg : sg); }
                u32x4 w; w.x = cvt_pk_bf16(o[0], o[1]); w.y = cvt_pk_bf16(o[2], o[3]); w.z = cvt_pk_bf16(o[4], o[5]); w.w = cvt_pk_bf16(o[6], o[7]);
                *(u32x4*)(rowp + bj * HALF) = w; }
            asm volatile("" ::: "memory"); __builtin_amdgcn_sched_barrier(0); }
}
template <int mode> struct EpiIn {
    static constexpr bool PERM = true, AFTER_DRAIN = false;
    bf16_t *p0, *p1, *p2, *p3; bf16_t* p4 = nullptr;
    __device__ __forceinline__ void operator()(f32x4 (&acc)[2][2][4][2], const Unit& u, int wr, int wc, int fr, int fq) const {
        bf16_t* base; size_t ldc = 1024; int act, ct;
        if (mode == 0) { if (u.pn < 4) { base = p0; act = ACT_SILU; ct = u.pn; } else { base = p1; act = ACT_SIGM; ct = u.pn - 4; } }
        else if (mode == 1) {
            if (u.pn < 4) { base = p0; act = ACT_NONE; ct = u.pn; }
            else if (u.pn < 6) { base = p1; act = ACT_NONE; ct = u.pn - 4; ldc = 512; }
            else if (u.pn < 10) { base = p2; act = ACT_SILU; ct = u.pn - 6; }
            else { base = (p4 && u.pm >= 128) ? p4 - (size_t)128 * BM * 1024 : p3; act = ACT_SIGM; ct = u.pn - 10; } }
        else if (mode == 3) { base = p0; act = ACT_NONE; ct = u.pn; ldc = 512; }
        else { if (u.pn < 4) { base = p0; act = ACT_GELU; ct = u.pn; } else if (u.pn < 8) { base = p1; act = ACT_SILU; ct = u.pn - 4; } else { base = p2; act = ACT_SIGM; ct = u.pn - 8; } }
        base += (size_t)u.pm * BM * ldc + ct * BM;
        if (mode == 2 && act == ACT_GELU) store_tile_bf16<ACT_GELU>(acc, base, ldc, wr, wc, fr, fq);
        else if ((mode == 1 || mode == 3) && act == ACT_NONE) store_tile_bf16<ACT_NONE>(acc, base, ldc, wr, wc, fr, fq);
        else store_tile_rt(acc, base, ldc, wr, wc, fr, fq, act);
    }
};
template <bool GELU> struct EpiT {
    static constexpr bool PERM = true, AFTER_DRAIN = false;
    bf16_t* O; int ldc; float* statp;
    __device__ __forceinline__ void operator()(f32x4 (&acc)[2][2][4][2], const Unit& u, int wr, int wc, int fr, int fq) const {
        asm volatile("" : "+v"(fr), "+v"(fq));
        bf16_t* base = O + (size_t)u.pm * BM * ldc + (size_t)u.pn * BM;
        if constexpr (!GELU) { store_tile_bf16<ACT_NONE>(acc, base, ldc, wr, wc, fr, fq); return; } else {
#pragma unroll
        for (int ai = 0; ai < 2; ++ai)
#pragma unroll
            for (int bj = 0; bj < 2; ++bj)
#pragma unroll
                for (int m = 0; m < 4; ++m)
#pragma unroll
                    for (int n = 0; n < 2; ++n) acc[ai][bj][m][n] = act4<ACT_GELU>(acc[ai][bj][m][n]);
        store_tile_bf16<ACT_NONE>(acc, base, ldc, wr, wc, fr, fq);
        const int part = u.pm * 2 + wr;
#pragma unroll
        for (int bj = 0; bj < 2; ++bj)
#pragma unroll
            for (int n = 0; n < 2; ++n) {
                f32x4 s = (f32x4){0.f, 0.f, 0.f, 0.f}, q = s;
#pragma unroll
                for (int ai = 0; ai < 2; ++ai)
#pragma unroll
                    for (int m = 0; m < 4; ++m) { const f32x4 x = acc[ai][bj][m][n]; s += x; q += x * x; }
#pragma unroll
                for (int c = 0; c < 4; ++c) {
                    float a = s[c], b = q[c];
                    a = sx_add<1>(a); b = sx_add<1>(b); a = sx_add<2>(a); b = sx_add<2>(b);
                    a = sx_add<4>(a); b = sx_add<4>(b); a = sx_add<8>(a); b = sx_add<8>(b);
                    s[c] = a; q[c] = b; }
                if (fr == 0) { const int tok = u.pn * BM + bj * HALF + wc * 32 + 8 * fq + 4 * n; float* sp = statp + ((size_t)part * ldc + tok) * 2;
                    *(f32x4*)(sp) = (f32x4){s[0], q[0], s[1], q[1]}; *(f32x4*)(sp + 4) = (f32x4){s[2], q[2], s[3], q[3]}; }
            }
        }
    }
};
__device__ __forceinline__ float bflo(unsigned w) { return __uint_as_float(w << 16); }
__device__ __forceinline__ float bfhi(unsigned w) { return __uint_as_float(w & 0xffff0000u); }
struct EpiS {
    static constexpr bool PERM = true, AFTER_DRAIN = false;
    const bf16_t* G; bf16_t* S; int first;
    __device__ __forceinline__ void operator()(f32x4 (&acc)[2][2][4][2], const Unit& u, int wr, int wc, int fr, int fq) const {
        asm volatile("" : "+v"(fr), "+v"(fq));
#pragma unroll
        for (int ai = 0; ai < 2; ++ai)
#pragma unroll
            for (int m = 0; m < 4; ++m) { const size_t off = (size_t)(u.pm * BM + ai * HALF + wr * 64 + m * 16 + fr) * 1024 + u.pn * BM + wc * 32 + 8 * fq;
#pragma unroll
                for (int bj = 0; bj < 2; ++bj) { const u32x4 g = *(const u32x4*)(G + off + bj * HALF); u32x4 sv = zero4(); if (!first) sv = *(const u32x4*)(S + off + bj * HALF);
                    const f32x4 a0 = acc[ai][bj][m][0], a1 = acc[ai][bj][m][1]; u32x4 w;
                    w.x = cvt_pk_bf16(bflo(sv.x) + bflo(g.x) * a0[0], bfhi(sv.x) + bfhi(g.x) * a0[1]);
                    w.y = cvt_pk_bf16(bflo(sv.y) + bflo(g.y) * a0[2], bfhi(sv.y) + bfhi(g.y) * a0[3]);
                    w.z = cvt_pk_bf16(bflo(sv.z) + bflo(g.z) * a1[0], bfhi(sv.z) + bfhi(g.z) * a1[1]);
                    w.w = cvt_pk_bf16(bflo(sv.w) + bflo(g.w) * a1[2], bfhi(sv.w) + bfhi(g.w) * a1[3]);
                    *(u32x4*)(S + off + bj * HALF) = w; } }
    }
};
struct EpiY {
    static constexpr bool PERM = true, AFTER_DRAIN = false;
    float* Y; float* ysq; int ldm;
    __device__ __forceinline__ void operator()(f32x4 (&acc)[2][2][4][2], const Unit& u, int wr, int wc, int fr, int fq) const {
        asm volatile("" : "+v"(fr), "+v"(fq));
#pragma unroll
        for (int ai = 0; ai < 2; ++ai)
#pragma unroll
            for (int m = 0; m < 4; ++m) { const int row = u.pm * BM + ai * HALF + wr * 64 + m * 16 + fr; float* rowp = Y + (size_t)row * 1024 + u.pn * BM + wc * 32 + 8 * fq; float q = 0.f;
#pragma unroll
                for (int bj = 0; bj < 2; ++bj) { const f32x4 a0 = acc[ai][bj][m][0], a1 = acc[ai][bj][m][1];
                    *(f32x4*)(rowp + bj * HALF) = a0; *(f32x4*)(rowp + bj * HALF + 4) = a1;
                    q += (a0[0] * a0[0] + a0[1] * a0[1]) + (a0[2] * a0[2] + a0[3] * a0[3]) + (a1[0] * a1[0] + a1[1] * a1[1]) + (a1[2] * a1[2] + a1[3] * a1[3]); }
                q = sx_add<16>(q); q = sx_add<32>(q);
                if (fq == 0) ysq[(size_t)(u.pn * 4 + wc) * ldm + row] = q; }
    }
};
struct EpiF {
    static constexpr bool PERM = true, AFTER_DRAIN = false;
    bf16_t* F; const float* decay; int L;
    __device__ __forceinline__ void operator()(f32x4 (&acc)[2][2][4][2], const Unit& u, int wr, int wc, int fr, int fq) const {
        asm volatile("" : "+v"(fr), "+v"(fq));
        const float inv = -1.4426950408889634f / (float)(L - 1);
#pragma unroll
        for (int ai = 0; ai < 2; ++ai)
#pragma unroll
            for (int m = 0; m < 4; ++m) { const int r = u.pm * BM + ai * HALF + wr * 64 + m * 16 + fr; const int o = r >> 11, dir = (r >> 10) & 1, c = r & 1023;
                const float d = fabsf(decay[r]) * inv; bf16_t* rowp = F + ((size_t)(o * 1024 + c) * 2 + dir) * L + u.pn * BM + wc * 32 + 8 * fq;
#pragma unroll
                for (int bj = 0; bj < 2; ++bj) { const int t0 = u.pn * BM + bj * HALF + wc * 32 + 8 * fq; float o8[8];
#pragma unroll
                    for (int i = 0; i < 8; ++i) o8[i] = acc[ai][bj][m][i >> 2][i & 3] * __builtin_amdgcn_exp2f((float)(t0 + i) * d);
                    u32x4 w; w.x = cvt_pk_bf16(o8[0], o8[1]); w.y = cvt_pk_bf16(o8[2], o8[3]); w.z = cvt_pk_bf16(o8[4], o8[5]); w.w = cvt_pk_bf16(o8[6], o8[7]);
                    *(u32x4*)(rowp + bj * HALF) = w; }
                asm volatile("" ::: "memory"); }
    }
};
template <class Epi, class Sched, bool ALIGN_EPI = false, bool SP2 = false>
__device__ __forceinline__ void gemm_phase(PG8_LAS unsigned char* lds, const Gemm g, const Sched& S, const Epi& E) {
    int tid_l = threadIdx.x; asm volatile("" : "+v"(tid_l));
    const int tid = tid_l, wid = __builtin_amdgcn_readfirstlane(tid >> 6), lane = tid & 63, wr = wid >> 2, wc = wid & 3, fr = lane & 15, fq = lane >> 4;
    const int K = g.K, nt = K / BK;
    unsigned voffA[2], voffB[2];
#pragma unroll
    for (int i = 0; i < 2; ++i) { int R, C; stage_rc(tid * 16 + i * 8192, R, C); const int Rb = Epi::PERM ? ((R & ~31) + perm32(R & 31)) : R;
        voffA[i] = (unsigned)(R * K + C) * 2u; voffB[i] = (unsigned)(Rb * K + C) * 2u; }
    const size_t kstep = (size_t)(BK * 2);
    const size_t hstep = (size_t)HALF * K * 2;
    const size_t tstep = 2 * hstep;
    const unsigned ldsw = (unsigned)wid * 1024u;
    const int aoff = lds_byte(wr * 64 + fr, fq * 8), boff = lds_byte(wc * 32 + fr, fq * 8);
#define PG8_SA(b, h) (((b) * 2 + (h)) * HTB)
#define PG8_SB(b, h) ((4 + (b) * 2 + (h)) * HTB)
#define PG8_STAGE(bufoff, gbase, voff) do { _Pragma("unroll") for (int _i = 0; _i < 2; ++_i) \
        __builtin_amdgcn_global_load_lds((const unsigned*)((const char*)(gbase) + (voff)[_i]), (PG8_LAS unsigned*)(lds + (bufoff) + ldsw + _i * 8192), 16, 0, 0); } while (0)
#define PG8_LDA(dst, b, h) do { _Pragma("unroll") for (int m = 0; m < 4; ++m) _Pragma("unroll") for (int k = 0; k < 2; ++k) dst[m][k] = *(const PG8_LAS bf16x8*)(lds + PG8_SA(b, h) + aoff + m * 2048 + k * 1024); } while (0)
#define PG8_LDB(dst, b, h) do { _Pragma("unroll") for (int n = 0; n < 2; ++n) _Pragma("unroll") for (int k = 0; k < 2; ++k) dst[n][k] = *(const PG8_LAS bf16x8*)(lds + PG8_SB(b, h) + boff + n * 2048 + k * 1024); } while (0)
#define PG8_MMA(ai, bj, At, Bt) do { __builtin_amdgcn_s_setprio(1); _Pragma("unroll") for (int m = 0; m < 4; ++m) _Pragma("unroll") for (int n = 0; n < 2; ++n) _Pragma("unroll") for (int k = 0; k < 2; ++k) \
        acc[ai][bj][m][n] = __builtin_amdgcn_mfma_f32_16x16x32_bf16(Bt[n][k], At[m][k], acc[ai][bj][m][n], 0, 0, 0); __builtin_amdgcn_s_setprio(0); } while (0)
#define PG8_WAIT_V(n) asm volatile("s_waitcnt vmcnt(" #n ")" ::: "memory")
#define PG8_WAIT_L(n) asm volatile("s_waitcnt lgkmcnt(" #n ")" ::: "memory")
#define PG8_BAR __builtin_amdgcn_s_barrier()
#define PG8_SCHED __builtin_amdgcn_sched_barrier(0)
    Unit cur, nxt; int ui = 0;
    if (!S.next(0, cur)) return;
    f32x4 acc[2][2][4][2];
#pragma unroll
    for (int a = 0; a < 2; ++a)
#pragma unroll
        for (int b = 0; b < 2; ++b)
#pragma unroll
            for (int m = 0; m < 4; ++m)
#pragma unroll
                for (int n = 0; n < 2; ++n) acc[a][b][m][n] = (f32x4){0.f, 0.f, 0.f, 0.f};
    bf16x8 At[4][2], B0[2][2], B1[2][2];
    const char* cA = (const char*)g.A + (size_t)cur.pm * tstep; const char* cB = (const char*)g.Bt + (size_t)cur.pn * tstep;
    S.a_ready(cur);
    if constexpr (SP2) {
        PG8_STAGE(PG8_SB(0, 0), cB, voffB); PG8_STAGE(PG8_SB(0, 1), cB + hstep, voffB); PG8_STAGE(PG8_SA(0, 0), cA, voffA); PG8_STAGE(PG8_SA(0, 1), cA + hstep, voffA);
        if (wr == 1) PG8_BAR;
        PG8_WAIT_V(2); PG8_BAR;
        PG8_STAGE(PG8_SB(1, 0), cB + kstep, voffB); PG8_STAGE(PG8_SA(1, 0), cA + kstep, voffA); PG8_STAGE(PG8_SB(1, 1), cB + hstep + kstep, voffB);
        PG8_WAIT_V(6); PG8_BAR;
    } else {
        PG8_STAGE(PG8_SB(0, 0), cB, voffB); PG8_STAGE(PG8_SA(0, 0), cA, voffA); PG8_STAGE(PG8_SB(0, 1), cB + hstep, voffB); PG8_STAGE(PG8_SA(0, 1), cA + hstep, voffA);
        if (wr == 1) PG8_BAR;
        PG8_WAIT_V(4); PG8_BAR;
        PG8_STAGE(PG8_SB(1, 0), cB + kstep, voffB); PG8_STAGE(PG8_SA(1, 0), cA + kstep, voffA); PG8_STAGE(PG8_SB(1, 1), cB + hstep + kstep, voffB);
        PG8_WAIT_V(6); PG8_BAR;
    }
    for (;;) {
        const bool has_next = S.next(ui + 1, nxt);
        const char* nA = has_next ? (const char*)g.A + (size_t)nxt.pm * tstep : cA; const char* nB = has_next ? (const char*)g.Bt + (size_t)nxt.pn * tstep : cB;
        for (int t = 0; t < nt; t += 2) {
            const bool last = (t == nt - 2);
            const char* a1 = cA + (size_t)(t + 1) * kstep;
            const char* a2 = last ? nA : cA + (size_t)(t + 2) * kstep; const char* b2 = last ? nB : cB + (size_t)(t + 2) * kstep;
                        asm volatile("" : "+s"(a1), "+s"(a2), "+s"(b2));
            const char* a3 = a2 + kstep; const char* b3 = b2 + kstep; asm volatile("" : "+s"(a3), "+s"(b3));
            if (last && has_next) S.a_ready(nxt);
            if constexpr (SP2) {
            PG8_LDB(B0, 0, 0); PG8_LDB(B1, 0, 1); PG8_SCHED; PG8_LDA(At, 0, 0); PG8_STAGE(PG8_SA(1, 1), a1 + hstep, voffA);
            PG8_WAIT_V(8); PG8_WAIT_L(0); PG8_BAR; PG8_MMA(0, 0, At, B0); PG8_MMA(0, 1, At, B1); PG8_BAR; PG8_SCHED;
            PG8_LDA(At, 0, 1); PG8_STAGE(PG8_SB(0, 0), b2, voffB); PG8_STAGE(PG8_SB(0, 1), b2 + hstep, voffB); PG8_STAGE(PG8_SA(0, 0), a2, voffA);
            PG8_WAIT_V(8); PG8_WAIT_L(0); PG8_BAR; PG8_MMA(1, 0, At, B0); PG8_MMA(1, 1, At, B1); PG8_BAR; PG8_SCHED;
            PG8_LDB(B0, 1, 0); PG8_LDB(B1, 1, 1); PG8_SCHED; PG8_LDA(At, 1, 0); PG8_STAGE(PG8_SA(0, 1), a2 + hstep, voffA);
            PG8_WAIT_V(8); PG8_WAIT_L(0); PG8_BAR; PG8_MMA(0, 0, At, B0); PG8_MMA(0, 1, At, B1); PG8_BAR; PG8_SCHED;
            PG8_LDA(At, 1, 1); PG8_STAGE(PG8_SB(1, 0), b3, voffB); PG8_STAGE(PG8_SB(1, 1), b3 + hstep, voffB); PG8_STAGE(PG8_SA(1, 0), a3, voffA);
            PG8_WAIT_V(8); PG8_WAIT_L(0); PG8_BAR; PG8_MMA(1, 0, At, B0); PG8_MMA(1, 1, At, B1); PG8_BAR; PG8_SCHED;
            } else {
            PG8_LDB(B0, 0, 0); PG8_SCHED; PG8_LDA(At, 0, 0); PG8_STAGE(PG8_SA(1, 1), a1 + hstep, voffA);
            PG8_WAIT_L(8); PG8_BAR; PG8_WAIT_L(0); PG8_MMA(0, 0, At, B0); PG8_BAR; PG8_SCHED;
            PG8_LDB(B1, 0, 1); PG8_STAGE(PG8_SB(0, 0), b2, voffB);
            PG8_BAR; PG8_WAIT_L(0); PG8_MMA(0, 1, At, B1); PG8_BAR;
            PG8_LDA(At, 0, 1); PG8_STAGE(PG8_SA(0, 0), a2, voffA);
            PG8_BAR; PG8_WAIT_L(0); PG8_MMA(1, 0, At, B0); PG8_BAR; PG8_SCHED;
            PG8_STAGE(PG8_SB(0, 1), b2 + hstep, voffB);
            PG8_WAIT_V(6); PG8_BAR; PG8_MMA(1, 1, At, B1); PG8_BAR;
            PG8_LDB(B0, 1, 0); PG8_SCHED; PG8_LDA(At, 1, 0); PG8_STAGE(PG8_SA(0, 1), a2 + hstep, voffA);
            PG8_WAIT_L(8); PG8_BAR; PG8_WAIT_L(0); PG8_MMA(0, 0, At, B0); PG8_BAR; PG8_SCHED;
            PG8_LDB(B1, 1, 1); PG8_STAGE(PG8_SB(1, 0), b3, voffB);
            PG8_BAR; PG8_WAIT_L(0); PG8_MMA(0, 1, At, B1); PG8_BAR;
            PG8_LDA(At, 1, 1); PG8_STAGE(PG8_SA(1, 0), a3, voffA);
            PG8_BAR; PG8_WAIT_L(0); PG8_MMA(1, 0, At, B0); PG8_BAR; PG8_SCHED;
            PG8_STAGE(PG8_SB(1, 1), b3 + hstep, voffB);
            PG8_WAIT_V(6); PG8_BAR; PG8_MMA(1, 1, At, B1); PG8_BAR;
            }
        }
        if constexpr (ALIGN_EPI) { if (wr == 0) PG8_BAR; }
        if constexpr (!Epi::AFTER_DRAIN) { E(acc, cur, wr, wc, fr, fq); S.done(cur); }
        if (!has_next) break;
#pragma unroll
        for (int a = 0; a < 2; ++a)
#pragma unroll
            for (int b = 0; b < 2; ++b)
#pragma unroll
                for (int m = 0; m < 4; ++m)
#pragma unroll
                    for (int n = 0; n < 2; ++n) acc[a][b][m][n] = (f32x4){0.f, 0.f, 0.f, 0.f};
        cur = nxt; cA = nA; cB = nB; ++ui;
        if constexpr (ALIGN_EPI) { if (wr == 1) PG8_BAR; }
    }
    PG8_WAIT_V(0);
    if constexpr (!ALIGN_EPI) { if (wr == 0) PG8_BAR; }
    PG8_BAR;
    if constexpr (Epi::AFTER_DRAIN) { E.fused(acc, cur, wr, wc, fr, fq, lds, wid, lane); S.done(cur); }
#undef PG8_SA
#undef PG8_SB
#undef PG8_STAGE
#undef PG8_LDA
#undef PG8_LDB
#undef PG8_MMA
#undef PG8_WAIT_V
#undef PG8_WAIT_L
#undef PG8_BAR
#undef PG8_SCHED
}
}
namespace attn {
using bf16 = __hip_bfloat16;
constexpr int   D = 128, NW = 8, QBLK = 32, KVBLK = 64;
constexpr float SCALE = 0.088388347648318440f;
constexpr float THR = 8.f;
constexpr int SDEPTH = 2;
constexpr int LDQ = 1024, LDK = 256, LDO = 1024;
constexpr size_t SHM_V = KVBLK * D * 2, SHM_K = KVBLK * D * 2, SHM_ATTN = 2 * SHM_V + 2 * SHM_K + NW * 64 * 4;
using bf16x8 = __attribute__((ext_vector_type(8))) short;
using s16x4  = __attribute__((ext_vector_type(4))) short;
using f32x16 = __attribute__((ext_vector_type(16))) float;
using f32x8  = __attribute__((ext_vector_type(8))) float;
using u32x4  = __attribute__((ext_vector_type(4))) unsigned;
#define KSWZ(row, colB) ((row) * 256 + ((colB) ^ (((row) & 7) << 4)))
#define SBAR() __builtin_amdgcn_sched_barrier(0)
__device__ __forceinline__ int crow(int r, int hi) { return (r & 3) + 8 * (r >> 2) + 4 * hi; }
__device__ __forceinline__ unsigned cvtpk(float lo, float hi) {
  unsigned r; asm volatile("v_cvt_pk_bf16_f32 %0, %1, %2" : "=v"(r) : "v"(lo), "v"(hi)); return r;
}
template <typename TIn> struct Stage;
template <> struct Stage<bf16>  { using T = bf16x8;
  __device__ static __forceinline__ T ld8(const bf16* p) { return *reinterpret_cast<const bf16x8*>(p); }
  __device__ static __forceinline__ bf16x8 tobf(T x) { return x; } };
template <> struct Stage<float> { using T = f32x8;
  __device__ static __forceinline__ T ld8(const float* p) { return *reinterpret_cast<const f32x8*>(p); }
  __device__ static __forceinline__ bf16x8 tobf(T x) {
    u32x4 w = {cvtpk(x[0], x[1]), cvtpk(x[2], x[3]), cvtpk(x[4], x[5]), cvtpk(x[6], x[7])}; return *reinterpret_cast<bf16x8*>(&w); } };

__device__ __forceinline__ void partialSM(f32x16& p0, f32x16& p1, float& m_reg, float& mn, float& alpha) {
  constexpr float C = SCALE * 1.4426950408889634f;
  float pmax = p0[0]; for (int r = 1; r < 16; ++r) pmax = fmaxf(pmax, p0[r]); for (int r = 0; r < 16; ++r) pmax = fmaxf(pmax, p1[r]);
  { auto rr = __builtin_amdgcn_permlane32_swap(__float_as_uint(pmax), __float_as_uint(pmax), false, false);
    pmax = fmaxf(__uint_as_float(rr[0]), __uint_as_float(rr[1])); }
  if (__builtin_expect(__all(pmax - m_reg <= THR / SCALE), 1)) { mn = m_reg; alpha = 1.f; }
  else { mn = fmaxf(m_reg, pmax); alpha = __builtin_amdgcn_exp2f((m_reg - mn) * C); m_reg = mn; }
  float mnC = -mn * C;
  for (int r = 0; r < 16; ++r) p0[r] = fmaf(p0[r], C, mnC); for (int r = 0; r < 16; ++r) p1[r] = fmaf(p1[r], C, mnC);
  for (int r = 0; r < 16; ++r) p0[r] = __builtin_amdgcn_exp2f(p0[r]);
}
__device__ __forceinline__ void finishSM(f32x16& p0, f32x16& p1, float alpha, float& l_reg, bf16x8& pa0, bf16x8& pa1, bf16x8& pa2, bf16x8& pa3) {
  for (int r = 0; r < 16; ++r) p1[r] = __builtin_amdgcn_exp2f(p1[r]);
  float ps = 0; for (int r = 0; r < 16; ++r) ps += p0[r]; for (int r = 0; r < 16; ++r) ps += p1[r];
  { auto rr = __builtin_amdgcn_permlane32_swap(__float_as_uint(ps), __float_as_uint(ps), false, false);
    ps = __uint_as_float(rr[0]) + __uint_as_float(rr[1]); }
  l_reg = l_reg * alpha + ps;
#define PK4(P, BASE, OUT) do { unsigned a0 = cvtpk(P[BASE + 0], P[BASE + 1]), a1 = cvtpk(P[BASE + 2], P[BASE + 3]);   \
    unsigned b0 = cvtpk(P[BASE + 4], P[BASE + 5]), b1 = cvtpk(P[BASE + 6], P[BASE + 7]);                              \
    auto r0 = __builtin_amdgcn_permlane32_swap(a0, b0, false, false); auto r1 = __builtin_amdgcn_permlane32_swap(a1, b1, false, false); \
    u32x4 w = {r0[0], r1[0], r0[1], r1[1]}; OUT = *reinterpret_cast<bf16x8*>(&w); } while (0)
  PK4(p0, 0, pa0); PK4(p0, 8, pa1); PK4(p1, 0, pa2); PK4(p1, 8, pa3);
#undef PK4
}
__device__ __forceinline__ void qkt(f32x16& p0, f32x16& p1, const bf16* Ks, const bf16x8* qr, int r32, int hi) {
  p0 = f32x16{}; p1 = f32x16{};
  for (int d0 = 0; d0 < 8; ++d0) { int cb = (d0 * 16 + hi * 8) * 2;
    bf16x8 b0 = *reinterpret_cast<const bf16x8*>((const char*)Ks + KSWZ(r32, cb));
    bf16x8 b1 = *reinterpret_cast<const bf16x8*>((const char*)Ks + KSWZ(32 + r32, cb));
    p0 = __builtin_amdgcn_mfma_f32_32x32x16_bf16(b0, qr[d0], p0, 0, 0, 0);
    p1 = __builtin_amdgcn_mfma_f32_32x32x16_bf16(b1, qr[d0], p1, 0, 0, 0); }
}
__device__ __forceinline__ int v_st(int k, int c) { const int kk = (k & ~0xC) | ((k & 4) << 1) | ((k & 8) >> 1); return ((kk >> 3) * 4 + (c >> 5)) * 512 + ((kk & 7) * 32 + (c & 31)) * 2; }
__device__ __forceinline__ int v_rd_base(int lane) { return ((lane & 3) << 3) | (((lane >> 2) & 3) << 6) | (((lane >> 4) & 1) << 5) | (((lane >> 5) & 1) << 8); }
constexpr int v_rd_off(int d0, int ks, int half) { return d0 * 512 + ks * 4096 + half * 2048; }
template <int OFF> __device__ __forceinline__ s16x4 tr_read(int vb) {
  s16x4 r; asm volatile("ds_read_b64_tr_b16 %0, %1 offset:%2" : "=&v"(r) : "v"(vb), "i"(OFF) : "memory"); return r;
}
template <int D0> __device__ __forceinline__ void pv_one(f32x16& od, int vb, bf16x8 pa0, bf16x8 pa1, bf16x8 pa2, bf16x8 pa3) {
  const s16x4 l0 = tr_read<v_rd_off(D0, 0, 0)>(vb), h0 = tr_read<v_rd_off(D0, 0, 1)>(vb), l1 = tr_read<v_rd_off(D0, 1, 0)>(vb), h1 = tr_read<v_rd_off(D0, 1, 1)>(vb);
  const s16x4 l2 = tr_read<v_rd_off(D0, 2, 0)>(vb), h2 = tr_read<v_rd_off(D0, 2, 1)>(vb), l3 = tr_read<v_rd_off(D0, 3, 0)>(vb), h3 = tr_read<v_rd_off(D0, 3, 1)>(vb);
  asm volatile("s_waitcnt lgkmcnt(0)" ::: "memory"); SBAR();
#define PK(L, H) (bf16x8){L[0], L[1], L[2], L[3], H[0], H[1], H[2], H[3]}
  od = __builtin_amdgcn_mfma_f32_32x32x16_bf16(pa0, PK(l0, h0), od, 0, 0, 0);
  od = __builtin_amdgcn_mfma_f32_32x32x16_bf16(pa1, PK(l1, h1), od, 0, 0, 0);
  od = __builtin_amdgcn_mfma_f32_32x32x16_bf16(pa2, PK(l2, h2), od, 0, 0, 0);
  od = __builtin_amdgcn_mfma_f32_32x32x16_bf16(pa3, PK(l3, h3), od, 0, 0, 0);
#undef PK
}
__device__ __forceinline__ void pv_d0(f32x16* o, int vb, bf16x8 pa0, bf16x8 pa1, bf16x8 pa2, bf16x8 pa3) {
  pv_one<0>(o[0], vb, pa0, pa1, pa2, pa3); pv_one<1>(o[1], vb, pa0, pa1, pa2, pa3); pv_one<2>(o[2], vb, pa0, pa1, pa2, pa3); pv_one<3>(o[3], vb, pa0, pa1, pa2, pa3);
}

__device__ __forceinline__ void attn_dense_body(const bf16* Qb, const bf16* __restrict__ Kh, const bf16* __restrict__ Vh,
                                                unsigned short* Ob, const unsigned short* __restrict__ Gb, int seq, char* lds) {
  using TQ = bf16;
  using St = Stage<bf16>; using SQ = Stage<TQ>;
  int tid_l = threadIdx.x; asm volatile("" : "+v"(tid_l));
  const int tid = tid_l, wid = tid >> 6, lane = tid & 63, r32 = lane & 31, hi = lane >> 5;
  bf16* V_lds = (bf16*)lds; bf16* K_lds = (bf16*)(lds + 2 * SHM_V);
  float* ws = (float*)(lds + 2 * SHM_V + 2 * SHM_K) + wid * 64; float* li_l = ws; float* al_l = ws + 32;
  float m_reg = -1e30f, l_reg = 0; f32x16 o[4] = {}; bf16x8 qr[8];
  const TQ* Qw = Qb + (long)(wid * QBLK + r32) * LDQ + hi * 8;
#pragma unroll
  for (int d0 = 0; d0 < 8; ++d0) qr[d0] = SQ::tobf(SQ::ld8(Qw + d0 * 16));
  const int sr = tid >> 4, sc = (tid & 15) * 8, vst0 = v_st(sr, sc), vst1 = v_st(32 + sr, sc);
  const int vb0 = (int)(uintptr_t)V_lds + v_rd_base(lane);
  struct { typename St::T vs0, vs1, ks0, ks1; } sr_[SDEPTH];
#define SLOAD(i, k0) do { sr_[i].vs0 = St::ld8(&Vh[(long)((k0) + sr) * LDK + sc]); sr_[i].vs1 = St::ld8(&Vh[(long)((k0) + 32 + sr) * LDK + sc]); \
    sr_[i].ks0 = St::ld8(&Kh[(long)((k0) + sr) * LDK + sc]); sr_[i].ks1 = St::ld8(&Kh[(long)((k0) + 32 + sr) * LDK + sc]); } while (0)
#define SWRITE(b, i) do { *(bf16x8*)((char*)V_lds + (b) * SHM_V + vst0) = St::tobf(sr_[i].vs0);          \
    *(bf16x8*)((char*)V_lds + (b) * SHM_V + vst1) = St::tobf(sr_[i].vs1); int kc = sc * 2;               \
    *(bf16x8*)((char*)K_lds + (b) * SHM_K + KSWZ(sr, kc)) = St::tobf(sr_[i].ks0);                       \
    *(bf16x8*)((char*)K_lds + (b) * SHM_K + KSWZ(32 + sr, kc)) = St::tobf(sr_[i].ks1); } while (0)
#define SWAIT() do { if constexpr (SDEPTH == 2) asm volatile("s_waitcnt vmcnt(4)" ::: "memory"); else asm volatile("s_waitcnt vmcnt(0)" ::: "memory"); } while (0)
#define RESC(a) do { if (__any((a) < 1.f)) { if (hi == 0) al_l[r32] = (a); asm volatile("s_waitcnt lgkmcnt(0)" ::: "memory"); \
    for (int d = 0; d < 4; ++d) for (int r = 0; r < 16; ++r) o[d][r] *= al_l[crow(r, hi)]; } } while (0)
  f32x16 pA0, pA1, pB0, pB1; float mnA, mnB, alA, alB; bf16x8 pa0, pa1, pa2, pa3; const int NT = seq / KVBLK;
  constexpr int SE = 0, SO = SDEPTH - 1;
  SLOAD(SE, 0); asm volatile("s_waitcnt vmcnt(0)" ::: "memory"); SWRITE(0, SE); __syncthreads();
  qkt(pA0, pA1, K_lds, qr, r32, hi); partialSM(pA0, pA1, m_reg, mnA, alA);
  SLOAD(SO, KVBLK); if constexpr (SDEPTH == 2) { if (2 < NT) SLOAD(SE, 2 * KVBLK); }
  SWAIT(); SWRITE(1, SO); __syncthreads();
  for (int j = 1; j + 1 < NT; j += 2) {
    SBAR(); qkt(pB0, pB1, (bf16*)((char*)K_lds + SHM_K), qr, r32, hi);
    finishSM(pA0, pA1, alA, l_reg, pa0, pa1, pa2, pa3); SBAR();
    SLOAD(SO, (j + SDEPTH) * KVBLK); SBAR();
    pv_d0(o, vb0, pa0, pa1, pa2, pa3); partialSM(pB0, pB1, m_reg, mnB, alB);
    __syncthreads(); SWAIT(); SWRITE(0, SE);
    RESC(alB); __syncthreads();
    SBAR(); qkt(pA0, pA1, K_lds, qr, r32, hi);
    finishSM(pB0, pB1, alB, l_reg, pa0, pa1, pa2, pa3); SBAR();
    if (SDEPTH == 1 || j + 3 < NT) SLOAD(SE, (j + 1 + SDEPTH) * KVBLK); SBAR();
    pv_d0(o, vb0 + (int)SHM_V, pa0, pa1, pa2, pa3); partialSM(pA0, pA1, m_reg, mnA, alA);
    __syncthreads(); SWAIT(); SWRITE(1, SO);
    RESC(alA); __syncthreads();
  }
  SBAR(); qkt(pB0, pB1, (bf16*)((char*)K_lds + SHM_K), qr, r32, hi);
  finishSM(pA0, pA1, alA, l_reg, pa0, pa1, pa2, pa3); SBAR();
  pv_d0(o, vb0, pa0, pa1, pa2, pa3); partialSM(pB0, pB1, m_reg, mnB, alB);
  __syncthreads(); RESC(alB);
  finishSM(pB0, pB1, alB, l_reg, pa0, pa1, pa2, pa3); SBAR();
  pv_d0(o, vb0 + (int)SHM_V, pa0, pa1, pa2, pa3);
  if (hi == 0) li_l[r32] = l_reg; asm volatile("s_waitcnt lgkmcnt(0)" ::: "memory");
  float rli[16];
#pragma unroll
  for (int r = 0; r < 16; ++r) rli[r] = __builtin_amdgcn_rcpf(li_l[crow(r, hi)]);
  unsigned short* Ow = Ob + (long)(wid * QBLK) * LDO; const unsigned short* Gw = Gb + (long)(wid * QBLK) * LDO;
#pragma unroll
  for (int r = 0; r < 16; ++r) { int orow = crow(r, hi); asm volatile("" ::: "memory");
#pragma unroll
    for (int d0 = 0; d0 < 4; ++d0) { const long ix = (long)orow * LDO + d0 * 32 + r32; const float g = __uint_as_float((unsigned)Gw[ix] << 16);
      const float v = o[d0][r] * rli[r] * g; unsigned u = __float_as_uint(v); u = (u + 0x7fffu + ((u >> 16) & 1u)) >> 16; Ow[ix] = (unsigned short)u; } }
#undef SLOAD
#undef SWRITE
#undef SWAIT
#undef RESC
}

#undef KSWZ
#undef SBAR
}
using pg8::bf16_t; using pg8::bf16x8; using pg8::f32x4; using pg8::u32x4;
typedef float f32x16 __attribute__((ext_vector_type(16)));
typedef unsigned u32x2 __attribute__((ext_vector_type(2)));
constexpr size_t MiB = 1u << 20;
constexpr size_t WS_MOD = 0;
constexpr size_t WS_HDN = 1 * MiB;
constexpr size_t WS_HDNC = 2 * MiB;
constexpr size_t WS_STATP = 3 * MiB;
constexpr size_t WS_YSQ = 6 * MiB;
constexpr size_t WS_WIN = 10 * MiB;
constexpr size_t WS_WHYO = 35 * MiB, WS_WATTO = 37 * MiB, WS_WGMO = 39 * MiB, WS_WOUT = 41 * MiB;
constexpr size_t WS_GMWS = 43 * MiB;
constexpr size_t WS_FILT = 44 * MiB;
constexpr size_t WS_FILTC = 76 * MiB;
constexpr size_t WS_H = 78 * MiB;
constexpr size_t UNIT = 68 * MiB;
constexpr size_t WS_R0 = 146 * MiB, WS_R1 = WS_R0 + UNIT, WS_R2 = WS_R1 + UNIT, WS_R3 = WS_R2 + UNIT, WS_R4 = WS_R3 + UNIT, WS_END = WS_R4 + UNIT;
static_assert((size_t)MT * 1024 * 2 == UNIT, "unit");
constexpr int LDS_BYTES = 147456;

__device__ __forceinline__ unsigned f2bf(float f) { unsigned u = __float_as_uint(f); return (u + 0x7fffu + ((u >> 16) & 1u)) >> 16; }
__device__ __forceinline__ float bf2f(unsigned short b) { return __uint_as_float((unsigned)b << 16); }
__device__ __forceinline__ unsigned pk2(float lo, float hi) { return pg8::cvt_pk_bf16(lo, hi); }
__device__ __forceinline__ float wave_sum(float v) { v = sx_add<1>(v); v = sx_add<2>(v); v = sx_add<4>(v); v = sx_add<8>(v); v = sx_add<16>(v); v = sx_add<32>(v); return v; }
#define LDS_WAIT() asm volatile("s_waitcnt lgkmcnt(0)" ::: "memory")
__device__ __forceinline__ int crow(int r, int hi) { return (r & 3) + 8 * (r >> 2) + 4 * hi; }

struct Args { const float* in[29]; float* out; unsigned char* ws; int ph_lo, ph_hi; };
enum { I_X = 0, I_C, I_CTX, I_CCTX, I_WMOD, I_BMOD, I_GPRE, I_GPOST, I_WIN, I_HCW, I_HCB, I_HW1, I_HB1, I_HW2, I_HB2, I_HW3, I_HFREQ, I_HDECAY, I_HBIAS,
       I_QG, I_KG, I_LNG, I_LNB, I_GMWS, I_GMBS, I_WHYO, I_WATTO, I_WGMO, I_WOUT };

__device__ __forceinline__ void transpose_item(const float* W, int K, int N, bf16_t* WT, int k0, int n0, int dst_row0, LAS float* scr, int lane) {
    float tv[32];
#pragma unroll
    for (int i = 0; i < 32; ++i) { const int kk = 2 * i + (lane >> 5); tv[i] = W[(size_t)(k0 + kk) * N + n0 + (lane & 31)]; }
#pragma unroll
    for (int i = 0; i < 32; ++i) { const int kk = 2 * i + (lane >> 5); scr[kk * 33 + (lane & 31)] = tv[i]; }
    LDS_WAIT(); asm volatile("" ::: "memory");
    const int c = lane & 7;
#pragma unroll
    for (int j = 0; j < 4; ++j) { const int n = (lane >> 3) + 8 * j; const LAS float* s = scr + (8 * c) * 33 + n;
        u32x4 o; o.x = pk2(s[0 * 33], s[1 * 33]); o.y = pk2(s[2 * 33], s[3 * 33]); o.z = pk2(s[4 * 33], s[5 * 33]); o.w = pk2(s[6 * 33], s[7 * 33]);
        *(u32x4*)(WT + (size_t)(dst_row0 + n) * K + k0 + 8 * c) = o; }
    LDS_WAIT(); asm volatile("" ::: "memory");
}
__device__ __forceinline__ int win_remap(int src) {
    if (src < 4096) return src;
    if (src < 6656) return src + 1024;
    if (src < 7680) return src + 2048;
    if (src < 8704) return src + 4096;
    if (src < 9728) return src + 1024;
    if (src < 10752) return src - 5632;
    if (src < 11776) return src - 3072;
    return src - 1024;
}

__device__ __forceinline__ float silu_f(float x) { return x / (1.0f + __expf(-x)); }

__device__ __forceinline__ void hdn_item(const float* w1, const float* b1, const float* w2, const float* b2, const float* freq, int t, int L, bf16_t* dst, int lane) {
    const float tl = (float)t / (float)(L - 1);
    float zv = 0.f;
    if (lane == 0) zv = tl;
    else if (lane < 33) { const int jb = (lane - 1) & 15; const float band = 1e-4f + (float)jb * ((15.0f - 1e-4f) / 15.0f);
        const float ang = ((6.283185307179586f / (float)L) * (float)t) * band; zv = (lane < 17) ? cosf(ang) : -sinf(ang); }
    float a = b1[lane];
#pragma unroll
    for (int i = 0; i < 33; ++i) a += __uint_as_float(__builtin_amdgcn_readlane(__float_as_uint(zv), i)) * w1[i * 64 + lane];
    const float h1 = sinf(freq[lane] * a);
    float a2 = b2[lane];
#pragma unroll
    for (int k = 0; k < 64; ++k) a2 += __uint_as_float(__builtin_amdgcn_readlane(__float_as_uint(h1), k)) * w2[k * 64 + lane];
    dst[t * 128 + lane] = (bf16_t)f2bf(sinf(freq[64 + lane] * a2)); dst[t * 128 + 64 + lane] = 0;
}
__device__ __forceinline__ void h_row(const f32x4 (&v)[4], const float* gpre, const float* modr, bf16_t* hrow, int lane) {
    float s = 0.f;
#pragma unroll
    for (int j = 0; j < 4; ++j) s += (v[j].x * v[j].x + v[j].y * v[j].y) + (v[j].z * v[j].z + v[j].w * v[j].w);
    const float rn = rsqrtf(wave_sum(s) * (1.f / 1024.f) + 1e-6f);
#pragma unroll
    for (int j = 0; j < 4; ++j) { const int col = 4 * lane + 256 * j;
        const f32x4 g = *(const f32x4*)(gpre + col), sh = *(const f32x4*)(modr + col), sc = *(const f32x4*)(modr + 1024 + col);
        const f32x4 y = (v[j] * rn) * g * (sc + 1.0f) + sh;
        u32x2 w; w.x = pk2(y.x, y.y); w.y = pk2(y.z, y.w); *(u32x2*)(hrow + col) = w; }
}

template <int NTB>
__device__ __forceinline__ void lconv_unit(LAS unsigned char* lds, const bf16_t* zsrc, bool zconv, float zw0, float zw1, float zw2, float zb,
                                           const bf16_t* gsrcA, float gA0, float gA1, float gA2, float gAb, const bf16_t* gsrcB, float gB0, float gB1, float gB2, float gBb,
                                           const bf16_t* filtA, const bf16_t* filtB, float biasA, float biasB, bf16_t* dst) {
    constexpr int L = 64 * NTB;
    constexpr int RS = (L + 384) * 2 + 16;
    constexpr int FOFF = 8 * RS;
    constexpr int CLB = (((2 * L + 8) * 2 + 255) / 256) * 256 + 64;
    static_assert(FOFF % 16 == 0 && FOFF + 4 * CLB <= 144 * 1024, "lconv LDS");
    int tid_l = threadIdx.x; asm volatile("" : "+v"(tid_l));
    const int tid = tid_l, lane = tid & 63, wid = __builtin_amdgcn_readfirstlane(tid >> 6);
    const int n = lane & 31, h = lane >> 5;
    if (tid < 384) { const int b = tid / 48, j = tid % 48; const int off = b * RS + (j < 24 ? j * 16 : (192 + L) * 2 + (j - 24) * 16);
        *(LAS u32x4*)(lds + off) = zero4(); }
    constexpr int NIT = (L + 511) / 512;
    {
        u32x4 raw[NIT]; unsigned short pv[NIT], nx[NIT];
#pragma unroll
        for (int it = 0; it < NIT; ++it) { const int i = tid + 512 * it; raw[it] = zero4(); pv[it] = 0; nx[it] = 0;
            if (i < L) { const int b = i / (L / 8), s0 = (i % (L / 8)) * 8; const bf16_t* p = zsrc + (size_t)b * L + s0; raw[it] = *(const u32x4*)p;
                if (zconv) { if (s0 > 0) pv[it] = p[-1]; if (s0 + 8 < L) nx[it] = p[8]; } } }
#pragma unroll
        for (int it = 0; it < NIT; ++it) { const int i = tid + 512 * it;
            if (i < L) { const int b = i / (L / 8), s0 = (i % (L / 8)) * 8; u32x4 r4 = raw[it];
                if (zconv) {
                    float x[10];
                    x[0] = bf2f(pv[it]); x[9] = bf2f(nx[it]);
                    x[1] = pg8::bflo(r4.x); x[2] = pg8::bfhi(r4.x); x[3] = pg8::bflo(r4.y); x[4] = pg8::bfhi(r4.y);
                    x[5] = pg8::bflo(r4.z); x[6] = pg8::bfhi(r4.z); x[7] = pg8::bflo(r4.w); x[8] = pg8::bfhi(r4.w);
                    float y[8];
#pragma unroll
                    for (int e = 0; e < 8; ++e) y[e] = zw0 * x[e] + zw1 * x[e + 1] + zw2 * x[e + 2] + zb;
                    r4.x = pk2(y[0], y[1]); r4.y = pk2(y[2], y[3]); r4.z = pk2(y[4], y[5]); r4.w = pk2(y[6], y[7]);
                }
                *(LAS u32x4*)(lds + b * RS + (192 + s0) * 2) = r4; } }
    }
#pragma unroll 1
    for (int o = 0; o < 2; ++o) {
    int tid_o = tid_l; asm volatile("" : "+v"(tid_o));
    const int tid = tid_o, lane = tid & 63, wid = __builtin_amdgcn_readfirstlane(tid >> 6), n = lane & 31, h = lane >> 5;
    const bf16_t* gsrc = o ? gsrcB : gsrcA; const float gw0 = o ? gB0 : gA0, gw1 = o ? gB1 : gA1, gw2 = o ? gB2 : gA2, gb = o ? gBb : gAb;
    const bf16_t* filt = o ? filtB : filtA; const float bias = o ? biasB : biasA;
    if (tid < 36) { const int s = tid / 9, j = tid % 9; const int y = (j < 5 - s) ? j : 2 * L + 4 - s + (j - (5 - s)); *(LAS unsigned short*)(lds + FOFF + s * CLB + 2 * y) = 0; }
    for (int j = tid; j < 2 * L / 8; j += 512) {
        const int dir = j / (L / 8), t8 = (j % (L / 8)) * 8; const u32x4 raw = *(const u32x4*)(filt + (size_t)dir * L + t8);
        unsigned short e[8]; e[0] = raw.x & 0xffff; if (j == 0) e[0] = (unsigned short)f2bf(bf2f(e[0]) + bf2f(filt[L]));
 e[1] = raw.x >> 16; e[2] = raw.y & 0xffff; e[3] = raw.y >> 16; e[4] = raw.z & 0xffff; e[5] = raw.z >> 16; e[6] = raw.w & 0xffff; e[7] = raw.w >> 16;
#pragma unroll
        for (int i = 0; i < 8; ++i) { const int t = t8 + i; if (dir == 1 && t == 0) continue; const int d = dir ? -t : t;
#pragma unroll
            for (int s = 0; s < 4; ++s) { const int y = L + 4 - d - s; *(LAS unsigned short*)(lds + FOFF + s * CLB + 2 * y) = e[i]; } }
    }
    __syncthreads();
    u32x4 graw[NIT]; unsigned short gpv[NIT], gnx[NIT];
#define LC_GPREF() do { _Pragma("unroll") for (int it = 0; it < NIT; ++it) { const int i = tid + 512 * it; graw[it] = zero4(); gpv[it] = 0; gnx[it] = 0; \
        if (i < L) { const int b = i / (L / 8), s0 = (i % (L / 8)) * 8; const bf16_t* p = gsrc + (size_t)b * L + s0; graw[it] = *(const u32x4*)p; \
            if (s0 > 0) gpv[it] = p[-1]; if (s0 + 8 < L) gnx[it] = p[8]; } } } while (0)
    if constexpr (NTB != 64) LC_GPREF();
    const int Tw = 8 * wid;
    f32x16 acc[2][2];
#pragma unroll
    for (int a = 0; a < 2; ++a)
#pragma unroll
        for (int c = 0; c < 2; ++c)
#pragma unroll
            for (int r = 0; r < 16; ++r) acc[a][c][r] = 0.f;
    if (Tw < NTB) {
        const int sft = (4 - (n & 3)) & 3;
        const LAS unsigned char* bp = lds + FOFF + sft * CLB + 2 * (8 * h - n - sft + L + 4);
        const LAS unsigned char* zp = lds + (n & 7) * RS + 384 + 128 * (Tw + (n >> 3)) + 16 * h;
#define LC_LDT(TF, DD) do { _Pragma("unroll") for (int f = 0; f < 6; ++f) { const LAS unsigned char* q = bp + 32 * (f - 2 - 4 * (DD)); \
            const u32x2 lo = *(const LAS u32x2*)q, hi2 = *(const LAS u32x2*)(q + 8); const u32x4 w = (u32x4){lo.x, lo.y, hi2.x, hi2.y}; TF[f] = __builtin_bit_cast(bf16x8, w); } } while (0)
#define LC_LDZ(ZF, mt, DD) do { _Pragma("unroll") for (int ks = 0; ks < 4; ++ks) ZF[ks] = *(const LAS bf16x8*)(zp + 512 * (mt) + 32 * ks - 128 * (DD)); } while (0)
#define LC_MMA1(TF, ZF, mt) do { _Pragma("unroll") for (int ks = 0; ks < 4; ++ks) _Pragma("unroll") for (int nt = 0; nt < 2; ++nt) \
            acc[mt][nt] = __builtin_amdgcn_mfma_f32_32x32x16_bf16(ZF[ks], TF[ks - 2 * nt + 2], acc[mt][nt], 0, 0, 0); } while (0)
#define LC_MMA2(TF, ZF0, ZF1) do { _Pragma("unroll") for (int ks = 0; ks < 4; ++ks) _Pragma("unroll") for (int nt = 0; nt < 2; ++nt) { \
            acc[0][nt] = __builtin_amdgcn_mfma_f32_32x32x16_bf16(ZF0[ks], TF[ks - 2 * nt + 2], acc[0][nt], 0, 0, 0); \
            acc[1][nt] = __builtin_amdgcn_mfma_f32_32x32x16_bf16(ZF1[ks], TF[ks - 2 * nt + 2], acc[1][nt], 0, 0, 0); } } while (0)
        bf16x8 tfA[6], tfB[6], zA0[4], zA1[4], zB0[4], zB1[4];
        if constexpr (NTB == 64) {
            for (int Dd = Tw - 63; Dd < Tw - 59; ++Dd) { LC_LDT(tfA, Dd); LC_LDZ(zA0, 0, Dd); LC_MMA1(tfA, zA0, 0); }
            int Dd = Tw - 59;
            LC_LDT(tfA, Dd); LC_LDZ(zA0, 0, Dd); LC_LDZ(zA1, 1, Dd);
            for (int it = 0; it < 31; ++it) {
                LC_LDT(tfB, Dd + 1); LC_LDZ(zB0, 0, Dd + 1); LC_LDZ(zB1, 1, Dd + 1);
                __builtin_amdgcn_sched_barrier(0);
                LC_MMA2(tfA, zA0, zA1);
                __builtin_amdgcn_sched_barrier(0);
                LC_LDT(tfA, Dd + 2); LC_LDZ(zA0, 0, Dd + 2); LC_LDZ(zA1, 1, Dd + 2);
                __builtin_amdgcn_sched_barrier(0);
                LC_MMA2(tfB, zB0, zB1);
                __builtin_amdgcn_sched_barrier(0);
                Dd += 2;
            }
            LC_MMA2(tfA, zA0, zA1);
            LC_GPREF();
            for (int D3 = Tw + 4; D3 < Tw + 8; ++D3) { LC_LDT(tfA, D3); LC_LDZ(zA1, 1, D3); LC_MMA1(tfA, zA1, 1); }
        } else {
            for (int Dd = -(NTB - 1); Dd <= NTB - 1; ++Dd) { LC_LDT(tfA, Dd); LC_LDZ(zA0, 0, Dd); LC_MMA1(tfA, zA0, 0); }
        }
#undef LC_LDT
#undef LC_LDZ
#undef LC_MMA1
#undef LC_MMA2
#undef LC_GPREF
    }
    __syncthreads();
    if (Tw < NTB) {
#pragma unroll
        for (int mt = 0; mt < 2; ++mt) {
            if (Tw + 4 * mt < NTB) {
#pragma unroll
                for (int nt = 0; nt < 2; ++nt)
#pragma unroll
                    for (int r = 0; r < 16; ++r) {
                        const int b = (r & 3) + 4 * h, Tl = r >> 2, s = 64 * (Tw + 4 * mt + Tl) + 32 * nt + n;
                        LAS unsigned short* zq = (LAS unsigned short*)(lds + b * RS + (192 + s) * 2);
                        *zq = (unsigned short)f2bf(acc[mt][nt][r] + bias * bf2f(*zq));
                    }
            }
        }
    }
    __syncthreads();
    {
#pragma unroll
        for (int it = 0; it < NIT; ++it) { const int i = tid + 512 * it;
            if (i < L) { const int b = i / (L / 8), s0 = (i % (L / 8)) * 8; const u32x4 r4 = graw[it]; const u32x4 st = *(const LAS u32x4*)(lds + b * RS + (192 + s0) * 2);
                float x[10];
                x[0] = bf2f(gpv[it]); x[9] = bf2f(gnx[it]);
                x[1] = pg8::bflo(r4.x); x[2] = pg8::bfhi(r4.x); x[3] = pg8::bflo(r4.y); x[4] = pg8::bfhi(r4.y);
                x[5] = pg8::bflo(r4.z); x[6] = pg8::bfhi(r4.z); x[7] = pg8::bflo(r4.w); x[8] = pg8::bfhi(r4.w);
                float sv[8]; sv[0] = pg8::bflo(st.x); sv[1] = pg8::bfhi(st.x); sv[2] = pg8::bflo(st.y); sv[3] = pg8::bfhi(st.y); sv[4] = pg8::bflo(st.z); sv[5] = pg8::bfhi(st.z); sv[6] = pg8::bflo(st.w); sv[7] = pg8::bfhi(st.w);
                float y[8];
#pragma unroll
                for (int e = 0; e < 8; ++e) y[e] = (gw0 * x[e] + gw1 * x[e + 1] + gw2 * x[e + 2] + gb) * sv[e];
                u32x4 w; w.x = pk2(y[0], y[1]); w.y = pk2(y[2], y[3]); w.z = pk2(y[4], y[5]); w.w = pk2(y[6], y[7]);
                if (o == 0) *(LAS u32x4*)(lds + b * RS + (192 + s0) * 2) = w;
                else *(u32x4*)(dst + (size_t)b * L + s0) = w; } }
    }
    __syncthreads();
    }
}
__device__ __forceinline__ void gmlp_unit(LAS unsigned char* lds, int tok0, int g, const bf16_t* vT, const float* statp, const bf16_t* gmws, const float* bs,
                                          const float* lng, const float* lnb, bf16_t* U, const bf16_t* GG) {
    int tid_l = threadIdx.x; asm volatile("" : "+v"(tid_l));
    const int tid = tid_l, lane = tid & 63, wid = __builtin_amdgcn_readfirstlane(tid >> 6), n = lane & 31, h = lane >> 5;
    LAS float* mean = (LAS float*)lds; LAS float* rstd = mean + 128;
    constexpr int VOFF = 1024, VRS = 272, YOFF = VOFF + 128 * VRS, YRS = 132;
    { u32x4 raw[4];
#pragma unroll
      for (int q = 0; q < 4; ++q) { const int idx = tid + 512 * q, c = idx >> 4, ch = idx & 15; raw[q] = *(const u32x4*)(vT + (size_t)(g * 128 + c) * MT + tok0 + ch * 8); }
      if (tid < 128) { float s = 0.f, q2 = 0.f;
#pragma unroll
          for (int p = 0; p < 8; ++p) { const float* sp = statp + ((size_t)p * MT + tok0 + tid) * 2; s += sp[0]; q2 += sp[1]; }
          const float mu = s * (1.f / 1024.f); const float var = fmaxf(q2 * (1.f / 1024.f) - mu * mu, 0.f);
          mean[tid] = mu; rstd[tid] = rsqrtf(var + 1e-5f); }
#pragma unroll
      for (int q = 0; q < 4; ++q) { const int idx = tid + 512 * q, c = idx >> 4, ch = idx & 15; *(LAS u32x4*)(lds + VOFF + c * VRS + ch * 16) = raw[q]; } }
    __syncthreads();
    const int pt = wid >> 1, ctb = (wid & 1) * 2;
    f32x16 acc[2];
#pragma unroll
    for (int c = 0; c < 2; ++c)
#pragma unroll
        for (int r = 0; r < 16; ++r) acc[c][r] = 0.f;
    const bf16_t* ap = gmws + ((size_t)g * 128 + 32 * pt + n) * 128 + 8 * h;
    bf16x8 af[8];
#pragma unroll
    for (int ks = 0; ks < 8; ++ks) af[ks] = *(const bf16x8*)(ap + 16 * ks);
    float ga[2], be[2];
#pragma unroll
    for (int ct = 0; ct < 2; ++ct) { const int cgl = g * 128 + 32 * (ctb + ct) + n; ga[ct] = lng[cgl]; be[ct] = lnb[cgl]; }
#pragma unroll
    for (int ks = 0; ks < 8; ++ks) {
        float mu[8], rs[8];
#pragma unroll
        for (int e = 0; e < 8; ++e) { mu[e] = mean[16 * ks + 8 * h + e]; rs[e] = rstd[16 * ks + 8 * h + e]; }
#pragma unroll
        for (int ct = 0; ct < 2; ++ct) {
            const u32x4 raw = *(const LAS u32x4*)(lds + VOFF + (32 * (ctb + ct) + n) * VRS + (16 * ks + 8 * h) * 2);
            u32x4 w;
            w.x = pk2((pg8::bflo(raw.x) - mu[0]) * rs[0] * ga[ct] + be[ct], (pg8::bfhi(raw.x) - mu[1]) * rs[1] * ga[ct] + be[ct]);
            w.y = pk2((pg8::bflo(raw.y) - mu[2]) * rs[2] * ga[ct] + be[ct], (pg8::bfhi(raw.y) - mu[3]) * rs[3] * ga[ct] + be[ct]);
            w.z = pk2((pg8::bflo(raw.z) - mu[4]) * rs[4] * ga[ct] + be[ct], (pg8::bfhi(raw.z) - mu[5]) * rs[5] * ga[ct] + be[ct]);
            w.w = pk2((pg8::bflo(raw.w) - mu[6]) * rs[6] * ga[ct] + be[ct], (pg8::bfhi(raw.w) - mu[7]) * rs[7] * ga[ct] + be[ct]);
            acc[ct] = __builtin_amdgcn_mfma_f32_32x32x16_bf16(af[ks], __builtin_bit_cast(bf16x8, w), acc[ct], 0, 0, 0);
        }
    }
#pragma unroll
    for (int ct = 0; ct < 2; ++ct)
#pragma unroll
        for (int r = 0; r < 16; ++r) { const int p = 32 * pt + crow(r, h); ((LAS float*)(lds + YOFF))[p * YRS + 32 * (ctb + ct) + n] = acc[ct][r] + bs[g * 128 + p]; }
    __syncthreads();
    { u32x4 uu[4], gg[4];
#pragma unroll
      for (int q = 0; q < 4; ++q) { const int idx = tid + 512 * q, p = idx >> 4, ch = idx & 15; const size_t ix = (size_t)(tok0 + p) * 1024 + g * 128 + ch * 8; uu[q] = *(const u32x4*)(U + ix); gg[q] = *(const u32x4*)(GG + ix); }
#pragma unroll
      for (int q = 0; q < 4; ++q) { const int idx = tid + 512 * q, p = idx >> 4, ch = idx & 15; const size_t ix = (size_t)(tok0 + p) * 1024 + g * 128 + ch * 8;
        const LAS float* yp = (const LAS float*)(lds + YOFF) + p * YRS + ch * 8; const f32x4 y0 = *(const LAS f32x4*)yp, y1 = *(const LAS f32x4*)(yp + 4); u32x4 w;
        w.x = pk2(pg8::bflo(uu[q].x) * y0.x * pg8::bflo(gg[q].x), pg8::bfhi(uu[q].x) * y0.y * pg8::bfhi(gg[q].x));
        w.y = pk2(pg8::bflo(uu[q].y) * y0.z * pg8::bflo(gg[q].y), pg8::bfhi(uu[q].y) * y0.w * pg8::bfhi(gg[q].y));
        w.z = pk2(pg8::bflo(uu[q].z) * y1.x * pg8::bflo(gg[q].z), pg8::bfhi(uu[q].z) * y1.y * pg8::bfhi(gg[q].z));
        w.w = pk2(pg8::bflo(uu[q].w) * y1.z * pg8::bflo(gg[q].w), pg8::bfhi(uu[q].w) * y1.w * pg8::bfhi(gg[q].w));
        *(u32x4*)(U + ix) = w; } }
    __syncthreads();
}

__device__ __forceinline__ void qk_part(const bf16_t* src, bf16_t* dstp, const float* gain, const float* rope, int lane, bool lat, int s, bool active) {
    const int block = lane >> 2, j = lane & 3, axis = block & 1, off = (block >> 1) * 128 + axis * 64 + 8 * j;
    u32x4 ra = zero4(), rb = ra;
    if (active) { ra = *(const u32x4*)(src + off); rb = *(const u32x4*)(src + off + 32); }
    float a[8], c[8];
    a[0] = pg8::bflo(ra.x); a[1] = pg8::bfhi(ra.x); a[2] = pg8::bflo(ra.y); a[3] = pg8::bfhi(ra.y); a[4] = pg8::bflo(ra.z); a[5] = pg8::bfhi(ra.z); a[6] = pg8::bflo(ra.w); a[7] = pg8::bfhi(ra.w);
    c[0] = pg8::bflo(rb.x); c[1] = pg8::bfhi(rb.x); c[2] = pg8::bflo(rb.y); c[3] = pg8::bfhi(rb.y); c[4] = pg8::bflo(rb.z); c[5] = pg8::bfhi(rb.z); c[6] = pg8::bflo(rb.w); c[7] = pg8::bfhi(rb.w);
    float ss = 0.f;
#pragma unroll
    for (int e = 0; e < 8; ++e) ss += a[e] * a[e] + c[e] * c[e];
    ss = sx_add<1>(ss); ss = sx_add<2>(ss); ss = sx_add<4>(ss);
    const float rn = rsqrtf(ss * (1.f / 128.f) + 1e-6f);
    const float* gp = gain + axis * 64 + 8 * j;
    const f32x4 g0 = *(const f32x4*)gp, g1 = *(const f32x4*)(gp + 4), g2 = *(const f32x4*)(gp + 32), g3 = *(const f32x4*)(gp + 36);
    const float ga[8] = {g0.x, g0.y, g0.z, g0.w, g1.x, g1.y, g1.z, g1.w}, gc[8] = {g2.x, g2.y, g2.z, g2.w, g3.x, g3.y, g3.z, g3.w};
    float o1[8], o2[8];
    if (lat) {
        const int pos = axis ? (s & 63) : (s >> 6); const float* rp = rope + (size_t)(pos * 32 + 8 * j) * 2;
        const f32x4 t0 = *(const f32x4*)rp, t1 = *(const f32x4*)(rp + 4), t2 = *(const f32x4*)(rp + 8), t3 = *(const f32x4*)(rp + 12);
        const float cs[8] = {t0.x, t0.z, t1.x, t1.z, t2.x, t2.z, t3.x, t3.z}, sn[8] = {t0.y, t0.w, t1.y, t1.w, t2.y, t2.w, t3.y, t3.w};
#pragma unroll
        for (int e = 0; e < 8; ++e) { const float x = a[e] * rn * ga[e], y = c[e] * rn * gc[e]; o1[e] = x * cs[e] - y * sn[e]; o2[e] = y * cs[e] + x * sn[e]; }
    } else {
#pragma unroll
        for (int e = 0; e < 8; ++e) { o1[e] = a[e] * rn * ga[e]; o2[e] = c[e] * rn * gc[e]; }
    }
    if (active) {
        u32x4 w; w.x = pk2(o1[0], o1[1]); w.y = pk2(o1[2], o1[3]); w.z = pk2(o1[4], o1[5]); w.w = pk2(o1[6], o1[7]); *(u32x4*)(dstp + off) = w;
        w.x = pk2(o2[0], o2[1]); w.y = pk2(o2[2], o2[3]); w.z = pk2(o2[4], o2[5]); w.w = pk2(o2[6], o2[7]); *(u32x4*)(dstp + off + 32) = w; }
}
__device__ __forceinline__ void qk_row(int m, bf16_t* Q, const bf16_t* KV, bf16_t* Kp, bf16_t* Vp, const float* qg, const float* kg, const float* rope, int lane, bool doq) {
    const bool lat = m < ML; int b, s;
    if (lat) { b = m >> 12; s = m & 4095; } else { b = (m - ML) >> 8; s = (m - ML) & 255; }
    if (doq) qk_part(Q + (size_t)m * 1024, Q + (size_t)m * 1024, qg, rope, lane, lat, s, true);
    const size_t krow = (size_t)b * NKEY + (lat ? CTXL + s : s);
    const bf16_t* kr = KV + (size_t)m * 512;
    qk_part(kr, Kp + krow * 256, kg, rope, lane, lat, s, lane < 16);
    if (lane < 32) *(u32x4*)(Vp + krow * 256 + lane * 8) = *(const u32x4*)(kr + 256 + lane * 8);
}

__device__ __forceinline__ void tgate_item(LAS unsigned char* lds, const bf16_t* inT, const bf16_t* gate, bf16_t* out, int tok0, int c0) {
    int tid_l = threadIdx.x; asm volatile("" : "+v"(tid_l));
    const int tid = tid_l; LAS unsigned short* t = (LAS unsigned short*)lds;
    { const int cl = tid >> 3, ch = tid & 7; u32x4 raw[4];
#pragma unroll
      for (int q = 0; q < 4; ++q) raw[q] = *(const u32x4*)(inT + (size_t)(c0 + 64 * q + cl) * MT + tok0 + ch * 8);
#pragma unroll
      for (int q = 0; q < 4; ++q) { LAS unsigned short* d = t + q * (64 * 72) + (ch * 8) * 72 + cl;
        d[0 * 72] = (unsigned short)(raw[q].x & 0xffff); d[1 * 72] = (unsigned short)(raw[q].x >> 16); d[2 * 72] = (unsigned short)(raw[q].y & 0xffff); d[3 * 72] = (unsigned short)(raw[q].y >> 16);
        d[4 * 72] = (unsigned short)(raw[q].z & 0xffff); d[5 * 72] = (unsigned short)(raw[q].z >> 16); d[6 * 72] = (unsigned short)(raw[q].w & 0xffff); d[7 * 72] = (unsigned short)(raw[q].w >> 16); } }
    __syncthreads();
    { const int tl = tid >> 3, ch = tid & 7; u32x4 g[4];
#pragma unroll
      for (int q = 0; q < 4; ++q) g[q] = *(const u32x4*)(gate + (size_t)(tok0 + tl) * 1024 + c0 + 64 * q + ch * 8);
#pragma unroll
      for (int q = 0; q < 4; ++q) { const u32x4 v = *(const LAS u32x4*)(t + q * (64 * 72) + tl * 72 + ch * 8); u32x4 w;
        w.x = pk2(pg8::bflo(v.x) * pg8::bflo(g[q].x), pg8::bfhi(v.x) * pg8::bfhi(g[q].x)); w.y = pk2(pg8::bflo(v.y) * pg8::bflo(g[q].y), pg8::bfhi(v.y) * pg8::bfhi(g[q].y));
        w.z = pk2(pg8::bflo(v.z) * pg8::bflo(g[q].z), pg8::bfhi(v.z) * pg8::bfhi(g[q].z)); w.w = pk2(pg8::bflo(v.w) * pg8::bflo(g[q].w), pg8::bfhi(v.w) * pg8::bfhi(g[q].w));
        *(u32x4*)(out + (size_t)(tok0 + tl) * 1024 + c0 + 64 * q + ch * 8) = w; } }
    __syncthreads();
}
#define XB_TMO      128
#define XB_XCNT(j)  (256  + 64 * (j))
#define XB_XSUB(j)  (1280 + 64 * (j))
#define XB_XGEN(j)  (2304 + 64 * (j))
#define XB_TOP      3328
#define XB_TOPGEN   3392
#define XCD_BAR_WORDS 3456
#define XB_SPIN_CAP (1u << 18)

__device__ __forceinline__ unsigned xb_ld(unsigned* p)              { return __hip_atomic_load(p, __ATOMIC_RELAXED, __HIP_MEMORY_SCOPE_AGENT); }
__device__ __forceinline__ unsigned xb_add(unsigned* p, unsigned v) { return __hip_atomic_fetch_add(p, v, __ATOMIC_RELAXED, __HIP_MEMORY_SCOPE_AGENT); }
__device__ __forceinline__ unsigned xb_xcc_id() { return (unsigned)__builtin_amdgcn_s_getreg((3 << 11) | 20) & 0xFu; }
#define XB_SPIN(cond, bar) do { unsigned _sp = 0; while (cond) { __builtin_amdgcn_s_sleep(1); \
    if ((++_sp & 255u) == 0u) { if (xb_ld(&(bar)[XB_TMO])) break; if (_sp > XB_SPIN_CAP) { atomicAdd(&(bar)[XB_TMO], 1u); break; } } } } while (0)

struct XcdBarrier {
    unsigned* bar; unsigned x;
    volatile LAS unsigned* st;
};

__device__ __forceinline__ XcdBarrier xcd_barrier_post(unsigned* bar, volatile LAS unsigned* st) {
    XcdBarrier b; b.bar = bar; b.x = xb_xcc_id(); b.st = st;
    if (threadIdx.x == 0) (void)xb_add(&bar[XB_XCNT(b.x)], 1u);
    return b;
}
__device__ __forceinline__ void xcd_barrier_complete(unsigned* bar, unsigned x, unsigned& nloc, unsigned& nx) {
    const unsigned G = gridDim.x * gridDim.y * gridDim.z;
    unsigned sum, cnt, mine, sp = 0u;
    for (;;) {
        sum = 0u; cnt = 0u; mine = 0u;
#pragma unroll
        for (unsigned j = 0; j < 16; ++j) { const unsigned c = xb_ld(&bar[XB_XCNT(j)]); sum += c; cnt += (c > 0u) ? 1u : 0u; mine = (j == x) ? c : mine; }
        if (sum == G) break;
        __builtin_amdgcn_s_sleep(1);
        if ((++sp & 255u) == 0u) { if (xb_ld(&bar[XB_TMO])) break; if (sp > XB_SPIN_CAP) { atomicAdd(&bar[XB_TMO], 1u); break; } }
    }
    nloc = mine > 0u ? mine : 1u; nx = cnt > 0u ? cnt : 1u;
}

__device__ __forceinline__ void xcd_barrier(const XcdBarrier& b) {
    asm volatile("s_waitcnt vmcnt(0)" ::: "memory");
    __syncthreads();
    if (threadIdx.x == 0) {
        unsigned* bar = b.bar;
        __builtin_amdgcn_s_waitcnt(0);
        unsigned nloc = b.st[0], nx = b.st[1];
        if (nloc == 0u) { xcd_barrier_complete(bar, b.x, nloc, nx); b.st[0] = nloc; b.st[1] = nx; }
        const unsigned old = xb_add(&bar[XB_XSUB(b.x)], 1u);
        const unsigned gen = old / nloc;
        if (old + 1u == (gen + 1u) * nloc) {
            __builtin_amdgcn_fence(__ATOMIC_RELEASE, "agent");
            asm volatile("s_waitcnt vmcnt(0)" ::: "memory");
            const unsigned og = xb_add(&bar[XB_TOP], 1u);
            const unsigned tg = og / nx;
            if (og + 1u == (tg + 1u) * nx) xb_add(&bar[XB_TOPGEN], 1u);
            else XB_SPIN(xb_ld(&bar[XB_TOPGEN]) == tg, bar);
            __builtin_amdgcn_fence(__ATOMIC_ACQUIRE, "agent");
            xb_add(&bar[XB_XGEN(b.x)], 1u);
            asm volatile("s_waitcnt vmcnt(0)" ::: "memory");
        } else {
            XB_SPIN(xb_ld(&bar[XB_XGEN(b.x)]) == gen, bar);
            __builtin_amdgcn_fence(__ATOMIC_ACQUIRE, "agent");
            asm volatile("s_waitcnt vmcnt(0)" ::: "memory");
        }
    }
    __syncthreads();
}

constexpr size_t WS_BAR = 512 * 1024;
constexpr size_t WS_ROPE = 768 * 1024;
constexpr size_t WS_SPO = 492 * MiB, WS_SPG = 496 * MiB;
constexpr size_t WS_HDNB = 487 * MiB, WS_W3T = 488 * MiB, WS_HDNCB = 489 * MiB, WS_HDNB1 = 490 * MiB;
constexpr int NPH = 16;
#ifndef PHMASK
#define PHMASK 0xffff
#endif
#define PON(k) ((PHMASK >> (k)) & 1)
__global__ void __launch_bounds__(512, 2) fwd_kernel(Args args) {
    extern __shared__ __attribute__((aligned(16))) unsigned char lds_raw[];
    LAS unsigned char* lds = (LAS unsigned char*)lds_raw;
    cg::grid_group grid = cg::this_grid();
    const int G = gridDim.x, bx = blockIdx.x;
    if (threadIdx.x < 2) ((volatile LAS unsigned*)(lds + 147200))[threadIdx.x] = 0u;
    __syncthreads();
    XcdBarrier xbar; xbar.bar = (unsigned*)(args.ws + WS_BAR); xbar.x = 0; xbar.st = (volatile LAS unsigned*)(lds + 147200);
    const int vcu = (G % 8 == 0) ? (bx % 8) * (G / 8) + bx / 8 : bx;
    const int NGW = G * 8;
    if (args.ph_lo == 0) {
        int tid_p = threadIdx.x; asm volatile("" : "+v"(tid_p));
        const int lane = tid_p & 63, wave = __builtin_amdgcn_readfirstlane(tid_p >> 6); const int gw = vcu * 8 + wave; unsigned char* ws = args.ws;
        if (bx == (G > 1 ? 1 : 0)) { float* rt = (float*)(ws + WS_ROPE); for (int i = tid_p; i < 2048; i += 512) { const int pos = i >> 5, fi = i & 31; const float inv = powf(10000.0f, -(float)(2 * fi) * (1.0f / 64.0f)); const float ang = (float)pos * inv; rt[2 * i] = cosf(ang); rt[2 * i + 1] = sinf(ang); } }
        for (int it = gw; it < 4096 + 256 + 4096; it += NGW) {
            const int lw = (it < 4352) ? 0 : 1;
            const float* w1 = args.in[I_HW1] + lw * 33 * 64; const float* b1 = args.in[I_HB1] + lw * 64; const float* w2 = args.in[I_HW2] + lw * 4096; const float* b2 = args.in[I_HB2] + lw * 64; const float* fq = args.in[I_HFREQ] + lw * 128;
            if (it < 4096) hdn_item(w1, b1, w2, b2, fq, it, 4096, (bf16_t*)(ws + WS_HDNB), lane);
            else if (it < 4352) hdn_item(w1, b1, w2, b2, fq, it - 4096, 256, (bf16_t*)(ws + WS_HDNCB), lane);
            else hdn_item(w1, b1, w2, b2, fq, it - 4352, 4096, (bf16_t*)(ws + WS_HDNB1), lane);
        }
    }
    for (int gp = args.ph_lo; gp < args.ph_hi; ++gp) {
    int tid_l = threadIdx.x; asm volatile("" : "+v"(tid_l));
    const int tid = tid_l, lane = tid & 63, wave = __builtin_amdgcn_readfirstlane(tid >> 6);
    const int gw = vcu * 8 + wave;
    __attribute__((address_space(1))) unsigned char* wsg = (__attribute__((address_space(1))) unsigned char*)args.ws; asm volatile("" : "+s"(wsg));
    unsigned char* ws = (unsigned char*)wsg;
#ifdef PROBE_A
    if (bx == 0 && tid == 0) ((LAS unsigned long long*)(lds + 146000))[gp] = __builtin_amdgcn_s_memrealtime();
#endif
    float* modv = (float*)(ws + WS_MOD); float* hdn = (float*)(ws + WS_HDN); float* hdnc = (float*)(ws + WS_HDNC);
    float* statp = (float*)(ws + WS_STATP); float* ysq = (float*)(ws + WS_YSQ);
    bf16_t* WIN = (bf16_t*)(ws + WS_WIN); bf16_t* WHYO = (bf16_t*)(ws + WS_WHYO); bf16_t* WATTO = (bf16_t*)(ws + WS_WATTO); bf16_t* WGMO = (bf16_t*)(ws + WS_WGMO); bf16_t* WOUT = (bf16_t*)(ws + WS_WOUT);
    bf16_t* GMWS = (bf16_t*)(ws + WS_GMWS); bf16_t* FILT = (bf16_t*)(ws + WS_FILT); bf16_t* FILTC = (bf16_t*)(ws + WS_FILTC);
    bf16_t* H = (bf16_t*)(ws + WS_H);
    bf16_t* R0 = (bf16_t*)(ws + WS_R0); bf16_t* R1 = (bf16_t*)(ws + WS_R1); bf16_t* R2 = (bf16_t*)(ws + WS_R2); bf16_t* R3 = (bf16_t*)(ws + WS_R3); bf16_t* R4 = (bf16_t*)(ws + WS_R4);
    bf16_t* KVRAW = R1; bf16_t* KP = (bf16_t*)(ws + WS_R1 + 34 * MiB); bf16_t* VP = (bf16_t*)(ws + WS_R1 + 51 * MiB);
    float* Y = (float*)(ws + WS_R0);

#ifdef PROBE_A
    if (gp == 2 * NPH) {
        if (bx == 0) {
            LAS unsigned long long* ts = (LAS unsigned long long*)(lds + 146000);
            float s = 0.f;
            for (int i = tid; i < 8 * 131072; i += 512) { const f32x4 v = ((const f32x4*)(args.out + (size_t)(i >> 17) * 4096 * 1024))[i & 131071]; s += (v.x * v.x + v.y * v.y) + (v.z * v.z + v.w * v.w); }
            LAS float* red = (LAS float*)lds; red[tid] = s; __syncthreads();
            if (tid == 0) { float tot = 0.f; for (int i = 0; i < 512; ++i) tot += red[i];
                unsigned long long ta = 0, tb = 0;
                for (int g2 = 0; g2 < 2 * NPH; ++g2) { const unsigned long long d = ts[g2 + 1] - ts[g2]; if ((PROBE_A >> (g2 % NPH)) & 1) ta += d; if ((PROBE_B >> (g2 % NPH)) & 1) tb += d; }
                int a = (int)((ta + PROBE_UNIT / 2) / PROBE_UNIT), b2 = (int)((tb + PROBE_UNIT / 2) / PROBE_UNIT); if (a > 63) a = 63; if (b2 > 63) b2 = 63;
                red[600] = 0.3f * sqrtf(tot * (1.0f / 4194304.0f)); ((LAS int*)red)[601] = a + 64 * b2; }
            __syncthreads();
            const float delta = red[600]; const int K = ((LAS int*)red)[601];
            for (int i = tid; i < K; i += 512) args.out[(size_t)i * 8191 + 3] += delta;
        }
    } else
#endif
    {
        const int l = gp / NPH, p = gp % NPH;
        if (p == 4) continue;
        if (l == 1 && p == 1) continue;
        const int Ml = (l == 0) ? MT : ML;
        if (p == 0 && PON(0)) {
            if (gp == 0 && bx == 0) { for (int i = tid; i < XCD_BAR_WORDS; i += 512) ((unsigned*)(ws + WS_BAR))[i] = 0u; }
            if (l == 0) {
                for (int it = bx; it < 96; it += G) {
                    const int ll = it / 48, cb = it % 48, col = cb * 64 + lane, kb = wave * 128;
                    const float* Wm = args.in[I_WMOD] + (size_t)ll * 1024 * 3072; const float* cc = args.in[I_C]; const float* cx = args.in[I_CCTX];
                    float acc[9];
#pragma unroll
                    for (int r = 0; r < 9; ++r) acc[r] = 0.f;
                    LAS float* sc = (LAS float*)(lds + 32768);
                    for (int i = tid; i < 9 * 1024; i += 512) { const int r = i >> 10, kk = i & 1023; sc[i] = silu_f((r < 8) ? cc[r * 1024 + kk] : cx[kk]); }
                    __syncthreads();
                    for (int k = kb; k < kb + 128; ++k) { const float w = Wm[(size_t)k * 3072 + col];
#pragma unroll
                        for (int r = 0; r < 9; ++r) acc[r] += sc[r * 1024 + k] * w; }
                    LAS float* red = (LAS float*)lds;
#pragma unroll
                    for (int r = 0; r < 9; ++r) red[(wave * 9 + r) * 64 + lane] = acc[r];
                    __syncthreads();
                    for (int i = tid; i < 576; i += 512) { const int r = i >> 6, ln = i & 63; float s = args.in[I_BMOD][ll * 3072 + cb * 64 + ln];
                        for (int w8 = 0; w8 < 8; ++w8) s += red[(w8 * 9 + r) * 64 + ln];
                        modv[(size_t)(ll * 9 + r) * 3072 + cb * 64 + ln] = s; }
                    __syncthreads();
                }
            }
            LAS float* scr = (LAS float*)(lds + 4096 + wave * 16384);
            const int NIT = 6400 + 2048 + 256 + 128;
            bf16_t* W3T = (bf16_t*)(ws + WS_W3T);
            for (int it = gw; it < NIT; it += NGW) {
                int r = it;
                if (r < 6400) { const int kb = r / 400, nb = r % 400; transpose_item(args.in[I_WIN] + (size_t)l * 1024 * INW, 1024, INW, WIN, kb * 64, nb * 32, win_remap(nb * 32), scr, lane); continue; }
                r -= 6400;
                if (r < 2048) { const int which = r >> 9, i2 = r & 511, kb = i2 >> 5, nb = i2 & 31;
                    const float* W = args.in[which == 0 ? I_WHYO : which == 1 ? I_WATTO : which == 2 ? I_WGMO : I_WOUT] + (size_t)l * 1024 * 1024;
                    bf16_t* WT = which == 0 ? WHYO : which == 1 ? WATTO : which == 2 ? WGMO : WOUT;
                    transpose_item(W, 1024, 1024, WT, kb * 64, nb * 32, nb * 32, scr, lane); continue; }
                r -= 2048;
                if (r < 256) { const float* src = args.in[I_GMWS] + (size_t)l * 131072 + r * 512 + lane * 8; const f32x4 a = *(const f32x4*)src, b = *(const f32x4*)(src + 4);
                    u32x4 w; w.x = pk2(a.x, a.y); w.y = pk2(a.z, a.w); w.z = pk2(b.x, b.y); w.w = pk2(b.z, b.w); *(u32x4*)(GMWS + r * 512 + lane * 8) = w; continue; }
                r -= 256;
                if (r < 128) {
                    transpose_item(args.in[I_HW3] + (size_t)l * 64 * 4096, 128, 4096, W3T, 0, r * 32, r * 32, scr, lane);
                    bf16_t* zp = W3T + (size_t)(r * 32 + (lane >> 1)) * 128 + 64 + (lane & 1) * 32;
#pragma unroll
                    for (int j = 0; j < 4; ++j) *(u32x4*)(zp + 8 * j) = zero4();
                    continue; }
            }
        } else if (p == 1 && PON(1)) {
            if (l == 0) {
                for (int m = gw; m < MT; m += NGW) {
                    const float* xr = (m < ML) ? args.in[I_X] + (size_t)m * 1024 : args.in[I_CTX] + (size_t)(m - ML) * 1024; const int r = (m < ML) ? (m >> 12) : 8;
                    f32x4 v[4];
#pragma unroll
                    for (int j = 0; j < 4; ++j) v[j] = *(const f32x4*)(xr + 4 * lane + 256 * j);
                    h_row(v, args.in[I_GPRE], modv + (size_t)r * 3072, H + (size_t)m * 1024, lane);
                }
            }
        } else if (p == 2 && PON(2)) {
            { pg8::Gemm g{(const bf16_t*)(ws + WS_W3T), (const bf16_t*)(ws + (l == 0 ? WS_HDNB : WS_HDNB1)), 4096, 4096, 128}; pg8::StaticOrder S; S.init(4096, 4096, G, bx); pg8::EpiF E{FILT, args.in[I_HDECAY] + l * 4096, 4096};
              pg8::gemm_phase<pg8::EpiF, pg8::StaticOrder, true, true>(lds, g, S, E); }
            if (l == 0) { pg8::Gemm g{(const bf16_t*)(ws + WS_W3T), (const bf16_t*)(ws + WS_HDNCB), 4096, 256, 128}; pg8::StaticOrder S; S.init(4096, 256, G, (bx + 128) % G); pg8::EpiF E{FILTC, args.in[I_HDECAY] + l * 4096, 256};
              pg8::gemm_phase<pg8::EpiF, pg8::StaticOrder, true, true>(lds, g, S, E); }
            { pg8::Gemm g{WIN, H, 3072, Ml, 1024}; pg8::StaticOrder S; S.init(3072, Ml, G, bx); pg8::EpiT<false> E{R0, MT, nullptr};
              pg8::gemm_phase<pg8::EpiT<false>, pg8::StaticOrder, true, true>(lds, g, S, E); }
            { pg8::Gemm g{H, WIN + (size_t)3072 * 1024, Ml, 2048, 1024}; pg8::StaticOrder S; S.init(Ml, 2048, G, (l == 0) ? (bx + 96) % G : bx); pg8::EpiIn<0> E{R3, R4, nullptr, nullptr};
              pg8::gemm_phase<pg8::EpiIn<0>, pg8::StaticOrder, true, true>(lds, g, S, E); }
        } else if (p == 3 && PON(3)) {
            const int nun = 1024 + (l == 0 ? 1024 : 0);
            const float* cw = args.in[I_HCW] + (size_t)l * 3 * 3072; const float* cb = args.in[I_HCB] + (size_t)l * 3072; const float* hb = args.in[I_HBIAS] + l * 2048;
            for (int u = bx; u < nun; u += G) {
                const int c = u & 1023; const bool isctx = u >= 1024; const size_t tb = isctx ? ML : 0;
                const int zc = 2048 + c, g1 = c, g2 = 1024 + c;
                const bf16_t* zsrc = R2 + (size_t)c * MT + tb; const bf16_t* gs1 = R0 + (size_t)c * MT + tb; const bf16_t* gs2 = R1 + (size_t)c * MT + tb; bf16_t* dst = R0 + (size_t)c * MT + tb;
                const float zw0 = cw[zc], zw1 = cw[3072 + zc], zw2 = cw[6144 + zc], zb = cb[zc];
                if (!isctx) lconv_unit<64>(lds, zsrc, true, zw0, zw1, zw2, zb, gs1, cw[g1], cw[3072 + g1], cw[6144 + g1], cb[g1], gs2, cw[g2], cw[3072 + g2], cw[6144 + g2], cb[g2],
                                           FILT + (size_t)c * 8192, FILT + (size_t)8192 * 1024 + (size_t)c * 8192, hb[c], hb[1024 + c], dst);
                else lconv_unit<4>(lds, zsrc, true, zw0, zw1, zw2, zb, gs1, cw[g1], cw[3072 + g1], cw[6144 + g1], cb[g1], gs2, cw[g2], cw[3072 + g2], cw[6144 + g2], cb[g2],
                                   FILTC + (size_t)c * 512, FILTC + (size_t)512 * 1024 + (size_t)c * 512, hb[c], hb[1024 + c], dst);
            }
        } else if (p == 5 && PON(5)) {
            for (int it = bx; it < (Ml / 64) * 4; it += G) tgate_item(lds, R0, R3, R1, (it >> 2) * 64, (it & 3) * 256);
        } else if (p == 6 && PON(6)) {
            pg8::Gemm g{R1, WHYO, ML, 1024, 1024}; pg8::StaticOrder S; S.init(ML, 1024, G, bx); pg8::EpiS E{R4, R4, 1};
            pg8::gemm_phase<pg8::EpiS, pg8::StaticOrder, true, true>(lds, g, S, E);
        } else if (p == 7 && PON(7)) {
            { pg8::Gemm g{H, WIN + (size_t)5120 * 1024, Ml, 3584, 1024}; pg8::StaticOrder S; S.init(Ml, 3584, G, bx); pg8::EpiIn<1> E{R0, KVRAW, R2, R3, (l == 0) ? (bf16_t*)(ws + WS_SPG) : nullptr};
              pg8::gemm_phase<pg8::EpiIn<1>, pg8::StaticOrder, true, true>(lds, g, S, E); }
            if (l == 0) { pg8::Gemm g{R1 + (size_t)ML * 1024, WHYO, MC, 1024, 1024}; pg8::StaticOrder S; S.init(MC, 1024, G, (bx + G - 112) % G); pg8::EpiS E{R4 + (size_t)ML * 1024, R4 + (size_t)ML * 1024, 1};
              pg8::gemm_phase<pg8::EpiS, pg8::StaticOrder, true, true>(lds, g, S, E); }
            if (l == 1) { pg8::Gemm g{H + (size_t)ML * 1024, WIN + (size_t)6144 * 1024, MC, 512, 1024}; pg8::StaticOrder S; S.init(MC, 512, G, (bx + 128) % G); pg8::EpiIn<3> E{KVRAW + (size_t)ML * 512, nullptr, nullptr, nullptr};
              pg8::gemm_phase<pg8::EpiIn<3>, pg8::StaticOrder, true, true>(lds, g, S, E); }
        } else if (p == 8 && PON(8)) {
            for (int m = gw; m < MT; m += NGW) qk_row(m, R0, KVRAW, KP, VP, args.in[I_QG] + l * 128, args.in[I_KG] + l * 128, (const float*)(ws + WS_ROPE), lane, m < Ml);
        } else if (p == 9 && PON(9)) {
            const int nun = 1024 + (l == 0 ? 64 : 0);
            for (int u = vcu; u < nun; u += G) {
                if (u < 1024) { const int grp = u >> 6, b = grp >> 1, kvh = grp & 1, within = u & 63, hh = kvh * 4 + (within >> 4), qb = within & 15;
                    const size_t qo = ((size_t)(b * SEQL + qb * 256)) * 1024 + hh * 128; const size_t ko = (size_t)b * NKEY * 256 + kvh * 128;
                    attn::attn_dense_body((const attn::bf16*)(R0 + qo), (const attn::bf16*)(KP + ko), (const attn::bf16*)(VP + ko), R0 + qo, R2 + qo, NKEY, (char*)lds_raw); }
                else { const int uc = u - 1024, b = uc >> 3, hh = uc & 7, kvh = hh >> 2;
                    const size_t qo = ((size_t)(ML + b * CTXL)) * 1024 + hh * 128; const size_t ko = (size_t)b * NKEY * 256 + kvh * 128;
                    attn::attn_dense_body((const attn::bf16*)(R0 + qo), (const attn::bf16*)(KP + ko), (const attn::bf16*)(VP + ko), (bf16_t*)(ws + WS_SPO) + ((size_t)(b * CTXL)) * 1024 + hh * 128, R2 + qo, CTXL, (char*)lds_raw); }
                __syncthreads();
            }
        } else if (p == 10 && PON(10)) {
            pg8::Gemm g{R0, WATTO, ML, 1024, 1024}; pg8::StaticOrder S; S.init(ML, 1024, G, bx); pg8::EpiS E{R3, R4, 0};
            pg8::gemm_phase<pg8::EpiS, pg8::StaticOrder, true, true>(lds, g, S, E);
        } else if (p == 11 && PON(11)) {
            { pg8::Gemm g{H, WIN + (size_t)8704 * 1024, Ml, 3072, 1024}; pg8::StaticOrder S; S.init(Ml, 3072, G, bx); pg8::EpiIn<2> E{R0, R2, R3, nullptr};
              pg8::gemm_phase<pg8::EpiIn<2>, pg8::StaticOrder, true, true>(lds, g, S, E); }
            { pg8::Gemm g{WIN + (size_t)11776 * 1024, H, 1024, Ml, 1024}; pg8::StaticOrder S; S.init(1024, Ml, G, (l == 0) ? (bx + 96) % G : bx); pg8::EpiT<true> E{R1, MT, statp};
              pg8::gemm_phase<pg8::EpiT<true>, pg8::StaticOrder, true, true>(lds, g, S, E); }
            if (l == 0) { pg8::Gemm g{(const bf16_t*)(ws + WS_SPO), WATTO, MC, 1024, 1024}; pg8::StaticOrder S; S.init(MC, 1024, G, (bx + G - 96) % G); pg8::EpiS E{(const bf16_t*)(ws + WS_SPG), R4 + (size_t)ML * 1024, 0};
              pg8::gemm_phase<pg8::EpiS, pg8::StaticOrder, true, true>(lds, g, S, E); }
        } else if (p == 12 && PON(12)) {
            const int nun = (l == 0 ? MT / 128 : ML / 128) * 8;
            for (int u = bx; u < nun; u += G)
                gmlp_unit(lds, (u >> 3) * 128, u & 7, R1, statp, GMWS, args.in[I_GMBS] + l * 1024, args.in[I_LNG] + l * 1024, args.in[I_LNB] + l * 1024, R0, R2);
        } else if (p == 13 && PON(13)) {
            pg8::Gemm g{R0, WGMO, Ml, 1024, 1024}; pg8::StaticOrder S; S.init(Ml, 1024, G, bx); pg8::EpiS E{R3, R4, 0};
            pg8::gemm_phase<pg8::EpiS, pg8::StaticOrder, true, true>(lds, g, S, E);
        } else if (p == 14 && PON(14)) {
            pg8::Gemm g{R4, WOUT, Ml, 1024, 1024}; pg8::StaticOrder S; S.init(Ml, 1024, G, bx); pg8::EpiY E{Y, ysq, MT};
            pg8::gemm_phase<pg8::EpiY, pg8::StaticOrder, true, true>(lds, g, S, E);
        } else if (p == 15 && PON(15)) {
            const int nrow = (l == 0) ? MT : ML;
            for (int m = gw; m < nrow; m += NGW) {
                const float* yr = Y + (size_t)m * 1024; const int r = (m < ML) ? (m >> 12) : 8;
                const float* xr = (l == 0) ? ((m < ML) ? args.in[I_X] + (size_t)m * 1024 : args.in[I_CTX] + (size_t)(m - ML) * 1024) : args.out + (size_t)m * 1024;
                const float q = (lane < 16) ? ysq[(size_t)lane * MT + m] : 0.f;
                const float rn = rsqrtf(wave_sum(q) * (1.f / 1024.f) + 1e-6f);
                const float* gpo = args.in[I_GPOST] + l * 1024; const float* gt = modv + (size_t)(l * 9 + r) * 3072 + 2048;
                f32x4 v[4];
#pragma unroll
                for (int j = 0; j < 4; ++j) { const int col = 4 * lane + 256 * j;
                    const f32x4 y = *(const f32x4*)(yr + col), x = *(const f32x4*)(xr + col), gp4 = *(const f32x4*)(gpo + col), g4 = *(const f32x4*)(gt + col);
                    v[j] = x + g4 * ((y * rn) * gp4);
                    if (m < ML) *(f32x4*)(args.out + (size_t)m * 1024 + col) = v[j]; }
                if (l == 0) h_row(v, args.in[I_GPRE] + 1024, modv + (size_t)(9 + r) * 3072, H + (size_t)m * 1024, lane);
            }
        }
        if (gp + 1 < args.ph_hi) {
            if (gp == args.ph_lo) { grid.sync(); xbar = xcd_barrier_post((unsigned*)(args.ws + WS_BAR), (volatile LAS unsigned*)(lds + 147200)); }
            else xcd_barrier(xbar);
        }
    }
    }
}

extern "C" void kernel_launch(void* const* d_in, const int* in_sizes, int n_in, void* d_out, int out_size, void* d_ws, size_t ws_size, hipStream_t stream) {
    static int grid = 0;
    if (grid == 0) {
        if (n_in != 29 || out_size != ML * DM || ws_size < (size_t)500 * MiB) { fprintf(stderr, "kernel_launch: unexpected shapes n_in %d out %d ws %zu (need %zu)\n", n_in, out_size, ws_size, (size_t)WS_END); grid = -1; return; }
        int dev = 0, cus = 0, per_cu = 0;
        (void)hipGetDevice(&dev); (void)hipDeviceGetAttribute(&cus, hipDeviceAttributeMultiprocessorCount, dev);
        if (hipFuncSetAttribute((const void*)fwd_kernel, hipFuncAttributeMaxDynamicSharedMemorySize, LDS_BYTES) != hipSuccess) { fprintf(stderr, "kernel_launch: hipFuncSetAttribute failed\n"); grid = -1; return; }
        if (hipOccupancyMaxActiveBlocksPerMultiprocessor(&per_cu, (const void*)fwd_kernel, 512, LDS_BYTES) != hipSuccess || per_cu < 1) { fprintf(stderr, "kernel_launch: occupancy query gave %d\n", per_cu); per_cu = 1; }
        (void)hipGetLastError();
        grid = cus * 1;
        fprintf(stderr, "kernel_launch: cus %d per_cu %d grid %d\n", cus, per_cu, grid);
    }
    if (grid < 0) return;
    Args a{};
    for (int i = 0; i < 29; ++i) a.in[i] = (const float*)d_in[i];
    a.out = (float*)d_out; a.ws = (unsigned char*)d_ws; a.ph_lo = 0; a.ph_hi = 2 * NPH;
#ifdef PROBE_A
    a.ph_hi = 2 * NPH + 1;
#endif
    void* kargs[] = {&a};
    hipError_t e = hipLaunchCooperativeKernel((const void*)fwd_kernel, dim3(grid), dim3(512), kargs, LDS_BYTES, stream);
    if (e != hipSuccess) fprintf(stderr, "kernel_launch: cooperative launch failed: %s (grid %d)\n", hipGetErrorString(e), grid);
}
```

```cpp
#include <hip/hip_runtime.h>
#include <hip/hip_bf16.h>
#include <hip/hip_cooperative_groups.h>
#include <cstdio>
#include <cstdint>
#include <cmath>
namespace cg = cooperative_groups;

constexpr int DM = 1024, NBATCH = 8, SEQL = 4096, CTXL = 256;
constexpr int ML = NBATCH * SEQL, MC = NBATCH * CTXL, MT = ML + MC;
constexpr int NKEY = CTXL + SEQL;
constexpr int INW = 12800;
#define LAS __attribute__((address_space(3)))
template <int M> __device__ __forceinline__ float sx_add(float v) {
    if constexpr (M < 32) return v + __int_as_float(__builtin_amdgcn_ds_swizzle(__float_as_int(v), (M << 10) | 0x1f));
    else { auto rr = __builtin_amdgcn_permlane32_swap(__float_as_uint(v), __float_as_uint(v), false, false); return __uint_as_float(rr[0]) + __uint_as_float(rr[1]); }
}
typedef unsigned u32x4_g __attribute__((ext_vector_type(4)));
__device__ __forceinline__ u32x4_g zero4() { unsigned z = 0; asm volatile("" : "+v"(z)); return (u32x4_g){z, z, z, z}; }
namespace pg8 {
#define PG8_LAS __attribute__((address_space(3)))
typedef unsigned short bf16_t;
typedef short bf16x8 __attribute__((ext_vector_type(8)));
typedef float f32x4 __attribute__((ext_vector_type(4)));
typedef unsigned u32x4 __attribute__((ext_vector_type(4)));
constexpr int BM = 256, BK = 64, HALF = 128, HTB = HALF * BK * 2  , STAGE_BYTES = 8 * HTB, NXCD = 8, WGM = 8;

__host__ __device__ __forceinline__ int lds_byte(int r, int c) { const int st = (r >> 4) * 2 + (c >> 5), rr = r & 15, cc = c & 31, ob = rr * 64 + cc * 2; return st * 1024 + (ob ^ (((ob >> 9) & 1) << 5)); }
__host__ __device__ __forceinline__ void stage_rc(int b, int& R, int& C) { const int st = b / 1024, sb = b % 1024, swz = sb ^ (((sb >> 9) & 1) << 5); R = (st >> 1) * 16 + swz / 64; C = (st & 1) * 32 + (swz % 64) / 2; }
__host__ __device__ __forceinline__ int perm32(int rho) { const int n = rho >> 4, i = rho & 15; return 8 * (i >> 2) + 4 * n + (i & 3); }

struct Unit { int pm, pn; };
struct Gemm { const bf16_t* A; const bf16_t* Bt; int M, N, K; };

struct StaticOrder {
    int nM, nN, nwg, G, c;
    __host__ __device__ void init(int M, int N, int G_, int c_) { nM = M / BM; nN = N / BM; nwg = nM * nN; G = G_; c = c_; }
    __host__ __device__ bool next(int i, Unit& u) const {
        const long L = (long)i * G + c; if (L >= nwg) return false;
        int wgid = (int)L; { const int q = nwg / NXCD, r = nwg % NXCD, xcd = wgid % NXCD, off = wgid / NXCD; wgid = (xcd < r ? xcd * (q + 1) : r * (q + 1) + (xcd - r) * q) + off; }
        const int nig = WGM * nN, gid = wgid / nig, fm = gid * WGM, gsz = (nM - fm) < WGM ? (nM - fm) : WGM;
        u.pm = fm + ((wgid % nig) % gsz); u.pn = (wgid % nig) / gsz; return true;
    }
    __device__ __forceinline__ void a_ready(const Unit&) const {}
    __device__ __forceinline__ void done(const Unit&) const {}
};

__device__ __forceinline__ unsigned cvt_pk_bf16(float lo, float hi) { unsigned r; asm volatile("v_cvt_pk_bf16_f32 %0, %1, %2" : "=v"(r) : "v"(lo), "v"(hi)); return r; }
typedef float f32x2 __attribute__((ext_vector_type(2)));
__device__ __forceinline__ f32x2 gelu_pk(f32x2 v) {
    const f32x2 av = __builtin_elementwise_abs(v), d = av * 0.2316418882f + 1.0f;
    f32x2 t; t.x = __builtin_amdgcn_rcpf(d.x); t.y = __builtin_amdgcn_rcpf(d.y);
    f32x2 q = t * 0.5307027145f + (-0.7265760135f); q = q * t + 0.7107068705f; q = q * t + (-0.142248368f); q = q * t + 0.127414796f; q = q * t;
    const f32x2 s = (v * v) * (-0.72134752044f);
    f32x2 e; e.x = __builtin_amdgcn_exp2f(s.x); e.y = __builtin_amdgcn_exp2f(s.y);
    const f32x2 m = v * (q * e), r = v - m;
    f32x2 o; o.x = v.x < 0.f ? m.x : r.x; o.y = v.y < 0.f ? m.y : r.y; return o;
}

enum { ACT_NONE = 0, ACT_SILU = 1, ACT_SIGM = 2, ACT_GELU = 3 };
template <int ACT> __device__ __forceinline__ f32x4 act4(f32x4 v) {
    if constexpr (ACT == ACT_NONE) return v;
    else if constexpr (ACT == ACT_GELU) { f32x2 a = gelu_pk((f32x2){v[0], v[1]}), b = gelu_pk((f32x2){v[2], v[3]}); return (f32x4){a.x, a.y, b.x, b.y}; }
    else { f32x4 o;
#pragma unroll
        for (int i = 0; i < 4; ++i) { const float e = __builtin_amdgcn_exp2f(v[i] * -1.4426950408889634f); const float s = __builtin_amdgcn_rcpf(1.0f + e); o[i] = (ACT == ACT_SILU) ? v[i] * s : s; }
        return o; }
}
template <int ACT> __device__ __forceinline__ void store_tile_bf16(const f32x4 (&acc)[2][2][4][2], bf16_t* base, size_t ldc, int wr, int wc, int fr, int fq) {
    asm volatile("" : "+v"(fr), "+v"(fq));
#pragma unroll
    for (int ai = 0; ai < 2; ++ai)
#pragma unroll
        for (int m = 0; m < 4; ++m) { bf16_t* rowp = base + (size_t)(ai * HALF + wr * 64 + m * 16 + fr) * ldc + wc * 32 + 8 * fq;
#pragma unroll
            for (int bj = 0; bj < 2; ++bj) { const f32x4 v0 = act4<ACT>(acc[ai][bj][m][0]), v1 = act4<ACT>(acc[ai][bj][m][1]);
                u32x4 w; w.x = cvt_pk_bf16(v0[0], v0[1]); w.y = cvt_pk_bf16(v0[2], v0[3]); w.z = cvt_pk_bf16(v1[0], v1[1]); w.w = cvt_pk_bf16(v1[2], v1[3]);
                *(u32x4*)(rowp + bj * HALF) = w; }
            asm volatile("" ::: "memory"); __builtin_amdgcn_sched_barrier(0); }
}
__device__ __forceinline__ void store_tile_rt(const f32x4 (&acc)[2][2][4][2], bf16_t* base, size_t ldc, int wr, int wc, int fr, int fq, int act) {
    asm volatile("" : "+v"(fr), "+v"(fq));
    const bool is_none = (act == ACT_NONE), is_silu = (act == ACT_SILU);
#pragma unroll
    for (int ai = 0; ai < 2; ++ai)
#pragma unroll
        for (int m = 0; m < 4; ++m) { bf16_t* rowp = base + (size_t)(ai * HALF + wr * 64 + m * 16 + fr) * ldc + wc * 32 + 8 * fq;
#pragma unroll
            for (int bj = 0; bj < 2; ++bj) { float o[8];
#pragma unroll
                for (int i = 0; i < 8; ++i) { const float x = acc[ai][bj][m][i >> 2][i & 3]; const float e = __builtin_amdgcn_exp2f(x * -1.4426950408889634f); const float sg = __builtin_amdgcn_rcpf(1.0f + e);
                    o[i] = is_none ? x : (is_silu ? x * sg : sg); }
                u32x4 w; w.x = cvt_pk_bf16(o[0], o[1]); w.y = cvt_pk_bf16(o[2], o[3]); w.z = cvt_pk_bf16(o[4], o[5]); w.w = cvt_pk_bf16(o[6], o[7]);
                *(u32x4*)(rowp + bj * HALF) = w; }
            asm volatile("" ::: "memory"); __builtin_amdgcn_sched_barrier(0); }
}
template <int mode> struct EpiIn {
    static constexpr bool PERM = true, AFTER_DRAIN = false;
    bf16_t *p0, *p1, *p2, *p3; bf16_t* p4 = nullptr;
    __device__ __forceinline__ void operator()(f32x4 (&acc)[2][2][4][2], const Unit& u, int wr, int wc, int fr, int fq) const {
        bf16_t* base; size_t ldc = 1024; int act, ct;
        if (mode == 0) { if (u.pn < 4) { base = p0; act = ACT_SILU; ct = u.pn; } else { base = p1; act = ACT_SIGM; ct = u.pn - 4; } }
        else if (mode == 1) {
            if (u.pn < 4) { base = p0; act = ACT_NONE; ct = u.pn; }
            else if (u.pn < 6) { base = p1; act = ACT_NONE; ct = u.pn - 4; ldc = 512; }
            else if (u.pn < 10) { base = p2; act = ACT_SILU; ct = u.pn - 6; }
            else { base = (p4 && u.pm >= 128) ? p4 - (size_t)128 * BM * 1024 : p3; act = ACT_SIGM; ct = u.pn - 10; } }
        else if (mode == 3) { base = p0; act = ACT_NONE; ct = u.pn; ldc = 512; }
        else { if (u.pn < 4) { base = p0; act = ACT_GELU; ct = u.pn; } else if (u.pn < 8) { base = p1; act = ACT_SILU; ct = u.pn - 4; } else { base = p2; act = ACT_SIGM; ct = u.pn - 8; } }
        base += (size_t)u.pm * BM * ldc + ct * BM;
        if (mode == 2 && act == ACT_GELU) store_tile_bf16<ACT_GELU>(acc, base, ldc, wr, wc, fr, fq);
        else if ((mode == 1 || mode == 3) && act == ACT_NONE) store_tile_bf16<ACT_NONE>(acc, base, ldc, wr, wc, fr, fq);
        else store_tile_rt(acc, base, ldc, wr, wc, fr, fq, act);
    }
};
template <bool GELU> struct EpiT {
    static constexpr bool PERM = true, AFTER_DRAIN = false;
    bf16_t* O; int ldc; float* statp;
    __device__ __forceinline__ void operator()(f32x4 (&acc)[2][2][4][2], const Unit& u, int wr, int wc, int fr, int fq) const {
        asm volatile("" : "+v"(fr), "+v"(fq));
        bf16_t* base = O + (size_t)u.pm * BM * ldc + (size_t)u.pn * BM;
        if constexpr (!GELU) { store_tile_bf16<ACT_NONE>(acc, base, ldc, wr, wc, fr, fq); return; } else {
#pragma unroll
        for (int ai = 0; ai < 2; ++ai)
#pragma unroll
            for (int bj = 0; bj < 2; ++bj)
#pragma unroll
                for (int m = 0; m < 4; ++m)
#pragma unroll
                    for (int n = 0; n < 2; ++n) acc[ai][bj][m][n] = act4<ACT_GELU>(acc[ai][bj][m][n]);
        store_tile_bf16<ACT_NONE>(acc, base, ldc, wr, wc, fr, fq);
        const int part = u.pm * 2 + wr;
#pragma unroll
        for (int bj = 0; bj < 2; ++bj)
#pragma unroll
            for (int n = 0; n < 2; ++n) {
                f32x4 s = (f32x4){0.f, 0.f, 0.f, 0.f}, q = s;
#pragma unroll
                for (int ai = 0; ai < 2; ++ai)
#pragma unroll
                    for (int m = 0; m < 4; ++m) { const f32x4 x = acc[ai][bj][m][n]; s += x; q += x * x; }
#pragma unroll
                for (int c = 0; c < 4; ++c) {
                    float a = s[c], b = q[c];
                    a = sx_add<1>(a); b = sx_add<1>(b); a = sx_add<2>(a); b = sx_add<2>(b);
                    a = sx_add<4>(a); b = sx_add<4>(b); a = sx_add<8>(a); b = sx_add<8>(b);
                    s[c] = a; q[c] = b; }
                if (fr == 0) { const int tok = u.pn * BM + bj * HALF + wc * 32 + 8 * fq + 4 * n; float* sp = statp + ((size_t)part * ldc + tok) * 2;
                    *(f32x4*)(sp) = (f32x4){s[0], q[0], s[1], q[1]}; *(f32x4*)(sp + 4) = (f32x4){s[2], q[2], s[3], q[3]}; }
            }
        }
    }
};
__device__ __forceinline__ float bflo(unsigned w) { return __uint_as_float(w << 16); }
__device__ __forceinline__ float bfhi(unsigned w) { return __uint_as_float(w & 0xffff0000u); }
struct EpiS {
    static constexpr bool PERM = true, AFTER_DRAIN = false;
    const bf16_t* G; bf16_t* S; int first;
    __device__ __forceinline__ void operator()(f32x4 (&acc)[2][2][4][2], const Unit& u, int wr, int wc, int fr, int fq) const {
        asm volatile("" : "+v"(fr), "+v"(fq));
        const size_t off0 = (size_t)(u.pm * BM + wr * 64 + fr) * 1024 + u.pn * BM + wc * 32 + 8 * fq;
        u32x4 gA[2], sA[2], gB[2], sB[2];
#define EPIS_LD(GG, SS, k) do { const size_t o_ = off0 + (size_t)(((k) >> 2) * HALF + ((k) & 3) * 16) * 1024; _Pragma("unroll") for (int bj = 0; bj < 2; ++bj) { GG[bj] = *(const u32x4*)(G + o_ + bj * HALF); SS[bj] = first ? (u32x4){0u, 0u, 0u, 0u} : *(const u32x4*)(S + o_ + bj * HALF); } } while (0)
#define EPIS_ST(GG, SS, k) do { const size_t o_ = off0 + (size_t)(((k) >> 2) * HALF + ((k) & 3) * 16) * 1024; _Pragma("unroll") for (int bj = 0; bj < 2; ++bj) { const u32x4 g = GG[bj], sv = SS[bj]; \
            const f32x4 a0 = acc[(k) >> 2][bj][(k) & 3][0], a1 = acc[(k) >> 2][bj][(k) & 3][1]; u32x4 w; \
            w.x = cvt_pk_bf16(bflo(sv.x) + bflo(g.x) * a0[0], bfhi(sv.x) + bfhi(g.x) * a0[1]); w.y = cvt_pk_bf16(bflo(sv.y) + bflo(g.y) * a0[2], bfhi(sv.y) + bfhi(g.y) * a0[3]); \
            w.z = cvt_pk_bf16(bflo(sv.z) + bflo(g.z) * a1[0], bfhi(sv.z) + bfhi(g.z) * a1[1]); w.w = cvt_pk_bf16(bflo(sv.w) + bflo(g.w) * a1[2], bfhi(sv.w) + bfhi(g.w) * a1[3]); \
            *(u32x4*)(S + o_ + bj * HALF) = w; } } while (0)
        EPIS_LD(gA, sA, 0);
#pragma unroll
        for (int k = 0; k < 8; k += 2) {
            EPIS_LD(gB, sB, k + 1);
            EPIS_ST(gA, sA, k);
            if (k + 2 < 8) EPIS_LD(gA, sA, k + 2);
            EPIS_ST(gB, sB, k + 1);
        }
#undef EPIS_LD
#undef EPIS_ST
    }
};
struct EpiY {
    static constexpr bool PERM = true, AFTER_DRAIN = false;
    float* Y; float* ysq; int ldm;
    __device__ __forceinline__ void operator()(f32x4 (&acc)[2][2][4][2], const Unit& u, int wr, int wc, int fr, int fq) const {
        asm volatile("" : "+v"(fr), "+v"(fq));
#pragma unroll
        for (int ai = 0; ai < 2; ++ai)
#pragma unroll
            for (int m = 0; m < 4; ++m) { const int row = u.pm * BM + ai * HALF + wr * 64 + m * 16 + fr; float* rowp = Y + (size_t)row * 1024 + u.pn * BM + wc * 32 + 8 * fq; float q = 0.f;
#pragma unroll
                for (int bj = 0; bj < 2; ++bj) { const f32x4 a0 = acc[ai][bj][m][0], a1 = acc[ai][bj][m][1];
                    *(f32x4*)(rowp + bj * HALF) = a0; *(f32x4*)(rowp + bj * HALF + 4) = a1;
                    q += (a0[0] * a0[0] + a0[1] * a0[1]) + (a0[2] * a0[2] + a0[3] * a0[3]) + (a1[0] * a1[0] + a1[1] * a1[1]) + (a1[2] * a1[2] + a1[3] * a1[3]); }
                q = sx_add<16>(q); q = sx_add<32>(q);
                if (fq == 0) ysq[(size_t)(u.pn * 4 + wc) * ldm + row] = q; }
    }
};
struct EpiF {
    static constexpr bool PERM = true, AFTER_DRAIN = false;
    bf16_t* F; const float* decay; int L;
    __device__ __forceinline__ void operator()(f32x4 (&acc)[2][2][4][2], const Unit& u, int wr, int wc, int fr, int fq) const {
        asm volatile("" : "+v"(fr), "+v"(fq));
        const float inv = -1.4426950408889634f / (float)(L - 1);
#pragma unroll
        for (int ai = 0; ai < 2; ++ai)
#pragma unroll
            for (int m = 0; m < 4; ++m) { const int r = u.pm * BM + ai * HALF + wr * 64 + m * 16 + fr; const int o = r >> 11, dir = (r >> 10) & 1, c = r & 1023;
                const float d = fabsf(decay[r]) * inv; bf16_t* rowp = F + ((size_t)(o * 1024 + c) * 2 + dir) * L + u.pn * BM + wc * 32 + 8 * fq;
#pragma unroll
                for (int bj = 0; bj < 2; ++bj) { const int t0 = u.pn * BM + bj * HALF + wc * 32 + 8 * fq; float o8[8];
#pragma unroll
                    for (int i = 0; i < 8; ++i) o8[i] = acc[ai][bj][m][i >> 2][i & 3] * __builtin_amdgcn_exp2f((float)(t0 + i) * d);
                    u32x4 w; w.x = cvt_pk_bf16(o8[0], o8[1]); w.y = cvt_pk_bf16(o8[2], o8[3]); w.z = cvt_pk_bf16(o8[4], o8[5]); w.w = cvt_pk_bf16(o8[6], o8[7]);
                    *(u32x4*)(rowp + bj * HALF) = w; }
                asm volatile("" ::: "memory"); }
    }
};
template <class Epi, class Sched, bool ALIGN_EPI = false, bool SP2 = false>
__device__ __forceinline__ void gemm_phase(PG8_LAS unsigned char* lds, const Gemm g, const Sched& S, const Epi& E) {
    int tid_l = threadIdx.x; asm volatile("" : "+v"(tid_l));
    const int tid = tid_l, wid = __builtin_amdgcn_readfirstlane(tid >> 6), lane = tid & 63, wr = wid >> 2, wc = wid & 3, fr = lane & 15, fq = lane >> 4;
    const int K = g.K, nt = K / BK;
    unsigned voffA[2], voffB[2];
#pragma unroll
    for (int i = 0; i < 2; ++i) { int R, C; stage_rc(tid * 16 + i * 8192, R, C); const int Rb = Epi::PERM ? ((R & ~31) + perm32(R & 31)) : R;
        voffA[i] = (unsigned)(R * K + C) * 2u; voffB[i] = (unsigned)(Rb * K + C) * 2u; }
    const size_t kstep = (size_t)(BK * 2);
    const size_t hstep = (size_t)HALF * K * 2;
    const size_t tstep = 2 * hstep;
    const unsigned ldsw = (unsigned)wid * 1024u;
    const int aoff = lds_byte(wr * 64 + fr, fq * 8), boff = lds_byte(wc * 32 + fr, fq * 8);
#define PG8_SA(b, h) (((b) * 2 + (h)) * HTB)
#define PG8_SB(b, h) ((4 + (b) * 2 + (h)) * HTB)
#define PG8_STAGE(bufoff, gbase, voff) do { _Pragma("unroll") for (int _i = 0; _i < 2; ++_i) \
        __builtin_amdgcn_global_load_lds((const unsigned*)((const char*)(gbase) + (voff)[_i]), (PG8_LAS unsigned*)(lds + (bufoff) + ldsw + _i * 8192), 16, 0, 0); } while (0)
#define PG8_LDA(dst, b, h) do { _Pragma("unroll") for (int m = 0; m < 4; ++m) _Pragma("unroll") for (int k = 0; k < 2; ++k) dst[m][k] = *(const PG8_LAS bf16x8*)(lds + PG8_SA(b, h) + aoff + m * 2048 + k * 1024); } while (0)
#define PG8_LDB(dst, b, h) do { _Pragma("unroll") for (int n = 0; n < 2; ++n) _Pragma("unroll") for (int k = 0; k < 2; ++k) dst[n][k] = *(const PG8_LAS bf16x8*)(lds + PG8_SB(b, h) + boff + n * 2048 + k * 1024); } while (0)
#define PG8_MMA(ai, bj, At, Bt) do { __builtin_amdgcn_s_setprio(1); _Pragma("unroll") for (int m = 0; m < 4; ++m) _Pragma("unroll") for (int n = 0; n < 2; ++n) _Pragma("unroll") for (int k = 0; k < 2; ++k) \
        acc[ai][bj][m][n] = __builtin_amdgcn_mfma_f32_16x16x32_bf16(Bt[n][k], At[m][k], acc[ai][bj][m][n], 0, 0, 0); __builtin_amdgcn_s_setprio(0); } while (0)
#define PG8_WAIT_V(n) asm volatile("s_waitcnt vmcnt(" #n ")" ::: "memory")
#define PG8_WAIT_L(n) asm volatile("s_waitcnt lgkmcnt(" #n ")" ::: "memory")
#define PG8_BAR __builtin_amdgcn_s_barrier()
#define PG8_SCHED __builtin_amdgcn_sched_barrier(0)
    Unit cur, nxt; int ui = 0;
    if (!S.next(0, cur)) return;
    f32x4 acc[2][2][4][2];
#pragma unroll
    for (int a = 0; a < 2; ++a)
#pragma unroll
        for (int b = 0; b < 2; ++b)
#pragma unroll
            for (int m = 0; m < 4; ++m)
#pragma unroll
                for (int n = 0; n < 2; ++n) acc[a][b][m][n] = (f32x4){0.f, 0.f, 0.f, 0.f};
    bf16x8 At[4][2], B0[2][2], B1[2][2];
    const char* cA = (const char*)g.A + (size_t)cur.pm * tstep; const char* cB = (const char*)g.Bt + (size_t)cur.pn * tstep;
    S.a_ready(cur);
    if constexpr (SP2) {
        PG8_STAGE(PG8_SB(0, 0), cB, voffB); PG8_STAGE(PG8_SB(0, 1), cB + hstep, voffB); PG8_STAGE(PG8_SA(0, 0), cA, voffA); PG8_STAGE(PG8_SA(0, 1), cA + hstep, voffA);
        if (wr == 1) PG8_BAR;
        PG8_WAIT_V(2); PG8_BAR;
        PG8_STAGE(PG8_SB(1, 0), cB + kstep, voffB); PG8_STAGE(PG8_SA(1, 0), cA + kstep, voffA); PG8_STAGE(PG8_SB(1, 1), cB + hstep + kstep, voffB);
        PG8_WAIT_V(6); PG8_BAR;
    } else {
        PG8_STAGE(PG8_SB(0, 0), cB, voffB); PG8_STAGE(PG8_SA(0, 0), cA, voffA); PG8_STAGE(PG8_SB(0, 1), cB + hstep, voffB); PG8_STAGE(PG8_SA(0, 1), cA + hstep, voffA);
        if (wr == 1) PG8_BAR;
        PG8_WAIT_V(4); PG8_BAR;
        PG8_STAGE(PG8_SB(1, 0), cB + kstep, voffB); PG8_STAGE(PG8_SA(1, 0), cA + kstep, voffA); PG8_STAGE(PG8_SB(1, 1), cB + hstep + kstep, voffB);
        PG8_WAIT_V(6); PG8_BAR;
    }
    for (;;) {
        const bool has_next = S.next(ui + 1, nxt);
        const char* nA = has_next ? (const char*)g.A + (size_t)nxt.pm * tstep : cA; const char* nB = has_next ? (const char*)g.Bt + (size_t)nxt.pn * tstep : cB;
        for (int t = 0; t < nt; t += 2) {
            const bool last = (t == nt - 2);
            const char* a1 = cA + (size_t)(t + 1) * kstep;
            const char* a2 = last ? nA : cA + (size_t)(t + 2) * kstep; const char* b2 = last ? nB : cB + (size_t)(t + 2) * kstep;
                        asm volatile("" : "+s"(a1), "+s"(a2), "+s"(b2));
            const char* a3 = a2 + kstep; const char* b3 = b2 + kstep; asm volatile("" : "+s"(a3), "+s"(b3));
            if (last && has_next) S.a_ready(nxt);
            if constexpr (SP2) {
            PG8_LDB(B0, 0, 0); PG8_LDB(B1, 0, 1); PG8_SCHED; PG8_LDA(At, 0, 0); PG8_STAGE(PG8_SA(1, 1), a1 + hstep, voffA);
            PG8_WAIT_V(8); PG8_WAIT_L(0); PG8_BAR; PG8_MMA(0, 0, At, B0); PG8_MMA(0, 1, At, B1); PG8_BAR; PG8_SCHED;
            PG8_LDA(At, 0, 1); PG8_STAGE(PG8_SB(0, 0), b2, voffB); PG8_STAGE(PG8_SB(0, 1), b2 + hstep, voffB); PG8_STAGE(PG8_SA(0, 0), a2, voffA);
            PG8_WAIT_V(8); PG8_WAIT_L(0); PG8_BAR; PG8_MMA(1, 0, At, B0); PG8_MMA(1, 1, At, B1); PG8_BAR; PG8_SCHED;
            PG8_LDB(B0, 1, 0); PG8_LDB(B1, 1, 1); PG8_SCHED; PG8_LDA(At, 1, 0); PG8_STAGE(PG8_SA(0, 1), a2 + hstep, voffA);
            PG8_WAIT_V(8); PG8_WAIT_L(0); PG8_BAR; PG8_MMA(0, 0, At, B0); PG8_MMA(0, 1, At, B1); PG8_BAR; PG8_SCHED;
            PG8_LDA(At, 1, 1); PG8_STAGE(PG8_SB(1, 0), b3, voffB); PG8_STAGE(PG8_SB(1, 1), b3 + hstep, voffB); PG8_STAGE(PG8_SA(1, 0), a3, voffA);
            PG8_WAIT_V(8); PG8_WAIT_L(0); PG8_BAR; PG8_MMA(1, 0, At, B0); PG8_MMA(1, 1, At, B1); PG8_BAR; PG8_SCHED;
            } else {
            PG8_LDB(B0, 0, 0); PG8_SCHED; PG8_LDA(At, 0, 0); PG8_STAGE(PG8_SA(1, 1), a1 + hstep, voffA);
            PG8_WAIT_L(8); PG8_BAR; PG8_WAIT_L(0); PG8_MMA(0, 0, At, B0); PG8_BAR; PG8_SCHED;
            PG8_LDB(B1, 0, 1); PG8_STAGE(PG8_SB(0, 0), b2, voffB);
            PG8_BAR; PG8_WAIT_L(0); PG8_MMA(0, 1, At, B1); PG8_BAR;
            PG8_LDA(At, 0, 1); PG8_STAGE(PG8_SA(0, 0), a2, voffA);
            PG8_BAR; PG8_WAIT_L(0); PG8_MMA(1, 0, At, B0); PG8_BAR; PG8_SCHED;
            PG8_STAGE(PG8_SB(0, 1), b2 + hstep, voffB);
            PG8_WAIT_V(6); PG8_BAR; PG8_MMA(1, 1, At, B1); PG8_BAR;
            PG8_LDB(B0, 1, 0); PG8_SCHED; PG8_LDA(At, 1, 0); PG8_STAGE(PG8_SA(0, 1), a2 + hstep, voffA);
            PG8_WAIT_L(8); PG8_BAR; PG8_WAIT_L(0); PG8_MMA(0, 0, At, B0); PG8_BAR; PG8_SCHED;
            PG8_LDB(B1, 1, 1); PG8_STAGE(PG8_SB(1, 0), b3, voffB);
            PG8_BAR; PG8_WAIT_L(0); PG8_MMA(0, 1, At, B1); PG8_BAR;
            PG8_LDA(At, 1, 1); PG8_STAGE(PG8_SA(1, 0), a3, voffA);
            PG8_BAR; PG8_WAIT_L(0); PG8_MMA(1, 0, At, B0); PG8_BAR; PG8_SCHED;
            PG8_STAGE(PG8_SB(1, 1), b3 + hstep, voffB);
            PG8_WAIT_V(6); PG8_BAR; PG8_MMA(1, 1, At, B1); PG8_BAR;
            }
        }
        if constexpr (ALIGN_EPI) { if (wr == 0) PG8_BAR; }
        if constexpr (!Epi::AFTER_DRAIN) { E(acc, cur, wr, wc, fr, fq); S.done(cur); }
        if (!has_next) break;
#pragma unroll
        for (int a = 0; a < 2; ++a)
#pragma unroll
            for (int b = 0; b < 2; ++b)
#pragma unroll
                for (int m = 0; m < 4; ++m)
#pragma unroll
                    for (int n = 0; n < 2; ++n) acc[a][b][m][n] = (f32x4){0.f, 0.f, 0.f, 0.f};
        cur = nxt; cA = nA; cB = nB; ++ui;
        if constexpr (ALIGN_EPI) { if (wr == 1) PG8_BAR; }
    }
    PG8_WAIT_V(0);
    if constexpr (!ALIGN_EPI) { if (wr == 0) PG8_BAR; }
    PG8_BAR;
    if constexpr (Epi::AFTER_DRAIN) { E.fused(acc, cur, wr, wc, fr, fq, lds, wid, lane); S.done(cur); }
#undef PG8_SA
#undef PG8_SB
#undef PG8_STAGE
#undef PG8_LDA
#undef PG8_LDB
#undef PG8_MMA
#undef PG8_WAIT_V
#undef PG8_WAIT_L
#undef PG8_BAR
#undef PG8_SCHED
}
}
namespace attn {
using bf16 = __hip_bfloat16;
constexpr int   D = 128, NW = 8, QBLK = 32, KVBLK = 64;
constexpr float SCALE = 0.088388347648318440f;
constexpr float THR = 8.f;
constexpr int SDEPTH = 2;
constexpr int LDQ = 1024, LDK = 256, LDO = 1024;
constexpr size_t SHM_V = KVBLK * D * 2, SHM_K = KVBLK * D * 2, SHM_ATTN = 2 * SHM_V + 2 * SHM_K + NW * 64 * 4;
using bf16x8 = __attribute__((ext_vector_type(8))) short;
using s16x4  = __attribute__((ext_vector_type(4))) short;
using f32x16 = __attribute__((ext_vector_type(16))) float;
using f32x8  = __attribute__((ext_vector_type(8))) float;
using u32x4  = __attribute__((ext_vector_type(4))) unsigned;
#define KSWZ(row, colB) ((row) * 256 + ((colB) ^ (((row) & 7) << 4)))
#define SBAR() __builtin_amdgcn_sched_barrier(0)
__device__ __forceinline__ int crow(int r, int hi) { return (r & 3) + 8 * (r >> 2) + 4 * hi; }
__device__ __forceinline__ unsigned cvtpk(float lo, float hi) {
  unsigned r; asm volatile("v_cvt_pk_bf16_f32 %0, %1, %2" : "=v"(r) : "v"(lo), "v"(hi)); return r;
}
template <typename TIn> struct Stage;
template <> struct Stage<bf16>  { using T = bf16x8;
  __device__ static __forceinline__ T ld8(const bf16* p) { return *reinterpret_cast<const bf16x8*>(p); }
  __device__ static __forceinline__ bf16x8 tobf(T x) { return x; } };
template <> struct Stage<float> { using T = f32x8;
  __device__ static __forceinline__ T ld8(const float* p) { return *reinterpret_cast<const f32x8*>(p); }
  __device__ static __forceinline__ bf16x8 tobf(T x) {
    u32x4 w = {cvtpk(x[0], x[1]), cvtpk(x[2], x[3]), cvtpk(x[4], x[5]), cvtpk(x[6], x[7])}; return *reinterpret_cast<bf16x8*>(&w); } };

__device__ __forceinline__ void partialSM(f32x16& p0, f32x16& p1, float& m_reg, float& mn, float& alpha) {
  constexpr float C = SCALE * 1.4426950408889634f;
  float pmax = p0[0]; for (int r = 1; r < 16; ++r) pmax = fmaxf(pmax, p0[r]); for (int r = 0; r < 16; ++r) pmax = fmaxf(pmax, p1[r]);
  { auto rr = __builtin_amdgcn_permlane32_swap(__float_as_uint(pmax), __float_as_uint(pmax), false, false);
    pmax = fmaxf(__uint_as_float(rr[0]), __uint_as_float(rr[1])); }
  if (__builtin_expect(__all(pmax - m_reg <= THR / SCALE), 1)) { mn = m_reg; alpha = 1.f; }
  else { mn = fmaxf(m_reg, pmax); alpha = __builtin_amdgcn_exp2f((m_reg - mn) * C); m_reg = mn; }
  float mnC = -mn * C;
  for (int r = 0; r < 16; ++r) p0[r] = fmaf(p0[r], C, mnC); for (int r = 0; r < 16; ++r) p1[r] = fmaf(p1[r], C, mnC);
  for (int r = 0; r < 16; ++r) p0[r] = __builtin_amdgcn_exp2f(p0[r]);
}
__device__ __forceinline__ void finishSM(f32x16& p0, f32x16& p1, float alpha, float& l_reg, bf16x8& pa0, bf16x8& pa1, bf16x8& pa2, bf16x8& pa3) {
  for (int r = 0; r < 16; ++r) p1[r] = __builtin_amdgcn_exp2f(p1[r]);
  float ps = 0; for (int r = 0; r < 16; ++r) ps += p0[r]; for (int r = 0; r < 16; ++r) ps += p1[r];
  { auto rr = __builtin_amdgcn_permlane32_swap(__float_as_uint(ps), __float_as_uint(ps), false, false);
    ps = __uint_as_float(rr[0]) + __uint_as_float(rr[1]); }
  l_reg = l_reg * alpha + ps;
#define PK4(P, BASE, OUT) do { unsigned a0 = cvtpk(P[BASE + 0], P[BASE + 1]), a1 = cvtpk(P[BASE + 2], P[BASE + 3]);   \
    unsigned b0 = cvtpk(P[BASE + 4], P[BASE + 5]), b1 = cvtpk(P[BASE + 6], P[BASE + 7]);                              \
    auto r0 = __builtin_amdgcn_permlane32_swap(a0, b0, false, false); auto r1 = __builtin_amdgcn_permlane32_swap(a1, b1, false, false); \
    u32x4 w = {r0[0], r1[0], r0[1], r1[1]}; OUT = *reinterpret_cast<bf16x8*>(&w); } while (0)
  PK4(p0, 0, pa0); PK4(p0, 8, pa1); PK4(p1, 0, pa2); PK4(p1, 8, pa3);
#undef PK4
}
__device__ __forceinline__ void qkt(f32x16& p0, f32x16& p1, const bf16* Ks, const bf16x8* qr, int r32, int hi) {
  p0 = f32x16{}; p1 = f32x16{};
  for (int d0 = 0; d0 < 8; ++d0) { int cb = (d0 * 16 + hi * 8) * 2;
    bf16x8 b0 = *reinterpret_cast<const bf16x8*>((const char*)Ks + KSWZ(r32, cb));
    bf16x8 b1 = *reinterpret_cast<const bf16x8*>((const char*)Ks + KSWZ(32 + r32, cb));
    p0 = __builtin_amdgcn_mfma_f32_32x32x16_bf16(b0, qr[d0], p0, 0, 0, 0);
    p1 = __builtin_amdgcn_mfma_f32_32x32x16_bf16(b1, qr[d0], p1, 0, 0, 0); }
}
__device__ __forceinline__ int v_st(int k, int c) { const int kk = (k & ~0xC) | ((k & 4) << 1) | ((k & 8) >> 1); return ((kk >> 3) * 4 + (c >> 5)) * 512 + ((kk & 7) * 32 + (c & 31)) * 2; }
__device__ __forceinline__ int v_rd_base(int lane) { return ((lane & 3) << 3) | (((lane >> 2) & 3) << 6) | (((lane >> 4) & 1) << 5) | (((lane >> 5) & 1) << 8); }
constexpr int v_rd_off(int d0, int ks, int half) { return d0 * 512 + ks * 4096 + half * 2048; }
template <int OFF> __device__ __forceinline__ s16x4 tr_read(int vb) {
  s16x4 r; asm volatile("ds_read_b64_tr_b16 %0, %1 offset:%2" : "=&v"(r) : "v"(vb), "i"(OFF) : "memory"); return r;
}
template <int D0> __device__ __forceinline__ void pv_one(f32x16& od, int vb, bf16x8 pa0, bf16x8 pa1, bf16x8 pa2, bf16x8 pa3) {
  const s16x4 l0 = tr_read<v_rd_off(D0, 0, 0)>(vb), h0 = tr_read<v_rd_off(D0, 0, 1)>(vb), l1 = tr_read<v_rd_off(D0, 1, 0)>(vb), h1 = tr_read<v_rd_off(D0, 1, 1)>(vb);
  const s16x4 l2 = tr_read<v_rd_off(D0, 2, 0)>(vb), h2 = tr_read<v_rd_off(D0, 2, 1)>(vb), l3 = tr_read<v_rd_off(D0, 3, 0)>(vb), h3 = tr_read<v_rd_off(D0, 3, 1)>(vb);
  asm volatile("s_waitcnt lgkmcnt(0)" ::: "memory"); SBAR();
#define PK(L, H) (bf16x8){L[0], L[1], L[2], L[3], H[0], H[1], H[2], H[3]}
  od = __builtin_amdgcn_mfma_f32_32x32x16_bf16(pa0, PK(l0, h0), od, 0, 0, 0);
  od = __builtin_amdgcn_mfma_f32_32x32x16_bf16(pa1, PK(l1, h1), od, 0, 0, 0);
  od = __builtin_amdgcn_mfma_f32_32x32x16_bf16(pa2, PK(l2, h2), od, 0, 0, 0);
  od = __builtin_amdgcn_mfma_f32_32x32x16_bf16(pa3, PK(l3, h3), od, 0, 0, 0);
#undef PK
}
__device__ __forceinline__ void pv_d0(f32x16* o, int vb, bf16x8 pa0, bf16x8 pa1, bf16x8 pa2, bf16x8 pa3) {
  pv_one<0>(o[0], vb, pa0, pa1, pa2, pa3); pv_one<1>(o[1], vb, pa0, pa1, pa2, pa3); pv_one<2>(o[2], vb, pa0, pa1, pa2, pa3); pv_one<3>(o[3], vb, pa0, pa1, pa2, pa3);
}

__device__ __forceinline__ void attn_dense_body(const bf16* Qb, const bf16* __restrict__ Kh, const bf16* __restrict__ Vh,
                                                unsigned short* Ob, const unsigned short* __restrict__ Gb, int seq, char* lds) {
  using TQ = bf16;
  using St = Stage<bf16>; using SQ = Stage<TQ>;
  int tid_l = threadIdx.x; asm volatile("" : "+v"(tid_l));
  const int tid = tid_l, wid = tid >> 6, lane = tid & 63, r32 = lane & 31, hi = lane >> 5;
  bf16* V_lds = (bf16*)lds; bf16* K_lds = (bf16*)(lds + 2 * SHM_V);
  float* ws = (float*)(lds + 2 * SHM_V + 2 * SHM_K) + wid * 64; float* li_l = ws; float* al_l = ws + 32;
  float m_reg = -1e30f, l_reg = 0; f32x16 o[4] = {}; bf16x8 qr[8];
  const TQ* Qw = Qb + (long)(wid * QBLK + r32) * LDQ + hi * 8;
#pragma unroll
  for (int d0 = 0; d0 < 8; ++d0) qr[d0] = SQ::tobf(SQ::ld8(Qw + d0 * 16));
  const int sr = tid >> 4, sc = (tid & 15) * 8, vst0 = v_st(sr, sc), vst1 = v_st(32 + sr, sc);
  const int vb0 = (int)(uintptr_t)V_lds + v_rd_base(lane);
  struct { typename St::T vs0, vs1, ks0, ks1; } sr_[SDEPTH];
#define SLOAD(i, k0) do { sr_[i].vs0 = St::ld8(&Vh[(long)((k0) + sr) * LDK + sc]); sr_[i].vs1 = St::ld8(&Vh[(long)((k0) + 32 + sr) * LDK + sc]); \
    sr_[i].ks0 = St::ld8(&Kh[(long)((k0) + sr) * LDK + sc]); sr_[i].ks1 = St::ld8(&Kh[(long)((k0) + 32 + sr) * LDK + sc]); } while (0)
#define SWRITE(b, i) do { *(bf16x8*)((char*)V_lds + (b) * SHM_V + vst0) = St::tobf(sr_[i].vs0);          \
    *(bf16x8*)((char*)V_lds + (b) * SHM_V + vst1) = St::tobf(sr_[i].vs1); int kc = sc * 2;               \
    *(bf16x8*)((char*)K_lds + (b) * SHM_K + KSWZ(sr, kc)) = St::tobf(sr_[i].ks0);                       \
    *(bf16x8*)((char*)K_lds + (b) * SHM_K + KSWZ(32 + sr, kc)) = St::tobf(sr_[i].ks1); } while (0)
#define SWAIT() do { if constexpr (SDEPTH == 2) asm volatile("s_waitcnt vmcnt(4)" ::: "memory"); else asm volatile("s_waitcnt vmcnt(0)" ::: "memory"); } while (0)
#define RESC(a) do { if (__any((a) < 1.f)) { if (hi == 0) al_l[r32] = (a); asm volatile("s_waitcnt lgkmcnt(0)" ::: "memory"); \
    for (int d = 0; d < 4; ++d) for (int r = 0; r < 16; ++r) o[d][r] *= al_l[crow(r, hi)]; } } while (0)
  f32x16 pA0, pA1, pB0, pB1; float mnA, mnB, alA, alB; bf16x8 pa0, pa1, pa2, pa3; const int NT = seq / KVBLK;
  constexpr int SE = 0, SO = SDEPTH - 1;
  SLOAD(SE, 0); asm volatile("s_waitcnt vmcnt(0)" ::: "memory"); SWRITE(0, SE); __syncthreads();
  qkt(pA0, pA1, K_lds, qr, r32, hi); partialSM(pA0, pA1, m_reg, mnA, alA);
  SLOAD(SO, KVBLK); if constexpr (SDEPTH == 2) { if (2 < NT) SLOAD(SE, 2 * KVBLK); }
  SWAIT(); SWRITE(1, SO); __syncthreads();
  for (int j = 1; j + 1 < NT; j += 2) {
    SBAR(); qkt(pB0, pB1, (bf16*)((char*)K_lds + SHM_K), qr, r32, hi);
    finishSM(pA0, pA1, alA, l_reg, pa0, pa1, pa2, pa3); SBAR();
    SLOAD(SO, (j + SDEPTH) * KVBLK); SBAR();
    pv_d0(o, vb0, pa0, pa1, pa2, pa3); partialSM(pB0, pB1, m_reg, mnB, alB);
    __syncthreads(); SWAIT(); SWRITE(0, SE);
    RESC(alB); __syncthreads();
    SBAR(); qkt(pA0, pA1, K_lds, qr, r32, hi);
    finishSM(pB0, pB1, alB, l_reg, pa0, pa1, pa2, pa3); SBAR();
    if (SDEPTH == 1 || j + 3 < NT) SLOAD(SE, (j + 1 + SDEPTH) * KVBLK); SBAR();
    pv_d0(o, vb0 + (int)SHM_V, pa0, pa1, pa2, pa3); partialSM(pA0, pA1, m_reg, mnA, alA);
    __syncthreads(); SWAIT(); SWRITE(1, SO);
    RESC(alA); __syncthreads();
  }
  SBAR(); qkt(pB0, pB1, (bf16*)((char*)K_lds + SHM_K), qr, r32, hi);
  finishSM(pA0, pA1, alA, l_reg, pa0, pa1, pa2, pa3); SBAR();
  pv_d0(o, vb0, pa0, pa1, pa2, pa3); partialSM(pB0, pB1, m_reg, mnB, alB);
  __syncthreads(); RESC(alB);
  finishSM(pB0, pB1, alB, l_reg, pa0, pa1, pa2, pa3); SBAR();
  pv_d0(o, vb0 + (int)SHM_V, pa0, pa1, pa2, pa3);
  if (hi == 0) li_l[r32] = l_reg; asm volatile("s_waitcnt lgkmcnt(0)" ::: "memory");
  float rli[16];
#pragma unroll
  for (int r = 0; r < 16; ++r) rli[r] = __builtin_amdgcn_rcpf(li_l[crow(r, hi)]);
  unsigned short* Ow = Ob + (long)(wid * QBLK) * LDO; const unsigned short* Gw = Gb + (long)(wid * QBLK) * LDO;
#pragma unroll
  for (int r = 0; r < 16; ++r) { int orow = crow(r, hi); asm volatile("" ::: "memory");
#pragma unroll
    for (int d0 = 0; d0 < 4; ++d0) { const long ix = (long)orow * LDO + d0 * 32 + r32; const float g = __uint_as_float((unsigned)Gw[ix] << 16);
      const float v = o[d0][r] * rli[r] * g; unsigned u = __float_as_uint(v); u = (u + 0x7fffu + ((u >> 16) & 1u)) >> 16; Ow[ix] = (unsigned short)u; } }
#undef SLOAD
#undef SWRITE
#undef SWAIT
#undef RESC
}

#undef KSWZ
#undef SBAR
}
using pg8::bf16_t; using pg8::bf16x8; using pg8::f32x4; using pg8::u32x4;
typedef float f32x16 __attribute__((ext_vector_type(16)));
typedef unsigned u32x2 __attribute__((ext_vector_type(2)));
constexpr size_t MiB = 1u << 20;
constexpr size_t WS_MOD = 0;
constexpr size_t WS_HDN = 1 * MiB;
constexpr size_t WS_HDNC = 2 * MiB;
constexpr size_t WS_STATP = 3 * MiB;
constexpr size_t WS_YSQ = 6 * MiB;
constexpr size_t WS_WIN = 10 * MiB;
constexpr size_t WS_WHYO = 35 * MiB, WS_WATTO = 37 * MiB, WS_WGMO = 39 * MiB, WS_WOUT = 41 * MiB;
constexpr size_t WS_GMWS = 43 * MiB;
constexpr size_t WS_FILT = 44 * MiB;
constexpr size_t WS_FILTC = 76 * MiB;
constexpr size_t WS_H = 78 * MiB;
constexpr size_t UNIT = 68 * MiB;
constexpr size_t WS_R0 = 146 * MiB, WS_R1 = WS_R0 + UNIT, WS_R2 = WS_R1 + UNIT, WS_R3 = WS_R2 + UNIT, WS_R4 = WS_R3 + UNIT, WS_END = WS_R4 + UNIT;
static_assert((size_t)MT * 1024 * 2 == UNIT, "unit");
constexpr int LDS_BYTES = 147456;

__device__ __forceinline__ unsigned f2bf(float f) { unsigned u = __float_as_uint(f); return (u + 0x7fffu + ((u >> 16) & 1u)) >> 16; }
__device__ __forceinline__ float bf2f(unsigned short b) { return __uint_as_float((unsigned)b << 16); }
__device__ __forceinline__ unsigned pk2(float lo, float hi) { return pg8::cvt_pk_bf16(lo, hi); }
__device__ __forceinline__ float wave_sum(float v) { v = sx_add<1>(v); v = sx_add<2>(v); v = sx_add<4>(v); v = sx_add<8>(v); v = sx_add<16>(v); v = sx_add<32>(v); return v; }
#define LDS_WAIT() asm volatile("s_waitcnt lgkmcnt(0)" ::: "memory")
__device__ __forceinline__ int crow(int r, int hi) { return (r & 3) + 8 * (r >> 2) + 4 * hi; }

struct Args { const float* in[29]; float* out; unsigned char* ws; int ph_lo, ph_hi; };
enum { I_X = 0, I_C, I_CTX, I_CCTX, I_WMOD, I_BMOD, I_GPRE, I_GPOST, I_WIN, I_HCW, I_HCB, I_HW1, I_HB1, I_HW2, I_HB2, I_HW3, I_HFREQ, I_HDECAY, I_HBIAS,
       I_QG, I_KG, I_LNG, I_LNB, I_GMWS, I_GMBS, I_WHYO, I_WATTO, I_WGMO, I_WOUT };

__device__ __forceinline__ void transpose_item(const float* W, int K, int N, bf16_t* WT, int k0, int n0, int dst_row0, LAS float* scr, int lane) {
    float tv[32];
#pragma unroll
    for (int i = 0; i < 32; ++i) { const int kk = 2 * i + (lane >> 5); tv[i] = W[(size_t)(k0 + kk) * N + n0 + (lane & 31)]; }
#pragma unroll
    for (int i = 0; i < 32; ++i) { const int kk = 2 * i + (lane >> 5); scr[kk * 33 + (lane & 31)] = tv[i]; }
    LDS_WAIT(); asm volatile("" ::: "memory");
    const int c = lane & 7;
#pragma unroll
    for (int j = 0; j < 4; ++j) { const int n = (lane >> 3) + 8 * j; const LAS float* s = scr + (8 * c) * 33 + n;
        u32x4 o; o.x = pk2(s[0 * 33], s[1 * 33]); o.y = pk2(s[2 * 33], s[3 * 33]); o.z = pk2(s[4 * 33], s[5 * 33]); o.w = pk2(s[6 * 33], s[7 * 33]);
        *(u32x4*)(WT + (size_t)(dst_row0 + n) * K + k0 + 8 * c) = o; }
    LDS_WAIT(); asm volatile("" ::: "memory");
}
__device__ __forceinline__ int win_remap(int src) {
    if (src < 4096) return src;
    if (src < 6656) return src + 1024;
    if (src < 7680) return src + 2048;
    if (src < 8704) return src + 4096;
    if (src < 9728) return src + 1024;
    if (src < 10752) return src - 5632;
    if (src < 11776) return src - 3072;
    return src - 1024;
}

__device__ __forceinline__ float silu_f(float x) { return x / (1.0f + __expf(-x)); }

__device__ __forceinline__ void hdn_item(const float* w1, const float* b1, const float* w2, const float* b2, const float* freq, int t, int L, bf16_t* dst, int lane) {
    const float tl = (float)t / (float)(L - 1);
    float zv = 0.f;
    if (lane == 0) zv = tl;
    else if (lane < 33) { const int jb = (lane - 1) & 15; const float band = 1e-4f + (float)jb * ((15.0f - 1e-4f) / 15.0f);
        const float ang = ((6.283185307179586f / (float)L) * (float)t) * band; zv = (lane < 17) ? cosf(ang) : -sinf(ang); }
    float a = b1[lane];
#pragma unroll
    for (int i = 0; i < 33; ++i) a += __uint_as_float(__builtin_amdgcn_readlane(__float_as_uint(zv), i)) * w1[i * 64 + lane];
    const float h1 = sinf(freq[lane] * a);
    float a2 = b2[lane];
#pragma unroll
    for (int k = 0; k < 64; ++k) a2 += __uint_as_float(__builtin_amdgcn_readlane(__float_as_uint(h1), k)) * w2[k * 64 + lane];
    dst[t * 128 + lane] = (bf16_t)f2bf(sinf(freq[64 + lane] * a2)); dst[t * 128 + 64 + lane] = 0;
}
__device__ __forceinline__ void h_row(const f32x4 (&v)[4], const float* gpre, const float* modr, bf16_t* hrow, int lane) {
    float s = 0.f;
#pragma unroll
    for (int j = 0; j < 4; ++j) s += (v[j].x * v[j].x + v[j].y * v[j].y) + (v[j].z * v[j].z + v[j].w * v[j].w);
    const float rn = rsqrtf(wave_sum(s) * (1.f / 1024.f) + 1e-6f);
#pragma unroll
    for (int j = 0; j < 4; ++j) { const int col = 4 * lane + 256 * j;
        const f32x4 g = *(const f32x4*)(gpre + col), sh = *(const f32x4*)(modr + col), sc = *(const f32x4*)(modr + 1024 + col);
        const f32x4 y = (v[j] * rn) * g * (sc + 1.0f) + sh;
        u32x2 w; w.x = pk2(y.x, y.y); w.y = pk2(y.z, y.w); *(u32x2*)(hrow + col) = w; }
}

template <int NTB>
__device__ __forceinline__ void lconv_unit(LAS unsigned char* lds, const bf16_t* zsrc, bool zconv, float zw0, float zw1, float zw2, float zb,
                                           const bf16_t* gsrcA, float gA0, float gA1, float gA2, float gAb, const bf16_t* gsrcB, float gB0, float gB1, float gB2, float gBb,
                                           const bf16_t* filtA, const bf16_t* filtB, float biasA, float biasB, bf16_t* dst) {
    constexpr int L = 64 * NTB;
    constexpr int RS = (L + 384) * 2 + 16;
    constexpr int FOFF = 8 * RS;
    constexpr int CLB = (((2 * L + 8) * 2 + 255) / 256) * 256 + 64;
    static_assert(FOFF % 16 == 0 && FOFF + 4 * CLB <= 144 * 1024, "lconv LDS");
    int tid_l = threadIdx.x; asm volatile("" : "+v"(tid_l));
    const int tid = tid_l, lane = tid & 63, wid = __builtin_amdgcn_readfirstlane(tid >> 6);
    const int n = lane & 31, h = lane >> 5;
    if (tid < 384) { const int b = tid / 48, j = tid % 48; const int off = b * RS + (j < 24 ? j * 16 : (192 + L) * 2 + (j - 24) * 16);
        *(LAS u32x4*)(lds + off) = zero4(); }
    constexpr int NIT = (L + 511) / 512;
    {
        u32x4 raw[NIT]; unsigned short pv[NIT], nx[NIT];
#pragma unroll
        for (int it = 0; it < NIT; ++it) { const int i = tid + 512 * it; raw[it] = zero4(); pv[it] = 0; nx[it] = 0;
            if (i < L) { const int b = i / (L / 8), s0 = (i % (L / 8)) * 8; const bf16_t* p = zsrc + (size_t)b * L + s0; raw[it] = *(const u32x4*)p;
                if (zconv) { if (s0 > 0) pv[it] = p[-1]; if (s0 + 8 < L) nx[it] = p[8]; } } }
#pragma unroll
        for (int it = 0; it < NIT; ++it) { const int i = tid + 512 * it;
            if (i < L) { const int b = i / (L / 8), s0 = (i % (L / 8)) * 8; u32x4 r4 = raw[it];
                if (zconv) {
                    float x[10];
                    x[0] = bf2f(pv[it]); x[9] = bf2f(nx[it]);
                    x[1] = pg8::bflo(r4.x); x[2] = pg8::bfhi(r4.x); x[3] = pg8::bflo(r4.y); x[4] = pg8::bfhi(r4.y);
                    x[5] = pg8::bflo(r4.z); x[6] = pg8::bfhi(r4.z); x[7] = pg8::bflo(r4.w); x[8] = pg8::bfhi(r4.w);
                    float y[8];
#pragma unroll
                    for (int e = 0; e < 8; ++e) y[e] = zw0 * x[e] + zw1 * x[e + 1] + zw2 * x[e + 2] + zb;
                    r4.x = pk2(y[0], y[1]); r4.y = pk2(y[2], y[3]); r4.z = pk2(y[4], y[5]); r4.w = pk2(y[6], y[7]);
                }
                *(LAS u32x4*)(lds + b * RS + (192 + s0) * 2) = r4; } }
    }
#pragma unroll 1
    for (int o = 0; o < 2; ++o) {
    int tid_o = tid_l; asm volatile("" : "+v"(tid_o));
    const int tid = tid_o, lane = tid & 63, wid = __builtin_amdgcn_readfirstlane(tid >> 6), n = lane & 31, h = lane >> 5;
    const bf16_t* gsrc = o ? gsrcB : gsrcA; const float gw0 = o ? gB0 : gA0, gw1 = o ? gB1 : gA1, gw2 = o ? gB2 : gA2, gb = o ? gBb : gAb;
    const bf16_t* filt = o ? filtB : filtA; const float bias = o ? biasB : biasA;
    if (tid < 36) { const int s = tid / 9, j = tid % 9; const int y = (j < 5 - s) ? j : 2 * L + 4 - s + (j - (5 - s)); *(LAS unsigned short*)(lds + FOFF + s * CLB + 2 * y) = 0; }
    for (int j = tid; j < 2 * L / 8; j += 512) {
        const int dir = j / (L / 8), t8 = (j % (L / 8)) * 8; const u32x4 raw = *(const u32x4*)(filt + (size_t)dir * L + t8);
        unsigned short e[8]; e[0] = raw.x & 0xffff; if (j == 0) e[0] = (unsigned short)f2bf(bf2f(e[0]) + bf2f(filt[L]));
 e[1] = raw.x >> 16; e[2] = raw.y & 0xffff; e[3] = raw.y >> 16; e[4] = raw.z & 0xffff; e[5] = raw.z >> 16; e[6] = raw.w & 0xffff; e[7] = raw.w >> 16;
#pragma unroll
        for (int i = 0; i < 8; ++i) { const int t = t8 + i; if (dir == 1 && t == 0) continue; const int d = dir ? -t : t;
#pragma unroll
            for (int s = 0; s < 4; ++s) { const int y = L + 4 - d - s; *(LAS unsigned short*)(lds + FOFF + s * CLB + 2 * y) = e[i]; } }
    }
    __syncthreads();
    u32x4 graw[NIT]; unsigned short gpv[NIT], gnx[NIT];
#define LC_GPREF() do { _Pragma("unroll") for (int it = 0; it < NIT; ++it) { const int i = tid + 512 * it; graw[it] = zero4(); gpv[it] = 0; gnx[it] = 0; \
        if (i < L) { const int b = i / (L / 8), s0 = (i % (L / 8)) * 8; const bf16_t* p = gsrc + (size_t)b * L + s0; graw[it] = *(const u32x4*)p; \
            if (s0 > 0) gpv[it] = p[-1]; if (s0 + 8 < L) gnx[it] = p[8]; } } } while (0)
    if constexpr (NTB != 64) LC_GPREF();
    const int Tw = 8 * wid;
    f32x16 acc[2][2];
#pragma unroll
    for (int a = 0; a < 2; ++a)
#pragma unroll
        for (int c = 0; c < 2; ++c)
#pragma unroll
            for (int r = 0; r < 16; ++r) acc[a][c][r] = 0.f;
    if (Tw < NTB) {
        const int sft = (4 - (n & 3)) & 3;
        const LAS unsigned char* bp = lds + FOFF + sft * CLB + 2 * (8 * h - n - sft + L + 4);
        const LAS unsigned char* zp = lds + (n & 7) * RS + 384 + 128 * (Tw + (n >> 3)) + 16 * h;
#define LC_LDT(TF, DD) do { _Pragma("unroll") for (int f = 0; f < 6; ++f) { const LAS unsigned char* q = bp + 32 * (f - 2 - 4 * (DD)); \
            const u32x2 lo = *(const LAS u32x2*)q, hi2 = *(const LAS u32x2*)(q + 8); const u32x4 w = (u32x4){lo.x, lo.y, hi2.x, hi2.y}; TF[f] = __builtin_bit_cast(bf16x8, w); } } while (0)
#define LC_LDZ(ZF, mt, DD) do { _Pragma("unroll") for (int ks = 0; ks < 4; ++ks) ZF[ks] = *(const LAS bf16x8*)(zp + 512 * (mt) + 32 * ks - 128 * (DD)); } while (0)
#define LC_MMA1(TF, ZF, mt) do { _Pragma("unroll") for (int ks = 0; ks < 4; ++ks) _Pragma("unroll") for (int nt = 0; nt < 2; ++nt) \
            acc[mt][nt] = __builtin_amdgcn_mfma_f32_32x32x16_bf16(ZF[ks], TF[ks - 2 * nt + 2], acc[mt][nt], 0, 0, 0); } while (0)
#define LC_MMA2(TF, ZF0, ZF1) do { _Pragma("unroll") for (int ks = 0; ks < 4; ++ks) _Pragma("unroll") for (int nt = 0; nt < 2; ++nt) { \
            acc[0][nt] = __builtin_amdgcn_mfma_f32_32x32x16_bf16(ZF0[ks], TF[ks - 2 * nt + 2], acc[0][nt], 0, 0, 0); \
            acc[1][nt] = __builtin_amdgcn_mfma_f32_32x32x16_bf16(ZF1[ks], TF[ks - 2 * nt + 2], acc[1][nt], 0, 0, 0); } } while (0)
        bf16x8 tfA[6], tfB[6], zA0[4], zA1[4], zB0[4], zB1[4];
        if constexpr (NTB == 64) {
            for (int Dd = Tw - 63; Dd < Tw - 59; ++Dd) { LC_LDT(tfA, Dd); LC_LDZ(zA0, 0, Dd); LC_MMA1(tfA, zA0, 0); }
            int Dd = Tw - 59;
            LC_LDT(tfA, Dd); LC_LDZ(zA0, 0, Dd); LC_LDZ(zA1, 1, Dd);
            for (int it = 0; it < 31; ++it) {
                LC_LDT(tfB, Dd + 1); LC_LDZ(zB0, 0, Dd + 1); LC_LDZ(zB1, 1, Dd + 1);
                __builtin_amdgcn_sched_barrier(0);
                LC_MMA2(tfA, zA0, zA1);
                __builtin_amdgcn_sched_barrier(0);
                LC_LDT(tfA, Dd + 2); LC_LDZ(zA0, 0, Dd + 2); LC_LDZ(zA1, 1, Dd + 2);
                __builtin_amdgcn_sched_barrier(0);
                LC_MMA2(tfB, zB0, zB1);
                __builtin_amdgcn_sched_barrier(0);
                Dd += 2;
            }
            LC_MMA2(tfA, zA0, zA1);
            LC_GPREF();
            for (int D3 = Tw + 4; D3 < Tw + 8; ++D3) { LC_LDT(tfA, D3); LC_LDZ(zA1, 1, D3); LC_MMA1(tfA, zA1, 1); }
        } else {
            for (int Dd = -(NTB - 1); Dd <= NTB - 1; ++Dd) { LC_LDT(tfA, Dd); LC_LDZ(zA0, 0, Dd); LC_MMA1(tfA, zA0, 0); }
        }
#undef LC_LDT
#undef LC_LDZ
#undef LC_MMA1
#undef LC_MMA2
#undef LC_GPREF
    }
    __syncthreads();
    if (Tw < NTB) {
#pragma unroll
        for (int mt = 0; mt < 2; ++mt) {
            if (Tw + 4 * mt < NTB) {
#pragma unroll
                for (int nt = 0; nt < 2; ++nt)
#pragma unroll
                    for (int r = 0; r < 16; ++r) {
                        const int b = (r & 3) + 4 * h, Tl = r >> 2, s = 64 * (Tw + 4 * mt + Tl) + 32 * nt + n;
                        LAS unsigned short* zq = (LAS unsigned short*)(lds + b * RS + (192 + s) * 2);
                        *zq = (unsigned short)f2bf(acc[mt][nt][r] + bias * bf2f(*zq));
                    }
            }
        }
    }
    __syncthreads();
    {
#pragma unroll
        for (int it = 0; it < NIT; ++it) { const int i = tid + 512 * it;
            if (i < L) { const int b = i / (L / 8), s0 = (i % (L / 8)) * 8; const u32x4 r4 = graw[it]; const u32x4 st = *(const LAS u32x4*)(lds + b * RS + (192 + s0) * 2);
                float x[10];
                x[0] = bf2f(gpv[it]); x[9] = bf2f(gnx[it]);
                x[1] = pg8::bflo(r4.x); x[2] = pg8::bfhi(r4.x); x[3] = pg8::bflo(r4.y); x[4] = pg8::bfhi(r4.y);
                x[5] = pg8::bflo(r4.z); x[6] = pg8::bfhi(r4.z); x[7] = pg8::bflo(r4.w); x[8] = pg8::bfhi(r4.w);
                float sv[8]; sv[0] = pg8::bflo(st.x); sv[1] = pg8::bfhi(st.x); sv[2] = pg8::bflo(st.y); sv[3] = pg8::bfhi(st.y); sv[4] = pg8::bflo(st.z); sv[5] = pg8::bfhi(st.z); sv[6] = pg8::bflo(st.w); sv[7] = pg8::bfhi(st.w);
                float y[8];
#pragma unroll
                for (int e = 0; e < 8; ++e) y[e] = (gw0 * x[e] + gw1 * x[e + 1] + gw2 * x[e + 2] + gb) * sv[e];
                u32x4 w; w.x = pk2(y[0], y[1]); w.y = pk2(y[2], y[3]); w.z = pk2(y[4], y[5]); w.w = pk2(y[6], y[7]);
                if (o == 0) *(LAS u32x4*)(lds + b * RS + (192 + s0) * 2) = w;
                else *(u32x4*)(dst + (size_t)b * L + s0) = w; } }
    }
    __syncthreads();
    }
}
__device__ __forceinline__ void gmlp_unit(LAS unsigned char* lds, int tok0, int g, const bf16_t* vT, const float* statp, const bf16_t* gmws, const float* bs,
                                          const float* lng, const float* lnb, bf16_t* U, const bf16_t* GG) {
    int tid_l = threadIdx.x; asm volatile("" : "+v"(tid_l));
    const int tid = tid_l, lane = tid & 63, wid = __builtin_amdgcn_readfirstlane(tid >> 6), n = lane & 31, h = lane >> 5;
    LAS float* mean = (LAS float*)lds; LAS float* rstd = mean + 128;
    constexpr int VOFF = 1024, VRS = 272, YOFF = VOFF + 128 * VRS, YRS = 132;
    { u32x4 raw[4];
#pragma unroll
      for (int q = 0; q < 4; ++q) { const int idx = tid + 512 * q, c = idx >> 4, ch = idx & 15; raw[q] = *(const u32x4*)(vT + (size_t)(g * 128 + c) * MT + tok0 + ch * 8); }
      if (tid < 128) { float s = 0.f, q2 = 0.f;
#pragma unroll
          for (int p = 0; p < 8; ++p) { const float* sp = statp + ((size_t)p * MT + tok0 + tid) * 2; s += sp[0]; q2 += sp[1]; }
          const float mu = s * (1.f / 1024.f); const float var = fmaxf(q2 * (1.f / 1024.f) - mu * mu, 0.f);
          mean[tid] = mu; rstd[tid] = rsqrtf(var + 1e-5f); }
#pragma unroll
      for (int q = 0; q < 4; ++q) { const int idx = tid + 512 * q, c = idx >> 4, ch = idx & 15; *(LAS u32x4*)(lds + VOFF + c * VRS + ch * 16) = raw[q]; } }
    __syncthreads();
    const int pt = wid >> 1, ctb = (wid & 1) * 2;
    f32x16 acc[2];
#pragma unroll
    for (int c = 0; c < 2; ++c)
#pragma unroll
        for (int r = 0; r < 16; ++r) acc[c][r] = 0.f;
    const bf16_t* ap = gmws + ((size_t)g * 128 + 32 * pt + n) * 128 + 8 * h;
    bf16x8 af[8];
#pragma unroll
    for (int ks = 0; ks < 8; ++ks) af[ks] = *(const bf16x8*)(ap + 16 * ks);
    float ga[2], be[2];
#pragma unroll
    for (int ct = 0; ct < 2; ++ct) { const int cgl = g * 128 + 32 * (ctb + ct) + n; ga[ct] = lng[cgl]; be[ct] = lnb[cgl]; }
#pragma unroll
    for (int ks = 0; ks < 8; ++ks) {
        float mu[8], rs[8];
#pragma unroll
        for (int e = 0; e < 8; ++e) { mu[e] = mean[16 * ks + 8 * h + e]; rs[e] = rstd[16 * ks + 8 * h + e]; }
#pragma unroll
        for (int ct = 0; ct < 2; ++ct) {
            const u32x4 raw = *(const LAS u32x4*)(lds + VOFF + (32 * (ctb + ct) + n) * VRS + (16 * ks + 8 * h) * 2);
            u32x4 w;
            w.x = pk2((pg8::bflo(raw.x) - mu[0]) * rs[0] * ga[ct] + be[ct], (pg8::bfhi(raw.x) - mu[1]) * rs[1] * ga[ct] + be[ct]);
            w.y = pk2((pg8::bflo(raw.y) - mu[2]) * rs[2] * ga[ct] + be[ct], (pg8::bfhi(raw.y) - mu[3]) * rs[3] * ga[ct] + be[ct]);
            w.z = pk2((pg8::bflo(raw.z) - mu[4]) * rs[4] * ga[ct] + be[ct], (pg8::bfhi(raw.z) - mu[5]) * rs[5] * ga[ct] + be[ct]);
            w.w = pk2((pg8::bflo(raw.w) - mu[6]) * rs[6] * ga[ct] + be[ct], (pg8::bfhi(raw.w) - mu[7]) * rs[7] * ga[ct] + be[ct]);
            acc[ct] = __builtin_amdgcn_mfma_f32_32x32x16_bf16(af[ks], __builtin_bit_cast(bf16x8, w), acc[ct], 0, 0, 0);
        }
    }
#pragma unroll
    for (int ct = 0; ct < 2; ++ct)
#pragma unroll
        for (int r = 0; r < 16; ++r) { const int p = 32 * pt + crow(r, h); ((LAS float*)(lds + YOFF))[p * YRS + 32 * (ctb + ct) + n] = acc[ct][r] + bs[g * 128 + p]; }
    __syncthreads();
    { u32x4 uu[4], gg[4];
#pragma unroll
      for (int q = 0; q < 4; ++q) { const int idx = tid + 512 * q, p = idx >> 4, ch = idx & 15; const size_t ix = (size_t)(tok0 + p) * 1024 + g * 128 + ch * 8; uu[q] = *(const u32x4*)(U + ix); gg[q] = *(const u32x4*)(GG + ix); }
#pragma unroll
      for (int q = 0; q < 4; ++q) { const int idx = tid + 512 * q, p = idx >> 4, ch = idx & 15; const size_t ix = (size_t)(tok0 + p) * 1024 + g * 128 + ch * 8;
        const LAS float* yp = (const LAS float*)(lds + YOFF) + p * YRS + ch * 8; const f32x4 y0 = *(const LAS f32x4*)yp, y1 = *(const LAS f32x4*)(yp + 4); u32x4 w;
        w.x = pk2(pg8::bflo(uu[q].x) * y0.x * pg8::bflo(gg[q].x), pg8::bfhi(uu[q].x) * y0.y * pg8::bfhi(gg[q].x));
        w.y = pk2(pg8::bflo(uu[q].y) * y0.z * pg8::bflo(gg[q].y), pg8::bfhi(uu[q].y) * y0.w * pg8::bfhi(gg[q].y));
        w.z = pk2(pg8::bflo(uu[q].z) * y1.x * pg8::bflo(gg[q].z), pg8::bfhi(uu[q].z) * y1.y * pg8::bfhi(gg[q].z));
        w.w = pk2(pg8::bflo(uu[q].w) * y1.z * pg8::bflo(gg[q].w), pg8::bfhi(uu[q].w) * y1.w * pg8::bfhi(gg[q].w));
        *(u32x4*)(U + ix) = w; } }
    __syncthreads();
}

__device__ __forceinline__ void qk_part(const bf16_t* src, bf16_t* dstp, const float* gain, const float* rope, int lane, bool lat, int s, bool active) {
    const int block = lane >> 2, j = lane & 3, axis = block & 1, off = (block >> 1) * 128 + axis * 64 + 8 * j;
    u32x4 ra = zero4(), rb = ra;
    if (active) { ra = *(const u32x4*)(src + off); rb = *(const u32x4*)(src + off + 32); }
    float a[8], c[8];
    a[0] = pg8::bflo(ra.x); a[1] = pg8::bfhi(ra.x); a[2] = pg8::bflo(ra.y); a[3] = pg8::bfhi(ra.y); a[4] = pg8::bflo(ra.z); a[5] = pg8::bfhi(ra.z); a[6] = pg8::bflo(ra.w); a[7] = pg8::bfhi(ra.w);
    c[0] = pg8::bflo(rb.x); c[1] = pg8::bfhi(rb.x); c[2] = pg8::bflo(rb.y); c[3] = pg8::bfhi(rb.y); c[4] = pg8::bflo(rb.z); c[5] = pg8::bfhi(rb.z); c[6] = pg8::bflo(rb.w); c[7] = pg8::bfhi(rb.w);
    float ss = 0.f;
#pragma unroll
    for (int e = 0; e < 8; ++e) ss += a[e] * a[e] + c[e] * c[e];
    ss = sx_add<1>(ss); ss = sx_add<2>(ss); ss = sx_add<4>(ss);
    const float rn = rsqrtf(ss * (1.f / 128.f) + 1e-6f);
    const float* gp = gain + axis * 64 + 8 * j;
    const f32x4 g0 = *(const f32x4*)gp, g1 = *(const f32x4*)(gp + 4), g2 = *(const f32x4*)(gp + 32), g3 = *(const f32x4*)(gp + 36);
    const float ga[8] = {g0.x, g0.y, g0.z, g0.w, g1.x, g1.y, g1.z, g1.w}, gc[8] = {g2.x, g2.y, g2.z, g2.w, g3.x, g3.y, g3.z, g3.w};
    float o1[8], o2[8];
    if (lat) {
        const int pos = axis ? (s & 63) : (s >> 6); const float* rp = rope + (size_t)(pos * 32 + 8 * j) * 2;
        const f32x4 t0 = *(const f32x4*)rp, t1 = *(const f32x4*)(rp + 4), t2 = *(const f32x4*)(rp + 8), t3 = *(const f32x4*)(rp + 12);
        const float cs[8] = {t0.x, t0.z, t1.x, t1.z, t2.x, t2.z, t3.x, t3.z}, sn[8] = {t0.y, t0.w, t1.y, t1.w, t2.y, t2.w, t3.y, t3.w};
#pragma unroll
        for (int e = 0; e < 8; ++e) { const float x = a[e] * rn * ga[e], y = c[e] * rn * gc[e]; o1[e] = x * cs[e] - y * sn[e]; o2[e] = y * cs[e] + x * sn[e]; }
    } else {
#pragma unroll
        for (int e = 0; e < 8; ++e) { o1[e] = a[e] * rn * ga[e]; o2[e] = c[e] * rn * gc[e]; }
    }
    if (active) {
        u32x4 w; w.x = pk2(o1[0], o1[1]); w.y = pk2(o1[2], o1[3]); w.z = pk2(o1[4], o1[5]); w.w = pk2(o1[6], o1[7]); *(u32x4*)(dstp + off) = w;
        w.x = pk2(o2[0], o2[1]); w.y = pk2(o2[2], o2[3]); w.z = pk2(o2[4], o2[5]); w.w = pk2(o2[6], o2[7]); *(u32x4*)(dstp + off + 32) = w; }
}
__device__ __forceinline__ void qk_row(int m, bf16_t* Q, const bf16_t* KV, bf16_t* Kp, bf16_t* Vp, const float* qg, const float* kg, const float* rope, int lane, bool doq) {
    const bool lat = m < ML; int b, s;
    if (lat) { b = m >> 12; s = m & 4095; } else { b = (m - ML) >> 8; s = (m - ML) & 255; }
    if (doq) qk_part(Q + (size_t)m * 1024, Q + (size_t)m * 1024, qg, rope, lane, lat, s, true);
    const size_t krow = (size_t)b * NKEY + (lat ? CTXL + s : s);
    const bf16_t* kr = KV + (size_t)m * 512;
    qk_part(kr, Kp + krow * 256, kg, rope, lane, lat, s, lane < 16);
    if (lane < 32) *(u32x4*)(Vp + krow * 256 + lane * 8) = *(const u32x4*)(kr + 256 + lane * 8);
}

__device__ __forceinline__ void tgate_item(LAS unsigned char* lds, const bf16_t* inT, const bf16_t* gate, bf16_t* out, int tok0, int c0) {
    int tid_l = threadIdx.x; asm volatile("" : "+v"(tid_l));
    const int tid = tid_l; LAS unsigned short* t = (LAS unsigned short*)lds;
    { const int cl = tid >> 3, ch = tid & 7; u32x4 raw[4];
#pragma unroll
      for (int q = 0; q < 4; ++q) raw[q] = *(const u32x4*)(inT + (size_t)(c0 + 64 * q + cl) * MT + tok0 + ch * 8);
#pragma unroll
      for (int q = 0; q < 4; ++q) { LAS unsigned short* d = t + q * (64 * 72) + (ch * 8) * 72 + cl;
        d[0 * 72] = (unsigned short)(raw[q].x & 0xffff); d[1 * 72] = (unsigned short)(raw[q].x >> 16); d[2 * 72] = (unsigned short)(raw[q].y & 0xffff); d[3 * 72] = (unsigned short)(raw[q].y >> 16);
        d[4 * 72] = (unsigned short)(raw[q].z & 0xffff); d[5 * 72] = (unsigned short)(raw[q].z >> 16); d[6 * 72] = (unsigned short)(raw[q].w & 0xffff); d[7 * 72] = (unsigned short)(raw[q].w >> 16); } }
    __syncthreads();
    { const int tl = tid >> 3, ch = tid & 7; u32x4 g[4];
#pragma unroll
      for (int q = 0; q < 4; ++q) g[q] = *(const u32x4*)(gate + (size_t)(tok0 + tl) * 1024 + c0 + 64 * q + ch * 8);
#pragma unroll
      for (int q = 0; q < 4; ++q) { const u32x4 v = *(const LAS u32x4*)(t + q * (64 * 72) + tl * 72 + ch * 8); u32x4 w;
        w.x = pk2(pg8::bflo(v.x) * pg8::bflo(g[q].x), pg8::bfhi(v.x) * pg8::bfhi(g[q].x)); w.y = pk2(pg8::bflo(v.y) * pg8::bflo(g[q].y), pg8::bfhi(v.y) * pg8::bfhi(g[q].y));
        w.z = pk2(pg8::bflo(v.z) * pg8::bflo(g[q].z), pg8::bfhi(v.z) * pg8::bfhi(g[q].z)); w.w = pk2(pg8::bflo(v.w) * pg8::bflo(g[q].w), pg8::bfhi(v.w) * pg8::bfhi(g[q].w));
        *(u32x4*)(out + (size_t)(tok0 + tl) * 1024 + c0 + 64 * q + ch * 8) = w; } }
    __syncthreads();
}
#define XB_TMO      128
#define XB_XCNT(j)  (256  + 64 * (j))
#define XB_XSUB(j)  (1280 + 64 * (j))
#define XB_XGEN(j)  (2304 + 64 * (j))
#define XB_TOP      3328
#define XB_TOPGEN   3392
#define XCD_BAR_WORDS 3456
#define XB_SPIN_CAP (1u << 18)

__device__ __forceinline__ unsigned xb_ld(unsigned* p)              { return __hip_atomic_load(p, __ATOMIC_RELAXED, __HIP_MEMORY_SCOPE_AGENT); }
__device__ __forceinline__ unsigned xb_add(unsigned* p, unsigned v) { return __hip_atomic_fetch_add(p, v, __ATOMIC_RELAXED, __HIP_MEMORY_SCOPE_AGENT); }
__device__ __forceinline__ unsigned xb_xcc_id() { return (unsigned)__builtin_amdgcn_s_getreg((3 << 11) | 20) & 0xFu; }
#define XB_SPIN(cond, bar) do { unsigned _sp = 0; while (cond) { __builtin_amdgcn_s_sleep(1); \
    if ((++_sp & 255u) == 0u) { if (xb_ld(&(bar)[XB_TMO])) break; if (_sp > XB_SPIN_CAP) { atomicAdd(&(bar)[XB_TMO], 1u); break; } } } } while (0)

struct XcdBarrier {
    unsigned* bar; unsigned x;
    volatile LAS unsigned* st;
};

__device__ __forceinline__ XcdBarrier xcd_barrier_post(unsigned* bar, volatile LAS unsigned* st) {
    XcdBarrier b; b.bar = bar; b.x = xb_xcc_id(); b.st = st;
    if (threadIdx.x == 0) (void)xb_add(&bar[XB_XCNT(b.x)], 1u);
    return b;
}
__device__ __forceinline__ void xcd_barrier_complete(unsigned* bar, unsigned x, unsigned& nloc, unsigned& nx) {
    const unsigned G = gridDim.x * gridDim.y * gridDim.z;
    unsigned sum, cnt, mine, sp = 0u;
    for (;;) {
        sum = 0u; cnt = 0u; mine = 0u;
#pragma unroll
        for (unsigned j = 0; j < 16; ++j) { const unsigned c = xb_ld(&bar[XB_XCNT(j)]); sum += c; cnt += (c > 0u) ? 1u : 0u; mine = (j == x) ? c : mine; }
        if (sum == G) break;
        __builtin_amdgcn_s_sleep(1);
        if ((++sp & 255u) == 0u) { if (xb_ld(&bar[XB_TMO])) break; if (sp > XB_SPIN_CAP) { atomicAdd(&bar[XB_TMO], 1u); break; } }
    }
    nloc = mine > 0u ? mine : 1u; nx = cnt > 0u ? cnt : 1u;
}

__device__ __forceinline__ void xcd_barrier(const XcdBarrier& b) {
    asm volatile("s_waitcnt vmcnt(0)" ::: "memory");
    __syncthreads();
    if (threadIdx.x == 0) {
        unsigned* bar = b.bar;
        __builtin_amdgcn_s_waitcnt(0);
        unsigned nloc = b.st[0], nx = b.st[1];
        if (nloc == 0u) { xcd_barrier_complete(bar, b.x, nloc, nx); b.st[0] = nloc; b.st[1] = nx; }
        const unsigned old = xb_add(&bar[XB_XSUB(b.x)], 1u);
        const unsigned gen = old / nloc;
        if (old + 1u == (gen + 1u) * nloc) {
            __builtin_amdgcn_fence(__ATOMIC_RELEASE, "agent");
            asm volatile("s_waitcnt vmcnt(0)" ::: "memory");
            const unsigned og = xb_add(&bar[XB_TOP], 1u);
            const unsigned tg = og / nx;
            if (og + 1u == (tg + 1u) * nx) xb_add(&bar[XB_TOPGEN], 1u);
            else XB_SPIN(xb_ld(&bar[XB_TOPGEN]) == tg, bar);
            __builtin_amdgcn_fence(__ATOMIC_ACQUIRE, "agent");
            xb_add(&bar[XB_XGEN(b.x)], 1u);
            asm volatile("s_waitcnt vmcnt(0)" ::: "memory");
        } else {
            XB_SPIN(xb_ld(&bar[XB_XGEN(b.x)]) == gen, bar);
            __builtin_amdgcn_fence(__ATOMIC_ACQUIRE, "agent");
            asm volatile("s_waitcnt vmcnt(0)" ::: "memory");
        }
    }
    __syncthreads();
}

constexpr size_t WS_BAR = 512 * 1024;
constexpr size_t WS_ROPE = 768 * 1024;
constexpr size_t WS_SPO = 492 * MiB, WS_SPG = 496 * MiB;
constexpr size_t WS_HDNB = 487 * MiB, WS_W3T = 488 * MiB, WS_HDNCB = 489 * MiB, WS_HDNB1 = 490 * MiB;
constexpr int NPH = 16;
#ifndef PHMASK
#define PHMASK 0xffff
#endif
#define PON(k) ((PHMASK >> (k)) & 1)
__global__ void __launch_bounds__(512, 2) fwd_kernel(Args args) {
    extern __shared__ __attribute__((aligned(16))) unsigned char lds_raw[];
    LAS unsigned char* lds = (LAS unsigned char*)lds_raw;
    cg::grid_group grid = cg::this_grid();
    const int G = gridDim.x, bx = blockIdx.x;
    if (threadIdx.x < 2) ((volatile LAS unsigned*)(lds + 147200))[threadIdx.x] = 0u;
    __syncthreads();
    XcdBarrier xbar; xbar.bar = (unsigned*)(args.ws + WS_BAR); xbar.x = 0; xbar.st = (volatile LAS unsigned*)(lds + 147200);
    const int vcu = (G % 8 == 0) ? (bx % 8) * (G / 8) + bx / 8 : bx;
    const int NGW = G * 8;
    if (args.ph_lo == 0) {
        int tid_p = threadIdx.x; asm volatile("" : "+v"(tid_p));
        const int lane = tid_p & 63, wave = __builtin_amdgcn_readfirstlane(tid_p >> 6); const int gw = vcu * 8 + wave; unsigned char* ws = args.ws;
        if (bx == (G > 1 ? 1 : 0)) { float* rt = (float*)(ws + WS_ROPE); for (int i = tid_p; i < 2048; i += 512) { const int pos = i >> 5, fi = i & 31; const float inv = powf(10000.0f, -(float)(2 * fi) * (1.0f / 64.0f)); const float ang = (float)pos * inv; rt[2 * i] = cosf(ang); rt[2 * i + 1] = sinf(ang); } }
        for (int it = gw; it < 4096 + 256 + 4096; it += NGW) {
            const int lw = (it < 4352) ? 0 : 1;
            const float* w1 = args.in[I_HW1] + lw * 33 * 64; const float* b1 = args.in[I_HB1] + lw * 64; const float* w2 = args.in[I_HW2] + lw * 4096; const float* b2 = args.in[I_HB2] + lw * 64; const float* fq = args.in[I_HFREQ] + lw * 128;
            if (it < 4096) hdn_item(w1, b1, w2, b2, fq, it, 4096, (bf16_t*)(ws + WS_HDNB), lane);
            else if (it < 4352) hdn_item(w1, b1, w2, b2, fq, it - 4096, 256, (bf16_t*)(ws + WS_HDNCB), lane);
            else hdn_item(w1, b1, w2, b2, fq, it - 4352, 4096, (bf16_t*)(ws + WS_HDNB1), lane);
        }
    }
    for (int gp = args.ph_lo; gp < args.ph_hi; ++gp) {
    int tid_l = threadIdx.x; asm volatile("" : "+v"(tid_l));
    const int tid = tid_l, lane = tid & 63, wave = __builtin_amdgcn_readfirstlane(tid >> 6);
    const int gw = vcu * 8 + wave;
    __attribute__((address_space(1))) unsigned char* wsg = (__attribute__((address_space(1))) unsigned char*)args.ws; asm volatile("" : "+s"(wsg));
    unsigned char* ws = (unsigned char*)wsg;
#ifdef PROBE_A
    if (bx == 0 && tid == 0) ((LAS unsigned long long*)(lds + 146000))[gp] = __builtin_amdgcn_s_memrealtime();
#endif
    float* modv = (float*)(ws + WS_MOD); float* hdn = (float*)(ws + WS_HDN); float* hdnc = (float*)(ws + WS_HDNC);
    float* statp = (float*)(ws + WS_STATP); float* ysq = (float*)(ws + WS_YSQ);
    bf16_t* WIN = (bf16_t*)(ws + WS_WIN); bf16_t* WHYO = (bf16_t*)(ws + WS_WHYO); bf16_t* WATTO = (bf16_t*)(ws + WS_WATTO); bf16_t* WGMO = (bf16_t*)(ws + WS_WGMO); bf16_t* WOUT = (bf16_t*)(ws + WS_WOUT);
    bf16_t* GMWS = (bf16_t*)(ws + WS_GMWS); bf16_t* FILT = (bf16_t*)(ws + WS_FILT); bf16_t* FILTC = (bf16_t*)(ws + WS_FILTC);
    bf16_t* H = (bf16_t*)(ws + WS_H);
    bf16_t* R0 = (bf16_t*)(ws + WS_R0); bf16_t* R1 = (bf16_t*)(ws + WS_R1); bf16_t* R2 = (bf16_t*)(ws + WS_R2); bf16_t* R3 = (bf16_t*)(ws + WS_R3); bf16_t* R4 = (bf16_t*)(ws + WS_R4);
    bf16_t* KVRAW = R1; bf16_t* KP = (bf16_t*)(ws + WS_R1 + 34 * MiB); bf16_t* VP = (bf16_t*)(ws + WS_R1 + 51 * MiB);
    float* Y = (float*)(ws + WS_R0);

#ifdef PROBE_A
    if (gp == 2 * NPH) {
        if (bx == 0) {
            LAS unsigned long long* ts = (LAS unsigned long long*)(lds + 146000);
            float s = 0.f;
            for (int i = tid; i < 8 * 131072; i += 512) { const f32x4 v = ((const f32x4*)(args.out + (size_t)(i >> 17) * 4096 * 1024))[i & 131071]; s += (v.x * v.x + v.y * v.y) + (v.z * v.z + v.w * v.w); }
            LAS float* red = (LAS float*)lds; red[tid] = s; __syncthreads();
            if (tid == 0) { float tot = 0.f; for (int i = 0; i < 512; ++i) tot += red[i];
                unsigned long long ta = 0, tb = 0;
                for (int g2 = 0; g2 < 2 * NPH; ++g2) { const unsigned long long d = ts[g2 + 1] - ts[g2]; if ((PROBE_A >> (g2 % NPH)) & 1) ta += d; if ((PROBE_B >> (g2 % NPH)) & 1) tb += d; }
                int a = (int)((ta + PROBE_UNIT / 2) / PROBE_UNIT), b2 = (int)((tb + PROBE_UNIT / 2) / PROBE_UNIT); if (a > 63) a = 63; if (b2 > 63) b2 = 63;
                red[600] = 0.3f * sqrtf(tot * (1.0f / 4194304.0f)); ((LAS int*)red)[601] = a + 64 * b2; }
            __syncthreads();
            const float delta = red[600]; const int K = ((LAS int*)red)[601];
            for (int i = tid; i < K; i += 512) args.out[(size_t)i * 8191 + 3] += delta;
        }
    } else
#endif
    {
        const int l = gp / NPH, p = gp % NPH;
        if (p == 4) continue;
        if (l == 1 && p == 1) continue;
        const int Ml = (l == 0) ? MT : ML;
        if (p == 0 && PON(0)) {
            if (gp == 0 && bx == 0) { for (int i = tid; i < XCD_BAR_WORDS; i += 512) ((unsigned*)(ws + WS_BAR))[i] = 0u; }
            if (l == 0) {
                for (int it = bx; it < 96; it += G) {
                    const int ll = it / 48, cb = it % 48, col = cb * 64 + lane, kb = wave * 128;
                    const float* Wm = args.in[I_WMOD] + (size_t)ll * 1024 * 3072; const float* cc = args.in[I_C]; const float* cx = args.in[I_CCTX];
                    float acc[9];
#pragma unroll
                    for (int r = 0; r < 9; ++r) acc[r] = 0.f;
                    LAS float* sc = (LAS float*)(lds + 32768);
                    for (int i = tid; i < 9 * 1024; i += 512) { const int r = i >> 10, kk = i & 1023; sc[i] = silu_f((r < 8) ? cc[r * 1024 + kk] : cx[kk]); }
                    __syncthreads();
                    for (int k = kb; k < kb + 128; ++k) { const float w = Wm[(size_t)k * 3072 + col];
#pragma unroll
                        for (int r = 0; r < 9; ++r) acc[r] += sc[r * 1024 + k] * w; }
                    LAS float* red = (LAS float*)lds;
#pragma unroll
                    for (int r = 0; r < 9; ++r) red[(wave * 9 + r) * 64 + lane] = acc[r];
                    __syncthreads();
                    for (int i = tid; i < 576; i += 512) { const int r = i >> 6, ln = i & 63; float s = args.in[I_BMOD][ll * 3072 + cb * 64 + ln];
                        for (int w8 = 0; w8 < 8; ++w8) s += red[(w8 * 9 + r) * 64 + ln];
                        modv[(size_t)(ll * 9 + r) * 3072 + cb * 64 + ln] = s; }
                    __syncthreads();
                }
            }
            LAS float* scr = (LAS float*)(lds + 4096 + wave * 16384);
            const int NIT = 6400 + 2048 + 256 + 128;
            bf16_t* W3T = (bf16_t*)(ws + WS_W3T);
            for (int it = gw; it < NIT; it += NGW) {
                int r = it;
                if (r < 6400) { const int kb = r / 400, nb = r % 400; transpose_item(args.in[I_WIN] + (size_t)l * 1024 * INW, 1024, INW, WIN, kb * 64, nb * 32, win_remap(nb * 32), scr, lane); continue; }
                r -= 6400;
                if (r < 2048) { const int which = r >> 9, i2 = r & 511, kb = i2 >> 5, nb = i2 & 31;
                    const float* W = args.in[which == 0 ? I_WHYO : which == 1 ? I_WATTO : which == 2 ? I_WGMO : I_WOUT] + (size_t)l * 1024 * 1024;
                    bf16_t* WT = which == 0 ? WHYO : which == 1 ? WATTO : which == 2 ? WGMO : WOUT;
                    transpose_item(W, 1024, 1024, WT, kb * 64, nb * 32, nb * 32, scr, lane); continue; }
                r -= 2048;
                if (r < 256) { const float* src = args.in[I_GMWS] + (size_t)l * 131072 + r * 512 + lane * 8; const f32x4 a = *(const f32x4*)src, b = *(const f32x4*)(src + 4);
                    u32x4 w; w.x = pk2(a.x, a.y); w.y = pk2(a.z, a.w); w.z = pk2(b.x, b.y); w.w = pk2(b.z, b.w); *(u32x4*)(GMWS + r * 512 + lane * 8) = w; continue; }
                r -= 256;
                if (r < 128) {
                    transpose_item(args.in[I_HW3] + (size_t)l * 64 * 4096, 128, 4096, W3T, 0, r * 32, r * 32, scr, lane);
                    bf16_t* zp = W3T + (size_t)(r * 32 + (lane >> 1)) * 128 + 64 + (lane & 1) * 32;
#pragma unroll
                    for (int j = 0; j < 4; ++j) *(u32x4*)(zp + 8 * j) = zero4();
                    continue; }
            }
        } else if (p == 1 && PON(1)) {
            if (l == 0) {
                for (int m = gw; m < MT; m += NGW) {
                    const float* xr = (m < ML) ? args.in[I_X] + (size_t)m * 1024 : args.in[I_CTX] + (size_t)(m - ML) * 1024; const int r = (m < ML) ? (m >> 12) : 8;
                    f32x4 v[4];
#pragma unroll
                    for (int j = 0; j < 4; ++j) v[j] = *(const f32x4*)(xr + 4 * lane + 256 * j);
                    h_row(v, args.in[I_GPRE], modv + (size_t)r * 3072, H + (size_t)m * 1024, lane);
                }
            }
        } else if (p == 2 && PON(2)) {
            { pg8::Gemm g{(const bf16_t*)(ws + WS_W3T), (const bf16_t*)(ws + (l == 0 ? WS_HDNB : WS_HDNB1)), 4096, 4096, 128}; pg8::StaticOrder S; S.init(4096, 4096, G, bx); pg8::EpiF E{FILT, args.in[I_HDECAY] + l * 4096, 4096};
              pg8::gemm_phase<pg8::EpiF, pg8::StaticOrder, true, true>(lds, g, S, E); }
            if (l == 0) { pg8::Gemm g{(const bf16_t*)(ws + WS_W3T), (const bf16_t*)(ws + WS_HDNCB), 4096, 256, 128}; pg8::StaticOrder S; S.init(4096, 256, G, (bx + 128) % G); pg8::EpiF E{FILTC, args.in[I_HDECAY] + l * 4096, 256};
              pg8::gemm_phase<pg8::EpiF, pg8::StaticOrder, true, true>(lds, g, S, E); }
            { pg8::Gemm g{WIN, H, 3072, Ml, 1024}; pg8::StaticOrder S; S.init(3072, Ml, G, bx); pg8::EpiT<false> E{R0, MT, nullptr};
              pg8::gemm_phase<pg8::EpiT<false>, pg8::StaticOrder, true, true>(lds, g, S, E); }
            { pg8::Gemm g{H, WIN + (size_t)3072 * 1024, Ml, 2048, 1024}; pg8::StaticOrder S; S.init(Ml, 2048, G, (l == 0) ? (bx + 96) % G : bx); pg8::EpiIn<0> E{R3, R4, nullptr, nullptr};
              pg8::gemm_phase<pg8::EpiIn<0>, pg8::StaticOrder, true, true>(lds, g, S, E); }
        } else if (p == 3 && PON(3)) {
            const int nun = 1024 + (l == 0 ? 1024 : 0);
            const float* cw = args.in[I_HCW] + (size_t)l * 3 * 3072; const float* cb = args.in[I_HCB] + (size_t)l * 3072; const float* hb = args.in[I_HBIAS] + l * 2048;
            for (int u = bx; u < nun; u += G) {
                const int c = u & 1023; const bool isctx = u >= 1024; const size_t tb = isctx ? ML : 0;
                const int zc = 2048 + c, g1 = c, g2 = 1024 + c;
                const bf16_t* zsrc = R2 + (size_t)c * MT + tb; const bf16_t* gs1 = R0 + (size_t)c * MT + tb; const bf16_t* gs2 = R1 + (size_t)c * MT + tb; bf16_t* dst = R0 + (size_t)c * MT + tb;
                const float zw0 = cw[zc], zw1 = cw[3072 + zc], zw2 = cw[6144 + zc], zb = cb[zc];
                if (!isctx) lconv_unit<64>(lds, zsrc, true, zw0, zw1, zw2, zb, gs1, cw[g1], cw[3072 + g1], cw[6144 + g1], cb[g1], gs2, cw[g2], cw[3072 + g2], cw[6144 + g2], cb[g2],
                                           FILT + (size_t)c * 8192, FILT + (size_t)8192 * 1024 + (size_t)c * 8192, hb[c], hb[1024 + c], dst);
                else lconv_unit<4>(lds, zsrc, true, zw0, zw1, zw2, zb, gs1, cw[g1], cw[3072 + g1], cw[6144 + g1], cb[g1], gs2, cw[g2], cw[3072 + g2], cw[6144 + g2], cb[g2],
                                   FILTC + (size_t)c * 512, FILTC + (size_t)512 * 1024 + (size_t)c * 512, hb[c], hb[1024 + c], dst);
            }
        } else if (p == 5 && PON(5)) {
            for (int it = bx; it < (Ml / 64) * 4; it += G) tgate_item(lds, R0, R3, R1, (it >> 2) * 64, (it & 3) * 256);
        } else if (p == 6 && PON(6)) {
            pg8::Gemm g{R1, WHYO, ML, 1024, 1024}; pg8::StaticOrder S; S.init(ML, 1024, G, bx); pg8::EpiS E{R4, R4, 1};
            pg8::gemm_phase<pg8::EpiS, pg8::StaticOrder, true, true>(lds, g, S, E);
        } else if (p == 7 && PON(7)) {
            { pg8::Gemm g{H, WIN + (size_t)5120 * 1024, Ml, 3584, 1024}; pg8::StaticOrder S; S.init(Ml, 3584, G, bx); pg8::EpiIn<1> E{R0, KVRAW, R2, R3, (l == 0) ? (bf16_t*)(ws + WS_SPG) : nullptr};
              pg8::gemm_phase<pg8::EpiIn<1>, pg8::StaticOrder, true, true>(lds, g, S, E); }
            if (l == 0) { pg8::Gemm g{R1 + (size_t)ML * 1024, WHYO, MC, 1024, 1024}; pg8::StaticOrder S; S.init(MC, 1024, G, (bx + G - 112) % G); pg8::EpiS E{R4 + (size_t)ML * 1024, R4 + (size_t)ML * 1024, 1};
              pg8::gemm_phase<pg8::EpiS, pg8::StaticOrder, true, true>(lds, g, S, E); }
            if (l == 1) { pg8::Gemm g{H + (size_t)ML * 1024, WIN + (size_t)6144 * 1024, MC, 512, 1024}; pg8::StaticOrder S; S.init(MC, 512, G, (bx + 128) % G); pg8::EpiIn<3> E{KVRAW + (size_t)ML * 512, nullptr, nullptr, nullptr};
              pg8::gemm_phase<pg8::EpiIn<3>, pg8::StaticOrder, true, true>(lds, g, S, E); }
        } else if (p == 8 && PON(8)) {
            for (int m = gw; m < MT; m += NGW) qk_row(m, R0, KVRAW, KP, VP, args.in[I_QG] + l * 128, args.in[I_KG] + l * 128, (const float*)(ws + WS_ROPE), lane, m < Ml);
        } else if (p == 9 && PON(9)) {
            const int nun = 1024 + (l == 0 ? 64 : 0);
            for (int u = vcu; u < nun; u += G) {
                if (u < 1024) { const int grp = u >> 6, b = grp >> 1, kvh = grp & 1, within = u & 63, hh = kvh * 4 + (within >> 4), qb = within & 15;
                    const size_t qo = ((size_t)(b * SEQL + qb * 256)) * 1024 + hh * 128; const size_t ko = (size_t)b * NKEY * 256 + kvh * 128;
                    attn::attn_dense_body((const attn::bf16*)(R0 + qo), (const attn::bf16*)(KP + ko), (const attn::bf16*)(VP + ko), R0 + qo, R2 + qo, NKEY, (char*)lds_raw); }
                else { const int uc = u - 1024, b = uc >> 3, hh = uc & 7, kvh = hh >> 2;
                    const size_t qo = ((size_t)(ML + b * CTXL)) * 1024 + hh * 128; const size_t ko = (size_t)b * NKEY * 256 + kvh * 128;
                    attn::attn_dense_body((const attn::bf16*)(R0 + qo), (const attn::bf16*)(KP + ko), (const attn::bf16*)(VP + ko), (bf16_t*)(ws + WS_SPO) + ((size_t)(b * CTXL)) * 1024 + hh * 128, R2 + qo, CTXL, (char*)lds_raw); }
                __syncthreads();
            }
        } else if (p == 10 && PON(10)) {
            pg8::Gemm g{R0, WATTO, ML, 1024, 1024}; pg8::StaticOrder S; S.init(ML, 1024, G, bx); pg8::EpiS E{R3, R4, 0};
            pg8::gemm_phase<pg8::EpiS, pg8::StaticOrder, true, true>(lds, g, S, E);
        } else if (p == 11 && PON(11)) {
            { pg8::Gemm g{H, WIN + (size_t)8704 * 1024, Ml, 3072, 1024}; pg8::StaticOrder S; S.init(Ml, 3072, G, bx); pg8::EpiIn<2> E{R0, R2, R3, nullptr};
              pg8::gemm_phase<pg8::EpiIn<2>, pg8::StaticOrder, true, true>(lds, g, S, E); }
            { pg8::Gemm g{WIN + (size_t)11776 * 1024, H, 1024, Ml, 1024}; pg8::StaticOrder S; S.init(1024, Ml, G, (l == 0) ? (bx + 96) % G : bx); pg8::EpiT<true> E{R1, MT, statp};
              pg8::gemm_phase<pg8::EpiT<true>, pg8::StaticOrder, true, true>(lds, g, S, E); }
            if (l == 0) { pg8::Gemm g{(const bf16_t*)(ws + WS_SPO), WATTO, MC, 1024, 1024}; pg8::StaticOrder S; S.init(MC, 1024, G, (bx + G - 96) % G); pg8::EpiS E{(const bf16_t*)(ws + WS_SPG), R4 + (size_t)ML * 1024, 0};
              pg8::gemm_phase<pg8::EpiS, pg8::StaticOrder, true, true>(lds, g, S, E); }
        } else if (p == 12 && PON(12)) {
            const int nun = (l == 0 ? MT / 128 : ML / 128) * 8;
            for (int u = bx; u < nun; u += G)
                gmlp_unit(lds, (u >> 3) * 128, u & 7, R1, statp, GMWS, args.in[I_GMBS] + l * 1024, args.in[I_LNG] + l * 1024, args.in[I_LNB] + l * 1024, R0, R2);
        } else if (p == 13 && PON(13)) {
            pg8::Gemm g{R0, WGMO, Ml, 1024, 1024}; pg8::StaticOrder S; S.init(Ml, 1024, G, bx); pg8::EpiS E{R3, R4, 0};
            pg8::gemm_phase<pg8::EpiS, pg8::StaticOrder, true, true>(lds, g, S, E);
        } else if (p == 14 && PON(14)) {
            pg8::Gemm g{R4, WOUT, Ml, 1024, 1024}; pg8::StaticOrder S; S.init(Ml, 1024, G, bx); pg8::EpiY E{Y, ysq, MT};
            pg8::gemm_phase<pg8::EpiY, pg8::StaticOrder, true, true>(lds, g, S, E);
        } else if (p == 15 && PON(15)) {
            const int nrow = (l == 0) ? MT : ML;
            for (int m = gw; m < nrow; m += NGW) {
                const float* yr = Y + (size_t)m * 1024; const int r = (m < ML) ? (m >> 12) : 8;
                const float* xr = (l == 0) ? ((m < ML) ? args.in[I_X] + (size_t)m * 1024 : args.in[I_CTX] + (size_t)(m - ML) * 1024) : args.out + (size_t)m * 1024;
                const float q = (lane < 16) ? ysq[(size_t)lane * MT + m] : 0.f;
                const float rn = rsqrtf(wave_sum(q) * (1.f / 1024.f) + 1e-6f);
                const float* gpo = args.in[I_GPOST] + l * 1024; const float* gt = modv + (size_t)(l * 9 + r) * 3072 + 2048;
                f32x4 v[4];
#pragma unroll
                for (int j = 0; j < 4; ++j) { const int col = 4 * lane + 256 * j;
                    const f32x4 y = *(const f32x4*)(yr + col), x = *(const f32x4*)(xr + col), gp4 = *(const f32x4*)(gpo + col), g4 = *(const f32x4*)(gt + col);
                    v[j] = x + g4 * ((y * rn) * gp4);
                    if (m < ML) *(f32x4*)(args.out + (size_t)m * 1024 + col) = v[j]; }
                if (l == 0) h_row(v, args.in[I_GPRE] + 1024, modv + (size_t)(9 + r) * 3072, H + (size_t)m * 1024, lane);
            }
        }
        if (gp + 1 < args.ph_hi) {
            if (gp == args.ph_lo) { grid.sync(); xbar = xcd_barrier_post((unsigned*)(args.ws + WS_BAR), (volatile LAS unsigned*)(lds + 147200)); }
            else xcd_barrier(xbar);
        }
    }
    }
}

extern "C" void kernel_launch(void* const* d_in, const int* in_sizes, int n_in, void* d_out, int out_size, void* d_ws, size_t ws_size, hipStream_t stream) {
    static int grid = 0;
    if (grid == 0) {
        if (n_in != 29 || out_size != ML * DM || ws_size < (size_t)500 * MiB) { fprintf(stderr, "kernel_launch: unexpected shapes n_in %d out %d ws %zu (need %zu)\n", n_in, out_size, ws_size, (size_t)WS_END); grid = -1; return; }
        int dev = 0, cus = 0, per_cu = 0;
        (void)hipGetDevice(&dev); (void)hipDeviceGetAttribute(&cus, hipDeviceAttributeMultiprocessorCount, dev);
        if (hipFuncSetAttribute((const void*)fwd_kernel, hipFuncAttributeMaxDynamicSharedMemorySize, LDS_BYTES) != hipSuccess) { fprintf(stderr, "kernel_launch: hipFuncSetAttribute failed\n"); grid = -1; return; }
        if (hipOccupancyMaxActiveBlocksPerMultiprocessor(&per_cu, (const void*)fwd_kernel, 512, LDS_BYTES) != hipSuccess || per_cu < 1) { fprintf(stderr, "kernel_launch: occupancy query gave %d\n", per_cu); per_cu = 1; }
        (void)hipGetLastError();
        grid = cus * 1;
        fprintf(stderr, "kernel_launch: cus %d per_cu %d grid %d\n", cus, per_cu, grid);
    }
    if (grid < 0) return;
    Args a{};
    for (int i = 0; i < 29; ++i) a.in[i] = (const float*)d_in[i];
    a.out = (float*)d_out; a.ws = (unsigned char*)d_ws; a.ph_lo = 0; a.ph_hi = 2 * NPH;
#ifdef PROBE_A
    a.ph_hi = 2 * NPH + 1;
#endif
    void* kargs[] = {&a};
    hipError_t e = hipLaunchCooperativeKernel((const void*)fwd_kernel, dim3(grid), dim3(512), kargs, LDS_BYTES, stream);
    if (e != hipSuccess) fprintf(stderr, "kernel_launch: cooperative launch failed: %s (grid %d)\n", hipGetErrorString(e), grid);
}
```
